# Optimizing an MI355X kernel written in HIP

```python
import math
import jax, jax.numpy as jnp
from jax import lax
import numpy as np

D_MODEL = 1024
BATCH = 8
SEQ = 2048
DEPTH = 2

RET_HEADS = 4
RET_DK = D_MODEL // RET_HEADS
RET_DV = 2 * RET_DK
RET_CHUNK = 128
ROPE_BASE = 10000.0
HGRN_HEADS = 8
HGRN_DK = D_MODEL // HGRN_HEADS
HGRN_DV = D_MODEL // HGRN_HEADS
HGRN_CHUNK = 64
LB_FLOOR = 1e-30
FNET_GROUPS = 4
FNET_WIDTH = D_MODEL
FNET_GROUP_DIM = FNET_WIDTH // FNET_GROUPS
D_FF = 2816
CONV_W = 3
N_BRANCH = 3
EPS = 1e-6

RET_QK_W = RET_HEADS * RET_DK
RET_V_W = RET_HEADS * RET_DV
HGRN_K_W = HGRN_HEADS * HGRN_DK
HGRN_V_W = HGRN_HEADS * HGRN_DV
D_IN = 2 * RET_QK_W + 2 * RET_V_W + 3 * HGRN_K_W + 2 * HGRN_V_W + FNET_WIDTH + N_BRANCH * D_MODEL

kernel_name = "hybrid_retention_hgrn2_fnet_encoder"


def _split_points():
    widths = (RET_QK_W, RET_QK_W, RET_V_W, RET_V_W,
              HGRN_K_W, HGRN_K_W, HGRN_K_W, HGRN_V_W, HGRN_V_W,
              FNET_WIDTH, N_BRANCH * D_MODEL)
    return tuple(int(c) for c in np.cumsum(widths)[:-1])


def _rms(x):
    xf = x.astype(jnp.float32)
    return xf * lax.rsqrt(jnp.mean(xf * xf, axis=-1, keepdims=True) + EPS)


def rms_norm(x, w):
    return (_rms(x) * w.astype(jnp.float32)).astype(x.dtype)


def rotary(x, positions):
    half = x.shape[-1] // 2
    inv_freq = ROPE_BASE ** (-jnp.arange(half, dtype=jnp.float32) / half)
    ang = positions.astype(jnp.float32)[..., None] * inv_freq
    cos = jnp.cos(ang)[:, :, None, :]
    sin = jnp.sin(ang)[:, :, None, :]
    x1 = x[..., :half].astype(jnp.float32)
    x2 = x[..., half:].astype(jnp.float32)
    return jnp.concatenate([x1 * cos - x2 * sin, x1 * sin + x2 * cos], axis=-1)


def retention_past(qc, kc, vc, log_gamma):
    B, H, nC, C, dk = qc.shape
    dv = vc.shape[-1]
    pos = jnp.arange(C, dtype=jnp.float32)
    q_dec = jnp.exp(log_gamma[:, None] * (pos + 1.0))[None, :, :, None]
    k_dec = jnp.exp(log_gamma[:, None] * (C - 1.0 - pos))[None, :, :, None]
    chunk_dec = jnp.exp(log_gamma * C)[None, :, None, None]

    def step(state, xs):
        q, k, v = xs
        out = jnp.einsum('bhcd,bhde->bhce', q * q_dec, state)
        state = state * chunk_dec + jnp.einsum('bhcd,bhce->bhde', k * k_dec, v)
        return state, out

    init = jnp.zeros((B, H, dk, dv), jnp.float32)
    xs = (jnp.moveaxis(qc, 2, 0), jnp.moveaxis(kc, 2, 0), jnp.moveaxis(vc, 2, 0))
    _, out = lax.scan(step, init, xs)
    return jnp.moveaxis(out, 0, 2)


def retention(q, k, v, log_gamma):
    B, S, H, _ = q.shape
    C = RET_CHUNK
    nC = S // C

    def chunk(t):
        return t.astype(jnp.float32).reshape(B, nC, C, H, -1).transpose(0, 3, 1, 2, 4)

    qc, kc, vc = chunk(q), chunk(k), chunk(v)
    pos = jnp.arange(C, dtype=jnp.float32)
    dist = jnp.abs(pos[:, None] - pos[None, :])
    decay = jnp.exp(log_gamma[:, None, None] * dist)
    scores = jnp.einsum('bhnid,bhnjd->bhnij', qc, kc) * decay[None, :, None]
    intra = jnp.einsum('bhnij,bhnje->bhnie', scores, vc)

    def flip(t):
        return t[:, :, ::-1, ::-1]

    past = retention_past(qc, kc, vc, log_gamma)
    future = flip(retention_past(flip(qc), flip(kc), flip(vc), log_gamma))
    out = intra + past + future
    return out.transpose(0, 2, 3, 1, 4).reshape(B, S, H, -1)


def hgrn2_scan(q, k, log_f, v):
    B, S, H, dk = q.shape
    dv = v.shape[-1]
    C = HGRN_CHUNK
    nC = S // C

    def chunk(t):
        return t.reshape(B, nC, C, H, -1).transpose(1, 0, 3, 2, 4)

    causal = jnp.tril(jnp.ones((C, C), dtype=bool))[None, None, :, :, None]

    def step(state, xs):
        qc, kc, gc, vc = xs
        b = jnp.cumsum(gc, axis=2)
        diff = b[:, :, :, None, :] - b[:, :, None, :, :]
        pair_dec = jnp.where(causal, jnp.exp(jnp.where(causal, diff, 0.0)), 0.0)
        attn = jnp.einsum('bhtsd,bhtd,bhsd->bhts', pair_dec, qc, kc)
        intra = jnp.einsum('bhts,bhse->bhte', attn, vc)
        inter = jnp.einsum('bhtd,bhde->bhte', qc * jnp.exp(b), state)
        b_last = b[:, :, -1:, :]
        state = (state * jnp.exp(b_last)[:, :, 0, :, None]
                 + jnp.einsum('bhsd,bhse->bhde', kc * jnp.exp(b_last - b), vc))
        return state, intra + inter

    init = jnp.zeros((B, H, dk, dv), jnp.float32)
    _, out = lax.scan(step, init, (chunk(q), chunk(k), chunk(log_f), chunk(v)))
    return out.transpose(1, 0, 3, 2, 4).reshape(B, S, H, dv)


def hgrn2_gate(z, lb):
    zf = z.astype(jnp.float32)
    log_lb = jnp.log(jnp.maximum(lb, LB_FLOOR))
    log_f = jnp.logaddexp(jax.nn.log_sigmoid(zf), log_lb + jax.nn.log_sigmoid(-zf))
    k = (1.0 - lb) * jax.nn.sigmoid(-zf)
    return log_f, k


def hgrn2_lower_bounds(lb_logits):
    p = jax.nn.softmax(lb_logits.astype(jnp.float32), axis=1)
    return jnp.cumsum(p, axis=1) - p[:, :1]


def fourier_mix(u):
    B, S, _ = u.shape
    ug = u.astype(jnp.float32).reshape(B, S, FNET_GROUPS, FNET_GROUP_DIM)
    y = jnp.fft.fft2(ug, axes=(1, 3), norm='ortho').real
    return y.reshape(B, S, FNET_WIDTH).astype(u.dtype)


def conv_ffn(x, w_up, conv_w, conv_b, w_down):
    h = x @ w_up
    pad = CONV_W // 2
    hp = jnp.pad(h, ((0, 0), (pad, pad), (0, 0)))
    S = h.shape[1]
    hc = conv_b
    for j in range(CONV_W):
        hc = hc + hp[:, j:j + S] * conv_w[j]
    gate, up = jnp.split(hc, 2, axis=-1)
    return (jax.nn.gelu(gate, approximate=True) * up) @ w_down


def setup_inputs(seed: int = 0) -> dict:
    key = jax.random.key(seed)
    ks = jax.random.split(key, 14)
    f32 = jnp.float32

    def nrm(k, shape, fan_in):
        return jax.random.normal(k, shape, f32) * (fan_in ** -0.5)

    x = jax.random.normal(ks[0], (BATCH, SEQ, D_MODEL), f32)
    positions = jnp.tile(jnp.arange(SEQ, dtype=jnp.int32)[None, :], (BATCH, 1))
    norm_w = 1.0 + 0.05 * jax.random.normal(ks[1], (DEPTH, 4, D_MODEL), f32)
    w_in = nrm(ks[2], (DEPTH, D_MODEL, D_IN), D_MODEL)
    hgrn_lb_logits = jax.random.normal(ks[3], (2, DEPTH, HGRN_K_W), f32)
    hgrn_norm_w = 1.0 + 0.05 * jax.random.normal(ks[4], (DEPTH, HGRN_DV), f32)
    w_ret_o = nrm(ks[5], (DEPTH, RET_V_W, D_MODEL), RET_V_W)
    w_hgrn_o = nrm(ks[6], (DEPTH, HGRN_V_W, D_MODEL), HGRN_V_W)
    w_fnet = nrm(ks[7], (DEPTH, FNET_WIDTH, D_MODEL), FNET_WIDTH)
    w_out = nrm(ks[8], (DEPTH, D_MODEL, D_MODEL), D_MODEL)
    w_up = nrm(ks[9], (DEPTH, D_MODEL, 2 * D_FF), D_MODEL)
    conv_w = nrm(ks[10], (DEPTH, CONV_W, 2 * D_FF), CONV_W)
    conv_b = 0.01 * jax.random.normal(ks[11], (DEPTH, 2 * D_FF), f32)
    w_down = nrm(ks[12], (DEPTH, D_FF, D_MODEL), D_FF)
    return {"x": x, "positions": positions, "norm_w": norm_w, "w_in": w_in,
            "hgrn_lb_logits": hgrn_lb_logits, "hgrn_norm_w": hgrn_norm_w,
            "w_ret_o": w_ret_o, "w_hgrn_o": w_hgrn_o, "w_fnet": w_fnet, "w_out": w_out,
            "w_up": w_up, "conv_w": conv_w, "conv_b": conv_b, "w_down": w_down}


def reference(x, positions, norm_w, w_in, hgrn_lb_logits, hgrn_norm_w,
              w_ret_o, w_hgrn_o, w_fnet, w_out, w_up, conv_w, conv_b, w_down):
    B, S, _ = x.shape
    dt = x.dtype
    split_points = _split_points()
    log_gamma = jnp.log(1.0 - 2.0 ** (-5.0 - jnp.arange(RET_HEADS, dtype=jnp.float32)))
    lower_bounds = hgrn2_lower_bounds(hgrn_lb_logits)
    hgrn_scale = HGRN_DK ** -0.5
    ret_scale = RET_DK ** -0.5

    def flip(t):
        return t[:, ::-1]

    for l in range(DEPTH):
        xn = rms_norm(x, norm_w[l, 0])
        u = xn @ w_in[l]
        (rq, rk, rv, rg, hq, hz_f, hz_b, hi, hg, fu, ga) = jnp.split(u, split_points, axis=-1)

        q = rotary(rq.reshape(B, S, RET_HEADS, RET_DK), positions)
        k = rotary(rk.reshape(B, S, RET_HEADS, RET_DK), positions) * ret_scale
        ro = retention(q, k, rv.reshape(B, S, RET_HEADS, RET_DV), log_gamma)
        ro = _rms(ro).reshape(B, S, RET_V_W).astype(dt) * jax.nn.silu(rg)
        y_ret = ro @ w_ret_o[l]

        hqh = jax.nn.silu(hq.astype(jnp.float32)).reshape(B, S, HGRN_HEADS, HGRN_DK) * hgrn_scale
        hih = hi.astype(jnp.float32).reshape(B, S, HGRN_HEADS, HGRN_DV)
        lf_f, k_f = hgrn2_gate(hz_f.reshape(B, S, HGRN_HEADS, HGRN_DK),
                               lower_bounds[0, l].reshape(HGRN_HEADS, HGRN_DK))
        lf_b, k_b = hgrn2_gate(hz_b.reshape(B, S, HGRN_HEADS, HGRN_DK),
                               lower_bounds[1, l].reshape(HGRN_HEADS, HGRN_DK))
        ho_f = hgrn2_scan(hqh, k_f, lf_f, hih)
        ho_b = flip(hgrn2_scan(flip(hqh), flip(k_b), flip(lf_b), flip(hih)))
        ho = _rms(ho_f + ho_b) * hgrn_norm_w[l].astype(jnp.float32)
        ho = ho.reshape(B, S, HGRN_V_W).astype(dt) * jax.nn.silu(hg)
        y_hgrn = ho @ w_hgrn_o[l]

        y_fft = fourier_mix(fu) @ w_fnet[l]

        g_ret, g_hgrn, g_fft = jnp.split(jax.nn.sigmoid(ga), N_BRANCH, axis=-1)
        mix = (g_ret * y_ret + g_hgrn * y_hgrn + g_fft * y_fft) @ w_out[l]
        x = x + rms_norm(mix, norm_w[l, 1])

        hn = rms_norm(x, norm_w[l, 2])
        x = x + rms_norm(conv_ffn(hn, w_up[l], conv_w[l], conv_b[l], w_down[l]), norm_w[l, 3])
    return x
```

```cpp
#include <hip/hip_runtime.h>
#include <hip/hip_cooperative_groups.h>
#include <cstdio>
#include <cstdint>
namespace cg = cooperative_groups;

#ifndef MK_MULTI
#define MK_MULTI 0
#endif

#define LAS __attribute__((address_space(3)))
typedef unsigned short bf16_t;
typedef short bf16x8 __attribute__((ext_vector_type(8)));
typedef float f32x4 __attribute__((ext_vector_type(4)));
typedef float f32x2 __attribute__((ext_vector_type(2)));
typedef unsigned u32x4 __attribute__((ext_vector_type(4)));
typedef unsigned u32x2 __attribute__((ext_vector_type(2)));

constexpr int BATCH = 8, SEQ = 2048, DM = 1024, DEPTH = 2, DIN = 15360, DFF = 2816;
constexpr int NB = 4;
constexpr int NGRP = BATCH / NB;
constexpr int TG = NB * SEQ;
constexpr int TA = BATCH * SEQ;
constexpr float EPS = 1e-6f;
constexpr int NTHREADS = 512;
constexpr int LDS_BYTES = 156 * 1024;

constexpr size_t MiB = 1u << 20;
constexpr size_t WS_WIN = 0;
constexpr size_t WS_WRET = WS_WIN + (size_t)DIN * DM * 2;
constexpr size_t WS_WHG = WS_WRET + (size_t)DM * 2048 * 2;
constexpr size_t WS_WFN = WS_WHG + (size_t)DM * DM * 2;
constexpr size_t WS_WOUT = WS_WFN + (size_t)DM * DM * 2;
constexpr size_t WS_WUP = WS_WOUT + (size_t)DM * DM * 2;
constexpr size_t WS_WDN = WS_WUP + (size_t)2 * DFF * DM * 2;
constexpr size_t WS_WEND = WS_WDN + (size_t)DM * DFF * 2;
static_assert(WS_WEND <= 58 * MiB, "weights");
constexpr size_t WS_DSEQ = 58 * MiB;
constexpr size_t WS_CDFT = 74 * MiB;
constexpr size_t WS_LB = WS_CDFT + 512 * 1024;
constexpr size_t WS_BAR = WS_CDFT + 640 * 1024;
constexpr size_t WS_ROPE = 75 * MiB;
constexpr size_t WS_MIXIN = 91 * MiB;
constexpr size_t WS_G = 123 * MiB;
constexpr size_t G_HOF = WS_G + 0 * MiB;
constexpr size_t G_Q = WS_G + 16 * MiB;
constexpr size_t G_K = WS_G + 32 * MiB;
constexpr size_t G_VT = WS_G + 48 * MiB;
constexpr size_t G_SGR = WS_G + 80 * MiB;
constexpr size_t G_HQ = WS_G + 112 * MiB;
constexpr size_t G_LFF = WS_G + 128 * MiB;
constexpr size_t G_LFB = WS_G + 144 * MiB;
constexpr size_t G_HI = WS_G + 160 * MiB;
constexpr size_t G_SGH = WS_G + 176 * MiB;
constexpr size_t G_FU = WS_G + 192 * MiB;
constexpr size_t G_GATES = WS_G + 208 * MiB;
constexpr size_t G_PQT = WS_G + 256 * MiB;
constexpr size_t G_SQ = WS_G + 16 * MiB;
constexpr size_t G_F1 = WS_G + 320 * MiB;
constexpr size_t G_F2 = WS_G + 336 * MiB;
constexpr size_t G_YF = WS_G + 288 * MiB;
constexpr size_t G_HOB = WS_G + 304 * MiB;
constexpr size_t G_END = WS_G + 320 * MiB;
constexpr size_t A_HN = WS_G + 0 * MiB;
constexpr size_t A_MIXO = WS_G + 32 * MiB;
constexpr size_t A_H = WS_G + 96 * MiB;
constexpr size_t A_FFO = A_H;
constexpr size_t A_ACT = WS_MIXIN;
constexpr size_t A_END = A_H + (size_t)TA * 2 * DFF * 2;
static_assert(G_END <= 480 * MiB && A_END <= 480 * MiB, "ws");
static_assert(A_ACT + (size_t)TA * DFF * 2 <= A_H, "act overlay");

__device__ __forceinline__ unsigned f2bf(float f) { unsigned u = __builtin_bit_cast(unsigned, f); return (u + 0x7fffu + ((u >> 16) & 1u)) >> 16; }
__device__ __forceinline__ unsigned pk2(float lo, float hi) { return f2bf(lo) | (f2bf(hi) << 16); }
__device__ __forceinline__ float bf2f(unsigned short h) { return __builtin_bit_cast(float, (unsigned)h << 16); }
__device__ __forceinline__ float bflo(unsigned w) { return __builtin_bit_cast(float, w << 16); }
__device__ __forceinline__ float bfhi(unsigned w) { return __builtin_bit_cast(float, w & 0xffff0000u); }
__device__ __forceinline__ float shx(float v, int o, int lane) { return __builtin_bit_cast(float, __builtin_amdgcn_ds_bpermute((lane ^ o) << 2, __builtin_bit_cast(int, v))); }
__device__ __forceinline__ float wave_sum(float v, int lane) {
#pragma unroll
    for (int o = 1; o < 64; o <<= 1) v += shx(v, o, lane);
    return v;
}
__device__ __forceinline__ int otid() { int t = threadIdx.x; asm volatile("" : "+v"(t)); return t; }
__device__ __forceinline__ int obid() { int t = blockIdx.x; asm volatile("" : "+s"(t)); return t; }
__device__ __forceinline__ int ogrid() { int t = gridDim.x; asm volatile("" : "+s"(t)); return t; }
typedef __bf16 bf16x2_t __attribute__((ext_vector_type(2)));
__device__ __forceinline__ unsigned cvtpk(float lo, float hi) { const f32x2 v = {lo, hi}; const bf16x2_t b = __builtin_convertvector(v, bf16x2_t); return __builtin_bit_cast(unsigned, b); }
__device__ __forceinline__ float silu_f(float x) { return x * __builtin_amdgcn_rcpf(1.f + __builtin_amdgcn_exp2f(-1.4426950408889634f * x)); }
__device__ __forceinline__ float sigm_f(float x) { return __builtin_amdgcn_rcpf(1.f + __builtin_amdgcn_exp2f(-1.4426950408889634f * x)); }
__device__ __forceinline__ f32x4 mfma16(bf16x8 a, bf16x8 b, f32x4 c) { return __builtin_amdgcn_mfma_f32_16x16x32_bf16(a, b, c, 0, 0, 0); }

namespace pg8 {
constexpr int BM = 256, BK = 64, HALF = 128, HTB = HALF * BK * 2, STAGE_BYTES = 8 * HTB, NXCD = 8, WGM = 8;
__host__ __device__ __forceinline__ int lds_byte(int r, int c) { const int st = (r >> 4) * 2 + (c >> 5), rr = r & 15, cc = c & 31, ob = rr * 64 + cc * 2; return st * 1024 + (ob ^ (((ob >> 9) & 1) << 5)); }
__host__ __device__ __forceinline__ void stage_rc(int b, int& R, int& C) { const int st = b / 1024, sb = b % 1024, swz = sb ^ (((sb >> 9) & 1) << 5); R = (st >> 1) * 16 + swz / 64; C = (st & 1) * 32 + (swz % 64) / 2; }
__host__ __device__ __forceinline__ int perm32(int rho) { const int n = rho >> 4, i = rho & 15; return 8 * (i >> 2) + 4 * n + (i & 3); }

struct Unit { int pm, pn, z; size_t offA, offB; };
struct Gemm { const bf16_t* A; const bf16_t* Bt; int lda, ldb, K; };

struct StaticOrder {
    int nM, nN, nwg, G, c;
    __device__ __forceinline__ void init(int nM_, int nN_, int G_, int c_) { nM = nM_; nN = nN_; nwg = nM * nN; G = G_; c = c_; }
    __device__ __forceinline__ bool next(int i, int& pm, int& pn) const {
        const long L = (long)i * G + c; if (L >= nwg) return false;
        int wgid = (int)L; { const int q = nwg / NXCD, r = nwg % NXCD, xcd = wgid % NXCD, off = wgid / NXCD; wgid = (xcd < r ? xcd * (q + 1) : r * (q + 1) + (xcd - r) * q) + off; }
        const int nig = WGM * nN, gid = wgid / nig, fm = gid * WGM, gsz = (nM - fm) < WGM ? (nM - fm) : WGM;
        pm = fm + ((wgid % nig) % gsz); pn = (wgid % nig) / gsz; return true;
    }
};
struct SchedPlain {
    StaticOrder o; size_t tA, tB;
    __device__ __forceinline__ void init(int M, int N, int lda, int ldb, int G, int c) { o.init(M / BM, N / BM, G, c); tA = (size_t)BM * lda * 2; tB = (size_t)BM * ldb * 2; }
    __device__ __forceinline__ bool next(int i, Unit& u) const { int pm, pn; if (!o.next(i, pm, pn)) return false; u.pm = pm; u.pn = pn; u.z = 0; u.offA = pm * tA; u.offB = pn * tB; return true; }
};
struct SchedInProj {
    StaticOrder o; size_t tA, tB;
    __device__ __forceinline__ void init(int G, int c) { o.init(TG / BM, 52, G, c); tA = (size_t)BM * DM * 2; tB = (size_t)BM * DM * 2; }
    __device__ __forceinline__ bool next(int i, Unit& u) const { int pm, pn; if (!o.next(i, pm, pn)) return false; if (pn >= 8) pn += 8; u.pm = pm; u.pn = pn; u.z = 0; u.offA = pm * tA; u.offB = pn * tB; return true; }
};
struct SchedChan {
    int G, c, base, lim;
    __device__ __forceinline__ void init(int G_, int c_, int base_ = 0, int lim_ = 4 * 2 * (TG / BM)) { G = G_; c = c_; base = base_; lim = lim_; }
    __device__ __forceinline__ bool next(int i, Unit& u) const {
        const int L = base + i * G + c; constexpr int NT = TG / BM; if (L >= lim) return false;
        const int g = L / (2 * NT), r = L % (2 * NT); u.z = g; u.pm = r / NT; u.pn = r % NT;
        u.offA = (size_t)u.pm * BM * 256 * 2; u.offB = ((size_t)u.pn * BM * DM + g * 256) * 2; return true;
    }
};

struct SchedSeqH {
    int G, c;
    __device__ __forceinline__ void init(int G_, int c_) { G = G_; c = c_; }
    __device__ __forceinline__ bool next(int i, Unit& u) const {
        const int L = i * G + c; constexpr int NN = NB * 1024 / BM; if (L >= 2 * 4 * NN) return false;
        const int z = L / (4 * NN), r = L % (4 * NN); u.z = z; u.pm = r / NN; u.pn = r % NN;
        u.offA = ((size_t)u.pm * BM * 4096 + z * 2048) * 2; u.offB = ((size_t)u.pn * BM * 4096 + z * 2048) * 2; return true;
    }
};
__device__ __forceinline__ unsigned cvt_pk_bf16(float lo, float hi) { return cvtpk(lo, hi); }

template <class Epi, class Sched, bool ALIGN_EPI = true, bool SP2 = true>
__device__ __forceinline__ void gemm_phase(LAS unsigned char* lds, const Gemm g, const Sched& S, const Epi& E) {
    int tid_ = threadIdx.x; asm volatile("" : "+v"(tid_));
    const int tid = tid_, wid = __builtin_amdgcn_readfirstlane(tid >> 6), lane = tid & 63, wr = wid >> 2, wc = wid & 3, fr = lane & 15, fq = lane >> 4;
    const int K = g.K, nt = K / BK;
    unsigned voffA[2], voffB[2];
#pragma unroll
    for (int i = 0; i < 2; ++i) { int R, C; stage_rc(tid * 16 + i * 8192, R, C); const int Rb = Epi::PERM ? ((R & ~31) + perm32(R & 31)) : R;
        voffA[i] = (unsigned)(R * g.lda + C) * 2u; voffB[i] = (unsigned)(Rb * g.ldb + C) * 2u; }
    const size_t kstep = (size_t)(BK * 2);
    const size_t hstepA = (size_t)HALF * g.lda * 2, hstepB = (size_t)HALF * g.ldb * 2;
    const unsigned ldsw = (unsigned)wid * 1024u;
    const int aoff = lds_byte(wr * 64 + fr, fq * 8), boff = lds_byte(wc * 32 + fr, fq * 8);
#define PG8_SA(b, h) (((b) * 2 + (h)) * HTB)
#define PG8_SB(b, h) ((4 + (b) * 2 + (h)) * HTB)
#define PG8_STAGE(bufoff, gbase, voff) do { const char* _gb = (const char*)(gbase); asm volatile("" : "+s"(_gb));     \
        _Pragma("unroll") for (int _i = 0; _i < 2; ++_i) \
        __builtin_amdgcn_global_load_lds((const unsigned*)(_gb + (voff)[_i]), (LAS unsigned*)(lds + (bufoff) + ldsw + _i * 8192), 16, 0, 0); } while (0)
#define PG8_LDA(dst, b, h) do { _Pragma("unroll") for (int m = 0; m < 4; ++m) _Pragma("unroll") for (int k = 0; k < 2; ++k) dst[m][k] = *(const LAS bf16x8*)(lds + PG8_SA(b, h) + aoff + m * 2048 + k * 1024); } while (0)
#define PG8_LDB(dst, b, h) do { _Pragma("unroll") for (int n = 0; n < 2; ++n) _Pragma("unroll") for (int k = 0; k < 2; ++k) dst[n][k] = *(const LAS bf16x8*)(lds + PG8_SB(b, h) + boff + n * 2048 + k * 1024); } while (0)
#define PG8_MMA(ai, bj, At, Bt) do { __builtin_amdgcn_s_setprio(1); _Pragma("unroll") for (int m = 0; m < 4; ++m) _Pragma("unroll") for (int n = 0; n < 2; ++n) _Pragma("unroll") for (int k = 0; k < 2; ++k) \
        acc[ai][bj][m][n] = __builtin_amdgcn_mfma_f32_16x16x32_bf16(Bt[n][k], At[m][k], acc[ai][bj][m][n], 0, 0, 0); __builtin_amdgcn_s_setprio(0); } while (0)
#define PG8_WAIT_V(n) asm volatile("s_waitcnt vmcnt(" #n ")" ::: "memory")
#define PG8_WAIT_L(n) asm volatile("s_waitcnt lgkmcnt(" #n ")" ::: "memory")
#define PG8_BAR __builtin_amdgcn_s_barrier()
#define PG8_SCHED __builtin_amdgcn_sched_barrier(0)
    Unit cur, nxt; int ui = 0;
    if (!S.next(0, cur)) return;
    f32x4 acc[2][2][4][2];
#pragma unroll
    for (int a = 0; a < 2; ++a)
#pragma unroll
        for (int b = 0; b < 2; ++b)
#pragma unroll
            for (int m = 0; m < 4; ++m)
#pragma unroll
                for (int n = 0; n < 2; ++n) acc[a][b][m][n] = (f32x4){0.f, 0.f, 0.f, 0.f};
    bf16x8 At[4][2], B0[2][2], B1[2][2];
    const char* cA = (const char*)g.A + cur.offA; const char* cB = (const char*)g.Bt + cur.offB;
    if constexpr (SP2) {
        PG8_STAGE(PG8_SB(0, 0), cB, voffB); PG8_STAGE(PG8_SB(0, 1), cB + hstepB, voffB); PG8_STAGE(PG8_SA(0, 0), cA, voffA); PG8_STAGE(PG8_SA(0, 1), cA + hstepA, voffA);
        if (wr == 1) PG8_BAR;
        PG8_WAIT_V(2); PG8_BAR;
        PG8_STAGE(PG8_SB(1, 0), cB + kstep, voffB); PG8_STAGE(PG8_SA(1, 0), cA + kstep, voffA); PG8_STAGE(PG8_SB(1, 1), cB + hstepB + kstep, voffB);
        PG8_WAIT_V(6); PG8_BAR;
    } else {
        PG8_STAGE(PG8_SB(0, 0), cB, voffB); PG8_STAGE(PG8_SA(0, 0), cA, voffA); PG8_STAGE(PG8_SB(0, 1), cB + hstepB, voffB); PG8_STAGE(PG8_SA(0, 1), cA + hstepA, voffA);
        if (wr == 1) PG8_BAR;
        PG8_WAIT_V(4); PG8_BAR;
        PG8_STAGE(PG8_SB(1, 0), cB + kstep, voffB); PG8_STAGE(PG8_SA(1, 0), cA + kstep, voffA); PG8_STAGE(PG8_SB(1, 1), cB + hstepB + kstep, voffB);
        PG8_WAIT_V(6); PG8_BAR;
    }
    for (;;) {
        const bool has_next = S.next(ui + 1, nxt);
        const char* nA = has_next ? (const char*)g.A + nxt.offA : cA; const char* nB = has_next ? (const char*)g.Bt + nxt.offB : cB;
        for (int t = 0; t < nt; t += 2) {
            const bool last = (t == nt - 2);
            const char* a1 = cA + (size_t)(t + 1) * kstep;
            const char* a2 = last ? nA : cA + (size_t)(t + 2) * kstep; const char* b2 = last ? nB : cB + (size_t)(t + 2) * kstep;
            const char* a3 = a2 + kstep; const char* b3 = b2 + kstep;
            if constexpr (SP2) {
            PG8_LDB(B0, 0, 0); PG8_LDB(B1, 0, 1); PG8_SCHED; PG8_LDA(At, 0, 0); PG8_STAGE(PG8_SA(1, 1), a1 + hstepA, voffA);
            PG8_WAIT_V(8); PG8_WAIT_L(0); PG8_BAR; PG8_MMA(0, 0, At, B0); PG8_MMA(0, 1, At, B1); PG8_BAR; PG8_SCHED;
            PG8_LDA(At, 0, 1); PG8_STAGE(PG8_SB(0, 0), b2, voffB); PG8_STAGE(PG8_SB(0, 1), b2 + hstepB, voffB); PG8_STAGE(PG8_SA(0, 0), a2, voffA);
            PG8_WAIT_V(8); PG8_WAIT_L(0); PG8_BAR; PG8_MMA(1, 0, At, B0); PG8_MMA(1, 1, At, B1); PG8_BAR; PG8_SCHED;
            PG8_LDB(B0, 1, 0); PG8_LDB(B1, 1, 1); PG8_SCHED; PG8_LDA(At, 1, 0); PG8_STAGE(PG8_SA(0, 1), a2 + hstepA, voffA);
            PG8_WAIT_V(8); PG8_WAIT_L(0); PG8_BAR; PG8_MMA(0, 0, At, B0); PG8_MMA(0, 1, At, B1); PG8_BAR; PG8_SCHED;
            PG8_LDA(At, 1, 1); PG8_STAGE(PG8_SB(1, 0), b3, voffB); PG8_STAGE(PG8_SB(1, 1), b3 + hstepB, voffB); PG8_STAGE(PG8_SA(1, 0), a3, voffA);
            PG8_WAIT_V(8); PG8_WAIT_L(0); PG8_BAR; PG8_MMA(1, 0, At, B0); PG8_MMA(1, 1, At, B1); PG8_BAR; PG8_SCHED;
            } else {
            PG8_LDB(B0, 0, 0); PG8_SCHED; PG8_LDA(At, 0, 0); PG8_STAGE(PG8_SA(1, 1), a1 + hstepA, voffA);
            PG8_WAIT_L(8); PG8_BAR; PG8_WAIT_L(0); PG8_MMA(0, 0, At, B0); PG8_BAR; PG8_SCHED;
            PG8_LDB(B1, 0, 1); PG8_STAGE(PG8_SB(0, 0), b2, voffB);
            PG8_BAR; PG8_WAIT_L(0); PG8_MMA(0, 1, At, B1); PG8_BAR;
            PG8_LDA(At, 0, 1); PG8_STAGE(PG8_SA(0, 0), a2, voffA);
            PG8_BAR; PG8_WAIT_L(0); PG8_MMA(1, 0, At, B0); PG8_BAR; PG8_SCHED;
            PG8_STAGE(PG8_SB(0, 1), b2 + hstepB, voffB);
            PG8_WAIT_V(6); PG8_BAR; PG8_MMA(1, 1, At, B1); PG8_BAR;
            PG8_LDB(B0, 1, 0); PG8_SCHED; PG8_LDA(At, 1, 0); PG8_STAGE(PG8_SA(0, 1), a2 + hstepA, voffA);
            PG8_WAIT_L(8); PG8_BAR; PG8_WAIT_L(0); PG8_MMA(0, 0, At, B0); PG8_BAR; PG8_SCHED;
            PG8_LDB(B1, 1, 1); PG8_STAGE(PG8_SB(1, 0), b3, voffB);
            PG8_BAR; PG8_WAIT_L(0); PG8_MMA(0, 1, At, B1); PG8_BAR;
            PG8_LDA(At, 1, 1); PG8_STAGE(PG8_SA(1, 0), a3, voffA);
            PG8_BAR; PG8_WAIT_L(0); PG8_MMA(1, 0, At, B0); PG8_BAR; PG8_SCHED;
            PG8_STAGE(PG8_SB(1, 1), b3 + hstepB, voffB);
            PG8_WAIT_V(6); PG8_BAR; PG8_MMA(1, 1, At, B1); PG8_BAR;
            }
        }
        if constexpr (ALIGN_EPI) { if (wr == 0) PG8_BAR; }
        { int t2 = tid; asm volatile("" : "+v"(t2));
          const int w2 = t2 >> 6, l2 = t2 & 63; E(acc, cur, w2 >> 2, w2 & 3, l2 & 15, l2 >> 4); }
        if (!has_next) break;
#pragma unroll
        for (int a = 0; a < 2; ++a)
#pragma unroll
            for (int b = 0; b < 2; ++b)
#pragma unroll
                for (int m = 0; m < 4; ++m)
#pragma unroll
                    for (int n = 0; n < 2; ++n) acc[a][b][m][n] = (f32x4){0.f, 0.f, 0.f, 0.f};
        cur = nxt; cA = nA; cB = nB; ++ui;
        if constexpr (ALIGN_EPI) { if (wr == 1) PG8_BAR; }
    }
    PG8_WAIT_V(0);
    if constexpr (!ALIGN_EPI) { if (wr == 0) PG8_BAR; }
    PG8_BAR;
#undef PG8_SA
#undef PG8_SB
#undef PG8_STAGE
#undef PG8_LDA
#undef PG8_LDB
#undef PG8_MMA
#undef PG8_WAIT_V
#undef PG8_WAIT_L
#undef PG8_BAR
#undef PG8_SCHED
}

typedef f32x4 Acc[2][2][4][2];
#define EPI_ROW_FENCE __builtin_amdgcn_sched_barrier(0)
__device__ __forceinline__ u32x4 pack8(const f32x4 v0, const f32x4 v1) { u32x4 w; w.x = cvt_pk_bf16(v0[0], v0[1]); w.y = cvt_pk_bf16(v0[2], v0[3]); w.z = cvt_pk_bf16(v1[0], v1[1]); w.w = cvt_pk_bf16(v1[2], v1[3]); return w; }

template <int LDC> __device__ __forceinline__ void store_tile_bf16(const Acc& acc, bf16_t* base) {
#pragma unroll
    for (int ai = 0; ai < 2; ++ai)
#pragma unroll
        for (int m = 0; m < 4; ++m) { bf16_t* rowp = base + (size_t)(ai * HALF + m * 16) * LDC;
#pragma unroll
            for (int bj = 0; bj < 2; ++bj) *(u32x4*)(rowp + bj * HALF) = pack8(acc[ai][bj][m][0], acc[ai][bj][m][1]);
            EPI_ROW_FENCE; }
}
template <int LDC> struct EpiBf16 {
    static constexpr bool PERM = true;
    bf16_t* O;
    __device__ __forceinline__ void operator()(const Acc& acc, const Unit& u, int wr, int wc, int fr, int fq) const {
        store_tile_bf16<LDC>(acc, O + (size_t)(u.pm * BM + wr * 64 + fr) * LDC + u.pn * BM + wc * 32 + 8 * fq);
    }
};
struct EpiF32 {
    static constexpr bool PERM = false;
    float* O;
    __device__ __forceinline__ void operator()(const Acc& acc, const Unit& u, int wr, int wc, int fr, int fq) const {
        float* base = O + (size_t)(u.pm * BM + wr * 64 + fr) * DM + u.pn * BM + wc * 32 + 4 * fq;
#pragma unroll
        for (int ai = 0; ai < 2; ++ai)
#pragma unroll
            for (int m = 0; m < 4; ++m) { float* rowp = base + (size_t)(ai * HALF + m * 16) * DM;
#pragma unroll
                for (int bj = 0; bj < 2; ++bj)
#pragma unroll
                    for (int n = 0; n < 2; ++n) *(f32x4*)(rowp + bj * HALF + 16 * n) = acc[ai][bj][m][n];
                EPI_ROW_FENCE; }
    }
};
struct EpiSeqH {
    static constexpr bool PERM = true;
    bf16_t* O;
    __device__ __forceinline__ void operator()(const Acc& acc, const Unit& u, int wr, int wc, int fr, int fq) const {
        constexpr int LD = NB * 1024;
        store_tile_bf16<LD>(acc, O + ((size_t)u.z * 1024 + u.pm * BM + wr * 64 + fr) * LD + u.pn * BM + wc * 32 + 8 * fq);
    }
};
template <int MODE> struct EpiMix {
    static constexpr bool PERM = false;
    bf16_t* F; const bf16_t* gates;
    __device__ __forceinline__ void operator()(const Acc& acc, const Unit& u, int wr, int wc, int fr, int fq) const {
        const size_t row0 = u.pm * BM + wr * 64 + fr; const int col0 = u.pn * BM + wc * 32 + 4 * fq;
        bf16_t* fb = F + row0 * DM + col0; const bf16_t* gb = gates + row0 * 3072 + col0;
#pragma unroll
        for (int ai = 0; ai < 2; ++ai) {
            u32x2 gw[4][4], ow[4][4];
#pragma unroll
            for (int m = 0; m < 4; ++m)
#pragma unroll
                for (int q = 0; q < 4; ++q) { const int ro = ai * HALF + m * 16, co = (q >> 1) * HALF + 16 * (q & 1);
                    gw[m][q] = *(const u32x2*)(gb + (size_t)ro * 3072 + co);
                    if (MODE >= 1) ow[m][q] = *(const u32x2*)(fb + (size_t)ro * DM + co); }
#pragma unroll
            for (int m = 0; m < 4; ++m)
#pragma unroll
                for (int q = 0; q < 4; ++q) { const int ro = ai * HALF + m * 16, co = (q >> 1) * HALF + 16 * (q & 1);
                    f32x4 v = acc[ai][q >> 1][m][q & 1]; v[0] *= bflo(gw[m][q].x); v[1] *= bfhi(gw[m][q].x); v[2] *= bflo(gw[m][q].y); v[3] *= bfhi(gw[m][q].y);
                    if (MODE >= 1) { v[0] += bflo(ow[m][q].x); v[1] += bfhi(ow[m][q].x); v[2] += bflo(ow[m][q].y); v[3] += bfhi(ow[m][q].y); }
                    u32x2 w; w.x = cvt_pk_bf16(v[0], v[1]); w.y = cvt_pk_bf16(v[2], v[3]); *(u32x2*)(fb + (size_t)ro * DM + co) = w; }
            EPI_ROW_FENCE; }
    }
};
struct EpiChan {
    static constexpr bool PERM = true;
    bf16_t* PQT;
    __device__ __forceinline__ void operator()(const Acc& acc, const Unit& u, int wr, int wc, int fr, int fq) const {
        const int tok0 = u.pn * BM, bl = tok0 >> 11, s0 = (tok0 & (SEQ - 1)) + wc * 32 + 8 * fq;
        store_tile_bf16<4096>(acc, PQT + ((size_t)(bl * 1024 + u.z * 256 + wr * 64 + fr)) * 4096 + u.pm * 2048 + s0);
    }
};
struct EpiSeq {
    static constexpr bool PERM = true;
    bf16_t* YF;
    __device__ __forceinline__ void operator()(const Acc& acc, const Unit& u, int wr, int wc, int fr, int fq) const {
        const int bl = u.pn >> 2, gc0 = (u.pn & 3) * 256 + wc * 32 + 8 * fq;
        store_tile_bf16<DM>(acc, YF + ((size_t)(bl * SEQ + u.pm * BM + wr * 64 + fr)) * DM + gc0);
    }
};
template <int KIND, int LDC> __device__ __forceinline__ void store_act(const Acc& acc, bf16_t* base, const float* lbp) {
    f32x4 lbv4[2][2];
#pragma unroll
    for (int bj = 0; bj < 2; ++bj)
#pragma unroll
        for (int n = 0; n < 2; ++n) lbv4[bj][n] = (KIND == 4) ? *(const f32x4*)(lbp + bj * HALF + 4 * n) : (f32x4){0.f, 0.f, 0.f, 0.f};
#pragma unroll
    for (int ai = 0; ai < 2; ++ai)
#pragma unroll
        for (int m = 0; m < 4; ++m) { bf16_t* rowp = base + (size_t)(ai * HALF + m * 16) * LDC;
#pragma unroll
            for (int bj = 0; bj < 2; ++bj) { f32x4 v[2] = {acc[ai][bj][m][0], acc[ai][bj][m][1]};
#pragma unroll
                for (int n = 0; n < 2; ++n) { const f32x4 lb = lbv4[bj][n];
#pragma unroll
                    for (int j = 0; j < 4; ++j) { float x = v[n][j];
                        if (KIND == 2) x = silu_f(x);
                        else if (KIND == 3) x = silu_f(x) * 0.08838834764831845f;
                        else if (KIND == 7) x = sigm_f(x);
                        else if (KIND == 4) { const float l = lb[j], e = __expf(-fabsf(x));
                            const float f = (x >= 0.f ? (1.f + l * e) : (e + l)) * __builtin_amdgcn_rcpf(1.f + e); x = fmaxf(__builtin_amdgcn_logf(f), -115.f); }
                        v[n][j] = x; } }
                *(u32x4*)(rowp + bj * HALF) = pack8(v[0], v[1]); }
            EPI_ROW_FENCE; }
}
struct EpiInProj {
    static constexpr bool PERM = true;
    unsigned char* ws; const float* rope; const float* lbv; int tok0;
    __device__ __forceinline__ void operator()(const Acc& acc, const Unit& u, int wr, int wc, int fr, int fq) const {
        const int pn = u.pn;
        const size_t row0 = u.pm * BM + wr * 64 + fr;
        const int cin = wc * 32 + 8 * fq;
        if (pn < 8) {
            const float sc = pn >= 4 ? 0.0625f : 1.0f;
            bf16_t* base = (bf16_t*)(ws + (pn >= 4 ? G_K : G_Q)) + row0 * DM + (pn & 3) * BM + cin;
            const float* rb = rope + ((size_t)(tok0 + row0) * 128 + cin) * 2;
#pragma unroll
            for (int ai = 0; ai < 2; ++ai) {
                f32x4 cs[4][4];
#pragma unroll
                for (int m = 0; m < 4; ++m) { const f32x4* rp = (const f32x4*)(rb + (size_t)(ai * HALF + m * 16) * 256);
#pragma unroll
                    for (int q = 0; q < 4; ++q) cs[m][q] = rp[q]; }
#pragma unroll
                for (int m = 0; m < 4; ++m) { const int ro = ai * HALF + m * 16;
                    f32x4 o1[2], o2[2];
#pragma unroll
                    for (int n = 0; n < 2; ++n) { const f32x4 cs0 = cs[m][2 * n], cs1 = cs[m][2 * n + 1];
                        const f32x4 x1 = acc[ai][0][m][n], x2 = acc[ai][1][m][n];
                        o1[n][0] = (x1[0] * cs0[0] - x2[0] * cs0[1]) * sc; o2[n][0] = (x1[0] * cs0[1] + x2[0] * cs0[0]) * sc;
                        o1[n][1] = (x1[1] * cs0[2] - x2[1] * cs0[3]) * sc; o2[n][1] = (x1[1] * cs0[3] + x2[1] * cs0[2]) * sc;
                        o1[n][2] = (x1[2] * cs1[0] - x2[2] * cs1[1]) * sc; o2[n][2] = (x1[2] * cs1[1] + x2[2] * cs1[0]) * sc;
                        o1[n][3] = (x1[3] * cs1[2] - x2[3] * cs1[3]) * sc; o2[n][3] = (x1[3] * cs1[3] + x2[3] * cs1[2]) * sc; }
                    bf16_t* rowp = base + (size_t)ro * DM;
                    *(u32x4*)rowp = pack8(o1[0], o1[1]);
                    *(u32x4*)(rowp + HALF) = pack8(o2[0], o2[1]); }
                EPI_ROW_FENCE; }
            return;
        }
        if (pn < 24) store_act<2, 2048>(acc, (bf16_t*)(ws + G_SGR) + row0 * 2048 + (pn - 16) * BM + cin, nullptr);
        else if (pn < 28) store_act<3, DM>(acc, (bf16_t*)(ws + G_HQ) + row0 * DM + (pn - 24) * BM + cin, nullptr);
        else if (pn < 32) store_act<4, DM>(acc, (bf16_t*)(ws + G_LFF) + row0 * DM + (pn - 28) * BM + cin, lbv + (pn - 28) * BM + cin);
        else if (pn < 36) store_act<4, DM>(acc, (bf16_t*)(ws + G_LFB) + row0 * DM + (pn - 32) * BM + cin, lbv + 1024 + (pn - 32) * BM + cin);
        else if (pn < 40) store_act<6, DM>(acc, (bf16_t*)(ws + G_HI) + row0 * DM + (pn - 36) * BM + cin, nullptr);
        else if (pn < 44) store_act<2, DM>(acc, (bf16_t*)(ws + G_SGH) + row0 * DM + (pn - 40) * BM + cin, nullptr);
        else if (pn < 48) store_act<6, DM>(acc, (bf16_t*)(ws + G_FU) + row0 * DM + (pn - 44) * BM + cin, nullptr);
        else store_act<7, 3072>(acc, (bf16_t*)(ws + G_GATES) + row0 * 3072 + (pn - 48) * BM + cin, nullptr);
    }
};
}

struct Params {
    const float* x; const int* pos; const float* norm_w; const float* w_in; const float* lb_logits; const float* hgrn_norm_w;
    const float* w_ret_o; const float* w_hgrn_o; const float* w_fnet; const float* w_out; const float* w_up; const float* conv_w; const float* conv_b; const float* w_down;
    float* out; unsigned char* ws; int ph_lo, ph_hi;
};

__device__ __forceinline__ void transpose_item(const float* W, int K, int N, bf16_t* WT, LAS float* scr, int item, int lane) {
    const int nblk = N / 32, kb = item / nblk, nb = item % nblk, k0 = 64 * kb, n0 = 32 * nb;
#pragma unroll 8
    for (int i = 0; i < 32; ++i) { const int kk = 2 * i + (lane >> 5); scr[kk * 33 + (lane & 31)] = W[(size_t)(k0 + kk) * N + n0 + (lane & 31)]; }
    asm volatile("s_waitcnt lgkmcnt(0)" ::: "memory");
    const int c = lane & 7;
#pragma unroll
    for (int j = 0; j < 4; ++j) { const int n = (lane >> 3) + 8 * j; const LAS float* s = scr + (8 * c) * 33 + n;
        u32x4 o; o.x = pk2(s[0 * 33], s[1 * 33]); o.y = pk2(s[2 * 33], s[3 * 33]); o.z = pk2(s[4 * 33], s[5 * 33]); o.w = pk2(s[6 * 33], s[7 * 33]);
        *(u32x4*)(WT + (size_t)(n0 + n) * K + k0 + 8 * c) = o; }
    asm volatile("s_waitcnt lgkmcnt(0)" ::: "memory");
}

__device__ __forceinline__ void prep_weights(const Params& p, int l, LAS unsigned char* lds) {
    const int tid = otid(), lane = tid & 63, wave = tid >> 6;
    LAS float* scr = (LAS float*)(lds + wave * 16384);
    const int gw = obid() * 8 + wave, NGW = ogrid() * 8;
    unsigned char* ws = p.ws;
    constexpr int I_IN = (DM / 64) * (DIN / 32), I_RET = (2048 / 64) * (DM / 32), I_SQ = (DM / 64) * (DM / 32), I_UP = (DM / 64) * (2 * DFF / 32), I_DN = (DFF / 64) * (DM / 32);
    constexpr int NITEMS = I_IN + I_RET + 3 * I_SQ + I_UP + I_DN;
    for (int it = gw; it < NITEMS; it += NGW) {
        int r = it;
        if (r < I_IN) { transpose_item(p.w_in + (size_t)l * DM * DIN, DM, DIN, (bf16_t*)(ws + WS_WIN), scr, r, lane); continue; } r -= I_IN;
        if (r < I_RET) { transpose_item(p.w_ret_o + (size_t)l * 2048 * DM, 2048, DM, (bf16_t*)(ws + WS_WRET), scr, r, lane); continue; } r -= I_RET;
        if (r < I_SQ) { transpose_item(p.w_hgrn_o + (size_t)l * DM * DM, DM, DM, (bf16_t*)(ws + WS_WHG), scr, r, lane); continue; } r -= I_SQ;
        if (r < I_SQ) { transpose_item(p.w_fnet + (size_t)l * DM * DM, DM, DM, (bf16_t*)(ws + WS_WFN), scr, r, lane); continue; } r -= I_SQ;
        if (r < I_SQ) { transpose_item(p.w_out + (size_t)l * DM * DM, DM, DM, (bf16_t*)(ws + WS_WOUT), scr, r, lane); continue; } r -= I_SQ;
        if (r < I_UP) { transpose_item(p.w_up + (size_t)l * DM * 2 * DFF, DM, 2 * DFF, (bf16_t*)(ws + WS_WUP), scr, r, lane); continue; } r -= I_UP;
        transpose_item(p.w_down + (size_t)l * DFF * DM, DFF, DM, (bf16_t*)(ws + WS_WDN), scr, r, lane);
    }
    const int gt = obid() * NTHREADS + tid;
    if (gt < 2 * DM) { const int dir = gt / DM, c = gt % DM;
        float lg[DEPTH], mx = -1e30f;
#pragma unroll
        for (int j = 0; j < DEPTH; ++j) { lg[j] = p.lb_logits[((size_t)dir * DEPTH + j) * DM + c]; mx = fmaxf(mx, lg[j]); }
        float den = 0.f, num = 0.f;
#pragma unroll
        for (int j = 0; j < DEPTH; ++j) { const float e = expf(lg[j] - mx); den += e; if (j >= 1 && j <= l) num += e; }
        ((float*)(ws + WS_LB))[gt] = fmaxf(num / den, 1e-30f); }
}

__device__ __forceinline__ void prep_tables(const Params& p) {
    const int gt = obid() * NTHREADS + otid(), NT = ogrid() * NTHREADS;
    unsigned char* ws = p.ws;
    bf16_t* dseq = (bf16_t*)(ws + WS_DSEQ);
    const float sc1 = 0.02209708691207961f;
    for (int it = gt; it < 2048 * 512; it += NT) { const int sp = it / 512, k0 = (it % 512) * 8;
        unsigned w[4];
#pragma unroll
        for (int h = 0; h < 4; ++h) { float v[2];
#pragma unroll
            for (int q = 0; q < 2; ++q) { const int kc = k0 + 2 * h + q, s = kc & 2047; const int ph = (s * sp) & 2047; const float a = (float)ph * (1.f / 1024.f);
                v[q] = (kc >> 11) ? -sinpif(a) * sc1 : cospif(a) * sc1; }
            w[h] = pk2(v[0], v[1]); }
        *(u32x4*)(dseq + (size_t)sp * 4096 + k0) = (u32x4){w[0], w[1], w[2], w[3]}; }
    bf16_t* cd = (bf16_t*)(ws + WS_CDFT);
    for (int it = gt; it < 512 * 256; it += NT) { const int r = it / 256, c = it % 256, cp = r & 255; const int ph = (c * cp) & 255; const float a = (float)ph * (1.f / 128.f);
        const float v = (r >> 8) ? sinpif(a) : cospif(a); cd[it] = (bf16_t)f2bf(v * 0.0625f); }
    f32x2* rope = (f32x2*)(ws + WS_ROPE);
    for (int it = gt; it < TA * 128; it += NT) { const int tok = it >> 7, i = it & 127;
        const float inv = powf(10000.f, -(float)i * (1.f / 128.f));
        const float ang = (float)p.pos[tok] * inv;
        double t = (double)ang * 0.31830988618379067; t -= 2.0 * rint(t * 0.5); const float tf = (float)t;
        rope[it] = (f32x2){cospif(tf), sinpif(tf)}; }
}

__device__ __forceinline__ void rms_rows(const float* xsrc, const float* w, bf16_t* XN, int nrows) {
    const int tid = otid(), lane = tid & 63, gw = obid() * 8 + (tid >> 6), NGW = ogrid() * 8;
    f32x4 wv[4];
#pragma unroll
    for (int j = 0; j < 4; ++j) wv[j] = ((const f32x4*)w)[lane + 64 * j];
    for (int m = gw; m < nrows; m += NGW) {
        const f32x4* xr = (const f32x4*)(xsrc + (size_t)m * DM); f32x4 v[4]; float ss = 0.f;
#pragma unroll
        for (int j = 0; j < 4; ++j) { v[j] = xr[lane + 64 * j]; ss += (v[j][0] * v[j][0] + v[j][1] * v[j][1]) + (v[j][2] * v[j][2] + v[j][3] * v[j][3]); }
        const float r = rsqrtf(wave_sum(ss, lane) * (1.f / DM) + EPS);
        u32x2* o = (u32x2*)(XN + (size_t)m * DM);
#pragma unroll
        for (int j = 0; j < 4; ++j) { const f32x4 y = v[j] * r * wv[j]; o[lane + 64 * j] = (u32x2){pk2(y[0], y[1]), pk2(y[2], y[3])}; }
    }
}
__device__ __forceinline__ void resid_rows(const bf16_t* V, const float* xsrc, float* out, const float* w1, const float* w2, bf16_t* HN) {
    const int tid = otid(), lane = tid & 63, gw = obid() * 8 + (tid >> 6), NGW = ogrid() * 8;
    for (int m = gw; m < TA; m += NGW) {
        const u32x2* vr = (const u32x2*)(V + (size_t)m * DM); const f32x4* xr = (const f32x4*)(xsrc + (size_t)m * DM); f32x4 v[4]; float ss = 0.f;
#pragma unroll
        for (int j = 0; j < 4; ++j) { const u32x2 vw = vr[lane + 64 * j]; v[j] = (f32x4){bflo(vw.x), bfhi(vw.x), bflo(vw.y), bfhi(vw.y)}; ss += (v[j][0] * v[j][0] + v[j][1] * v[j][1]) + (v[j][2] * v[j][2] + v[j][3] * v[j][3]); }
        const float r = rsqrtf(wave_sum(ss, lane) * (1.f / DM) + EPS); float s2 = 0.f;
#pragma unroll
        for (int j = 0; j < 4; ++j) { v[j] = xr[lane + 64 * j] + v[j] * r * ((const f32x4*)w1)[lane + 64 * j]; ((f32x4*)(out + (size_t)m * DM))[lane + 64 * j] = v[j];
            s2 += (v[j][0] * v[j][0] + v[j][1] * v[j][1]) + (v[j][2] * v[j][2] + v[j][3] * v[j][3]); }
        if (HN) { const float r2 = rsqrtf(wave_sum(s2, lane) * (1.f / DM) + EPS); u32x2* o = (u32x2*)(HN + (size_t)m * DM);
#pragma unroll
            for (int j = 0; j < 4; ++j) { const f32x4 y = v[j] * r2 * ((const f32x4*)w2)[lane + 64 * j]; o[lane + 64 * j] = (u32x2){pk2(y[0], y[1]), pk2(y[2], y[3])}; } }
    }
}

__device__ __forceinline__ float gelu_tanh(float x) { const float y = 0.7978845608028654f * (x + 0.044715f * x * x * x); const float t = 1.f - 2.f * __builtin_amdgcn_rcpf(1.f + __builtin_amdgcn_exp2f(2.8853900817779268f * y)); return 0.5f * x * (1.f + t); }
__device__ __forceinline__ void ld8(const bf16_t* p, float (&v)[8]) { const u32x4 w = *(const u32x4*)p; v[0] = bflo(w.x); v[1] = bfhi(w.x); v[2] = bflo(w.y); v[3] = bfhi(w.y); v[4] = bflo(w.z); v[5] = bfhi(w.z); v[6] = bflo(w.w); v[7] = bfhi(w.w); }
__device__ __forceinline__ void conv_phase(const bf16_t* H, const float* cw, const float* cb, bf16_t* ACT) {
    constexpr int RB = 16, NCH = DFF / 8;
    const int gt = obid() * NTHREADS + otid(), NT = ogrid() * NTHREADS;
    for (int it = gt; it < (TA / RB) * NCH; it += NT) {
        const int ch = it % NCH, rb = it / NCH, c0 = ch * 8, m0 = rb * RB, s0 = m0 % SEQ;
        float wg[3][8], wu[3][8], bg[8], bu[8];
#pragma unroll
        for (int t = 0; t < 3; ++t)
#pragma unroll
            for (int j = 0; j < 8; ++j) { wg[t][j] = cw[(size_t)t * 2 * DFF + c0 + j]; wu[t][j] = cw[(size_t)t * 2 * DFF + DFF + c0 + j]; }
#pragma unroll
        for (int j = 0; j < 8; ++j) { bg[j] = cb[c0 + j]; bu[j] = cb[DFF + c0 + j]; }
        float g0[8], g1[8], g2[8], u0[8], u1[8], u2[8];
        if (s0 > 0) { ld8(H + (size_t)(m0 - 1) * 2 * DFF + c0, g0); ld8(H + (size_t)(m0 - 1) * 2 * DFF + DFF + c0, u0); }
        else {
#pragma unroll
            for (int j = 0; j < 8; ++j) { g0[j] = 0.f; u0[j] = 0.f; } }
        ld8(H + (size_t)m0 * 2 * DFF + c0, g1); ld8(H + (size_t)m0 * 2 * DFF + DFF + c0, u1);
        for (int r = 0; r < RB; ++r) { const int m = m0 + r;
            if (s0 + r + 1 < SEQ) { ld8(H + (size_t)(m + 1) * 2 * DFF + c0, g2); ld8(H + (size_t)(m + 1) * 2 * DFF + DFF + c0, u2); }
            else {
#pragma unroll
                for (int j = 0; j < 8; ++j) { g2[j] = 0.f; u2[j] = 0.f; } }
            float o[8];
#pragma unroll
            for (int j = 0; j < 8; ++j) { const float gg = bg[j] + g0[j] * wg[0][j] + g1[j] * wg[1][j] + g2[j] * wg[2][j]; const float uu = bu[j] + u0[j] * wu[0][j] + u1[j] * wu[1][j] + u2[j] * wu[2][j]; o[j] = gelu_tanh(gg) * uu; }
            *(u32x4*)(ACT + (size_t)m * DFF + c0) = (u32x4){pk2(o[0], o[1]), pk2(o[2], o[3]), pk2(o[4], o[5]), pk2(o[6], o[7])};
#pragma unroll
            for (int j = 0; j < 8; ++j) { g0[j] = g1[j]; g1[j] = g2[j]; u0[j] = u1[j]; u1[j] = u2[j]; }
        }
    }
}

constexpr size_t G_RL = WS_G + 320 * MiB;
static_assert(G_RL + 32 * MiB <= 480 * MiB, "ws");
__device__ __forceinline__ void ret_local(const Params& p, unsigned char* lds, int item) {
    unsigned char* ws = p.ws;
    int tid_ = threadIdx.x; asm volatile("" : "+v"(tid_));
    const int tid = tid_, lane = tid & 63, w = tid >> 6, l15 = lane & 15, quad = lane >> 4;
    const int eq = item & 3, idx = (item >> 2) % 6, bh = (item >> 2) / 6, bl = bh >> 2, h = bh & 3;
    const int dirb = idx >= 3, m = dirb ? idx - 2 : idx;
    const float lg2 = log2f(1.f - exp2f(-5.f - (float)h));
    bf16_t* KT = (bf16_t*)lds;
    bf16_t* VTx = (bf16_t*)(lds + 20480);
    const bf16_t* Kg = (const bf16_t*)(ws + G_K) + ((size_t)(bl * SEQ + m * 512)) * DM + h * 256;
    const bf16_t* VT = (const bf16_t*)(ws + G_VT) + ((size_t)(h * 512 + eq * 128)) * TG + bl * SEQ + m * 512;
    const int kj = tid & 31, kc8 = (tid >> 5) * 8;
    const int ve = tid >> 2, vj8 = (tid & 3) * 8;
    f32x4 af[2][8];
#pragma unroll
    for (int i = 0; i < 2; ++i)
#pragma unroll
        for (int j = 0; j < 8; ++j) af[i][j] = (f32x4){0.f, 0.f, 0.f, 0.f};
    u32x4 kr0[2], kr1[2], kr2[2], kr3[2], vr0, vr1, vr2, vr3;
#define RL_LOAD(s, KR, VR) do { const int s_ = (s) < 16 ? (s) : 15; \
        _Pragma("unroll") for (int i = 0; i < 2; ++i) KR[i] = *(const u32x4*)(Kg + (size_t)(32 * s_ + kj) * DM + kc8 + 128 * i); \
        VR = *(const u32x4*)(VT + (size_t)ve * TG + 32 * s_ + vj8); } while (0)
    RL_LOAD(0, kr0, vr0); RL_LOAD(1, kr1, vr1); RL_LOAD(2, kr2, vr2);
    const int et0 = 2 * (w & 3), dt0 = 8 * (w >> 2);
    __syncthreads();
#define RL_STEP(s, KR, VR, KN, VN) do { \
        _Pragma("unroll") for (int i = 0; i < 2; ++i) { const int j = kj, c0 = kc8 + 128 * i; const unsigned wv[4] = {KR[i].x, KR[i].y, KR[i].z, KR[i].w}; \
            _Pragma("unroll") for (int q = 0; q < 4; ++q) { KT[(c0 + 2 * q) * 40 + j] = (bf16_t)(wv[q] & 0xffffu); KT[(c0 + 2 * q + 1) * 40 + j] = (bf16_t)(wv[q] >> 16); } } \
        { const unsigned wv[4] = {VR.x, VR.y, VR.z, VR.w}; unsigned ov[4]; \
          _Pragma("unroll") for (int q = 0; q < 4; ++q) { const int jj = 32 * (s) + vj8 + 2 * q; const float v0 = bflo(wv[q]), v1 = bfhi(wv[q]); \
              const float e0 = dirb ? (float)jj : (float)(511 - jj), e1 = dirb ? (float)(jj + 1) : (float)(510 - jj); \
              ov[q] = cvtpk(v0 * __builtin_amdgcn_exp2f(lg2 * e0), v1 * __builtin_amdgcn_exp2f(lg2 * e1)); } \
          *(u32x4*)(VTx + ve * 40 + vj8) = (u32x4){ov[0], ov[1], ov[2], ov[3]}; } \
        __syncthreads(); \
        RL_LOAD((s) + 3, KN, VN); \
        bf16x8 a0[2]; \
        _Pragma("unroll") for (int i = 0; i < 2; ++i) a0[i] = *(const bf16x8*)(VTx + (16 * (et0 + i) + l15) * 40 + quad * 8); \
        _Pragma("unroll") for (int j = 0; j < 8; ++j) { const bf16x8 b = *(const bf16x8*)(KT + (16 * (dt0 + j) + l15) * 40 + quad * 8); \
            _Pragma("unroll") for (int i = 0; i < 2; ++i) af[i][j] = mfma16(b, a0[i], af[i][j]); }       \
        __syncthreads(); } while (0)
    for (int s = 0; s < 16; s += 4) { RL_STEP(s, kr0, vr0, kr3, vr3); RL_STEP(s + 1, kr1, vr1, kr0, vr0); RL_STEP(s + 2, kr2, vr2, kr1, vr1); RL_STEP(s + 3, kr3, vr3, kr2, vr2); }
#undef RL_LOAD
#undef RL_STEP
    bf16_t* L = (bf16_t*)(ws + G_RL) + ((size_t)((bh * 4 + m) * 2 + dirb) * 512 + eq * 128) * 256;
#pragma unroll
    for (int i = 0; i < 2; ++i)
#pragma unroll
        for (int j = 0; j < 8; ++j)
            *(u32x2*)(L + (size_t)(16 * (et0 + i) + l15) * 256 + 16 * (dt0 + j) + 4 * quad) = (u32x2){cvtpk(af[i][j][0], af[i][j][1]), cvtpk(af[i][j][2], af[i][j][3])};
}

__device__ __forceinline__ void ret_item(const Params& p, unsigned char* lds, int item) {
    unsigned char* ws = p.ws;
    int tid_ = threadIdx.x; asm volatile("" : "+v"(tid_));
    const int tid = tid_, lane = tid & 63, w = tid >> 6, l15 = lane & 15, quad = lane >> 4;
    const int bh = item >> 5, bl = bh >> 2, h = bh & 3, qt = item & 31, cq = qt >> 3, kt0 = 8 * cq;
    const float lg2 = log2f(1.f - exp2f(-5.f - (float)h));
    bf16_t* Ks = (bf16_t*)lds;
    bf16_t* Ps = (bf16_t*)(lds + 67584);
    float* red = (float*)(lds + 86016);
    float* rstd = (float*)(lds + 88064);
    const bf16_t* Q = (const bf16_t*)(ws + G_Q) + ((size_t)(bl * SEQ + qt * 64)) * DM + h * 256;
    const bf16_t* Kg = (const bf16_t*)(ws + G_K) + ((size_t)(bl * SEQ)) * DM + h * 256;
    const bf16_t* VTw = (const bf16_t*)(ws + G_VT) + ((size_t)(h * 512 + 64 * w + l15)) * TG + bl * SEQ + quad * 16;
    const bf16_t* Lw = (const bf16_t*)(ws + G_RL) + ((size_t)(bh * 4) * 2 * 512 + 64 * w + l15) * 256 + quad * 16;
    const int ti = w >> 1, tj0 = (w & 1) * 2;
    bf16_t* Qs = (bf16_t*)(lds + 88320);
    const int kr = tid >> 5, kc = (tid & 31) * 8;
    const int prow = tid >> 3, pc8 = (tid & 7) * 8;
    const int pos = (qt & 7) * 64 + prow;
    u32x4 kreg[4], VA[8], VB[8], VC[8];
#define RET_LOADV(g, V) do { if ((g) < 8) { const bf16_t* s_ = VTw + (kt0 + (g)) * 64; \
            _Pragma("unroll") for (int j = 0; j < 4; ++j) _Pragma("unroll") for (int kk = 0; kk < 2; ++kk) V[j * 2 + kk] = *(const u32x4*)(s_ + (size_t)(16 * j) * TG + kk * 8); } \
        else if ((g) < 20) { const int st_ = (g) - 8, mi_ = st_ >> 2, m_ = mi_ + (mi_ >= cq ? 1 : 0), ds_ = st_ & 3; \
            const bf16_t* s_ = Lw + ((size_t)(m_ * 2 + (m_ < cq ? 0 : 1)) * 512) * 256 + ds_ * 64; \
            _Pragma("unroll") for (int j = 0; j < 4; ++j) _Pragma("unroll") for (int kk = 0; kk < 2; ++kk) V[j * 2 + kk] = *(const u32x4*)(s_ + (size_t)(16 * j) * 256 + kk * 8); } } while (0)
#define RET_PV(Pw, V) do { _Pragma("unroll") for (int kk = 0; kk < 2; ++kk) { bf16x8 a[4]; \
            _Pragma("unroll") for (int i = 0; i < 4; ++i) a[i] = *(const bf16x8*)((Pw) + (16 * i + l15) * 72 + quad * 16 + kk * 8); \
            _Pragma("unroll") for (int i = 0; i < 4; ++i) _Pragma("unroll") for (int j = 0; j < 4; ++j) o[i][j] = mfma16(__builtin_bit_cast(bf16x8, V[j * 2 + kk]), a[i], o[i][j]); } } while (0)
#define RET_TILE(g, VCU, VN) do { const int kt = kt0 + (g); const bf16_t* Kc = Ks + ((g) & 1) * (64 * 264); bf16_t* Pw = Ps + ((g) & 1) * (64 * 72); \
        f32x4 s0 = {0.f, 0.f, 0.f, 0.f}, s1 = {0.f, 0.f, 0.f, 0.f}; \
        _Pragma("unroll") for (int ks = 0; ks < 8; ++ks) { \
            const bf16x8 b0 = *(const bf16x8*)(Kc + (16 * tj0 + l15) * 264 + ks * 32 + quad * 8); \
            const bf16x8 b1 = *(const bf16x8*)(Kc + (16 * (tj0 + 1) + l15) * 264 + ks * 32 + quad * 8); \
            const bf16x8 qa = *(const bf16x8*)(Qs + (16 * ti + l15) * 264 + ks * 32 + quad * 8); \
            s0 = mfma16(qa, b0, s0); s1 = mfma16(qa, b1, s1); } \
        _Pragma("unroll") for (int r = 0; r < 4; ++r) { const int row = 16 * ti + 4 * quad + r, qpos = qt * 64 + row; \
            const int c0 = 16 * tj0 + l15, c1 = c0 + 16; \
            const float d0 = fabsf((float)(qpos - (kt * 64 + c0))), d1 = fabsf((float)(qpos - (kt * 64 + c1))); \
            Pw[row * 72 + c0] = (bf16_t)cvtpk(s0[r] * __builtin_amdgcn_exp2f(lg2 * d0), 0.f); \
            Pw[row * 72 + c1] = (bf16_t)cvtpk(s1[r] * __builtin_amdgcn_exp2f(lg2 * d1), 0.f); } \
        if ((g) + 1 < 8) { bf16_t* Kn = Ks + (((g) + 1) & 1) * (64 * 264); \
            _Pragma("unroll") for (int i = 0; i < 4; ++i) *(u32x4*)(Kn + (kr + 16 * i) * 264 + kc) = kreg[i]; } \
        __syncthreads(); \
        RET_LOADV((g) + 2, VN); \
        if ((g) + 2 < 8) { _Pragma("unroll") for (int i = 0; i < 4; ++i) kreg[i] = *(const u32x4*)(Kg + (size_t)((kt + 2) * 64 + kr + 16 * i) * DM + kc); } \
        RET_PV(Pw, VCU); } while (0)
#define RET_STATE(g, VCU, VN) do { bf16_t* Pw = Ps + ((g) & 1) * (64 * 72); \
        { const int mi = ((g) - 8) >> 2, m = mi + (mi >= cq ? 1 : 0); \
          const float ex = (m < cq) ? (float)(pos + 1 + (cq - 1 - m) * 512) : (float)(512 - pos + (m - cq - 1) * 512); \
          const float rs = __builtin_amdgcn_exp2f(lg2 * ex); const u32x4 qreg = *(const u32x4*)(Qs + prow * 264 + (((g) - 8) & 3) * 64 + pc8); \
          *(u32x4*)(Pw + prow * 72 + pc8) = (u32x4){cvtpk(bflo(qreg.x) * rs, bfhi(qreg.x) * rs), cvtpk(bflo(qreg.y) * rs, bfhi(qreg.y) * rs), cvtpk(bflo(qreg.z) * rs, bfhi(qreg.z) * rs), cvtpk(bflo(qreg.w) * rs, bfhi(qreg.w) * rs)}; } \
        __syncthreads(); \
        RET_LOADV((g) + 2, VN); \
        RET_PV(Pw, VCU); } while (0)
    __syncthreads();
#pragma unroll
    for (int i = 0; i < 4; ++i) { *(u32x4*)(Ks + (kr + 16 * i) * 264 + kc) = *(const u32x4*)(Kg + (size_t)(kt0 * 64 + kr + 16 * i) * DM + kc);
        *(u32x4*)(Qs + (kr + 16 * i) * 264 + kc) = *(const u32x4*)(Q + (size_t)(kr + 16 * i) * DM + kc); }
    RET_LOADV(0, VA); RET_LOADV(1, VB);
#pragma unroll
    for (int i = 0; i < 4; ++i) kreg[i] = *(const u32x4*)(Kg + (size_t)((kt0 + 1) * 64 + kr + 16 * i) * DM + kc);
    f32x4 o[4][4];
#pragma unroll
    for (int i = 0; i < 4; ++i)
#pragma unroll
        for (int j = 0; j < 4; ++j) o[i][j] = (f32x4){0.f, 0.f, 0.f, 0.f};
    __syncthreads();
#define RET_STEP(g, VCUR, VNXT) do { if ((g) < 8) RET_TILE(g, VCUR, VNXT); else if ((g) < 20) RET_STATE(g, VCUR, VNXT); } while (0)
    for (int g = 0; g < 21; g += 3) { RET_STEP(g, VA, VC); RET_STEP(g + 1, VB, VA); RET_STEP(g + 2, VC, VB); }
#undef RET_STEP
#undef RET_LOADV
#undef RET_PV
#undef RET_TILE
#undef RET_STATE
#pragma unroll
    for (int i = 0; i < 4; ++i) { float s = 0.f;
#pragma unroll
        for (int j = 0; j < 4; ++j)
#pragma unroll
            for (int r = 0; r < 4; ++r) s += o[i][j][r] * o[i][j][r];
        s += shx(s, 16, lane); s += shx(s, 32, lane);
        if (quad == 0) red[w * 64 + 16 * i + l15] = s; }
    __syncthreads();
    if (tid < 64) { float s = 0.f;
#pragma unroll
        for (int ww = 0; ww < 8; ++ww) s += red[ww * 64 + tid];
        rstd[tid] = rsqrtf(s * (1.f / 512.f) + EPS); }
    __syncthreads();
    bf16_t* RO = (bf16_t*)(ws + G_SGR) + ((size_t)(bl * SEQ + qt * 64)) * 2048 + h * 512 + 64 * w + 4 * quad;
    u32x2 gv[4][4];
#pragma unroll
    for (int i = 0; i < 4; ++i)
#pragma unroll
        for (int j = 0; j < 4; ++j) gv[i][j] = *(const u32x2*)(RO + (size_t)(16 * i + l15) * 2048 + 16 * j);
#pragma unroll
    for (int i = 0; i < 4; ++i) { const float rs = rstd[16 * i + l15];
#pragma unroll
        for (int j = 0; j < 4; ++j) { const f32x4 v = o[i][j] * rs;
            *(u32x2*)(RO + (size_t)(16 * i + l15) * 2048 + 16 * j) = (u32x2){cvtpk(v[0] * bflo(gv[i][j].x), v[1] * bfhi(gv[i][j].x)), cvtpk(v[2] * bflo(gv[i][j].y), v[3] * bfhi(gv[i][j].y))}; } }
}

struct HgRaw { unsigned q[8], l[8]; u32x4 v0, v1; };
__device__ __forceinline__ void hgrn_load(HgRaw& R, const bf16_t* HQ, const bf16_t* LF, const bf16_t* HI, int c, int dir, int d2, int tg, int vt, int veg) {
#pragma unroll
    for (int i = 0; i < 8; ++i) { const int tau = 32 * c + 8 * tg + i, s = dir ? (SEQ - 1 - tau) : tau; R.q[i] = *(const unsigned*)(HQ + (size_t)s * DM + 2 * d2); R.l[i] = *(const unsigned*)(LF + (size_t)s * DM + 2 * d2); }
    { const int tau = 32 * c + vt, s = dir ? (SEQ - 1 - tau) : tau; R.v0 = *(const u32x4*)(HI + (size_t)s * DM + veg * 16); R.v1 = *(const u32x4*)(HI + (size_t)s * DM + veg * 16 + 8); }
}
__device__ __forceinline__ void hgrn_prep(const HgRaw& R, bf16_t* Qe, bf16_t* Ke, bf16_t* KdT, float* decs, bf16_t* VTs, int d2, int tg, int vt, int veg, int lane) {
    float b0[8], b1[8], l0[8], l1[8]; float run0 = 0.f, run1 = 0.f;
#pragma unroll
    for (int i = 0; i < 8; ++i) { l0[i] = bflo(R.l[i]); l1[i] = bfhi(R.l[i]); run0 += l0[i]; run1 += l1[i]; b0[i] = run0; b1[i] = run1; }
    float pre0, pre1, bl0, bl1;
    { const float r1 = shx(run0, 1, lane), s2 = run0 + r1, s2x = shx(s2, 2, lane); bl0 = s2 + s2x; pre0 = ((tg & 1) ? r1 : 0.f) + ((tg & 2) ? s2x : 0.f); }
    { const float r1 = shx(run1, 1, lane), s2 = run1 + r1, s2x = shx(s2, 2, lane); bl1 = s2 + s2x; pre1 = ((tg & 1) ? r1 : 0.f) + ((tg & 2) ? s2x : 0.f); }
    const float c30 = __builtin_amdgcn_exp2f(bl0), c31 = __builtin_amdgcn_exp2f(bl1);
    float kd0[8], kd1[8];
#pragma unroll
    for (int i = 0; i < 8; ++i) { const int t = 8 * tg + i;
        const float bb0 = b0[i] + pre0, bb1 = b1[i] + pre1;
        const float k0 = 1.f - __builtin_amdgcn_exp2f(l0[i]), k1 = 1.f - __builtin_amdgcn_exp2f(l1[i]);
        const float ke0 = k0 * __builtin_amdgcn_exp2f(fminf(-bb0, 115.f)), ke1 = k1 * __builtin_amdgcn_exp2f(fminf(-bb1, 115.f));
        *(unsigned*)(Qe + t * 136 + 2 * d2) = cvtpk(bflo(R.q[i]) * __builtin_amdgcn_exp2f(bb0), bfhi(R.q[i]) * __builtin_amdgcn_exp2f(bb1));
        *(unsigned*)(Ke + t * 136 + 2 * d2) = cvtpk(ke0, ke1);
        kd0[i] = ke0 * c30; kd1[i] = ke1 * c31;
        if (__builtin_expect(!(bl0 > -86.f && bl1 > -86.f), 0)) { kd0[i] = k0 * __builtin_amdgcn_exp2f(bl0 - bb0); kd1[i] = k1 * __builtin_amdgcn_exp2f(bl1 - bb1); } }
    *(u32x4*)(KdT + (2 * d2) * 40 + 8 * tg) = (u32x4){cvtpk(kd0[0], kd0[1]), cvtpk(kd0[2], kd0[3]), cvtpk(kd0[4], kd0[5]), cvtpk(kd0[6], kd0[7])};
    *(u32x4*)(KdT + (2 * d2 + 1) * 40 + 8 * tg) = (u32x4){cvtpk(kd1[0], kd1[1]), cvtpk(kd1[2], kd1[3]), cvtpk(kd1[4], kd1[5]), cvtpk(kd1[6], kd1[7])};
    if (tg == 0) { decs[2 * d2] = c30; decs[2 * d2 + 1] = c31; }
    { const unsigned wv[8] = {R.v0.x, R.v0.y, R.v0.z, R.v0.w, R.v1.x, R.v1.y, R.v1.z, R.v1.w};
#pragma unroll
      for (int q = 0; q < 8; ++q) { VTs[(16 * veg + 2 * q) * 40 + vt] = (bf16_t)(wv[q] & 0xffffu); VTs[(16 * veg + 2 * q + 1) * 40 + vt] = (bf16_t)(wv[q] >> 16); } }
}
__device__ __forceinline__ void hgrn_item(const Params& p, unsigned char* lds, int item) {
    unsigned char* ws = p.ws;
    int tid_ = threadIdx.x; asm volatile("" : "+v"(tid_));
    const int tid = tid_, lane = tid & 63, w = tid >> 6, l15 = lane & 15, quad = lane >> 4;
    const int dir = item & 1, h = (item >> 1) & 7, bl = item >> 4;
    bf16_t* Qe2 = (bf16_t*)lds;
    bf16_t* Ke2 = (bf16_t*)(lds + 17408);
    bf16_t* KdT2 = (bf16_t*)(lds + 34816);
    bf16_t* VTs2 = (bf16_t*)(lds + 55296);
    float* decs2 = (float*)(lds + 75776);
    bf16_t* Ps = (bf16_t*)(lds + 76800);
    bf16_t* StT = (bf16_t*)(lds + 79360);
    const bf16_t* HQ = (const bf16_t*)(ws + G_HQ) + (size_t)bl * SEQ * DM + h * 128;
    const bf16_t* LF = (const bf16_t*)(ws + (dir ? G_LFB : G_LFF)) + (size_t)bl * SEQ * DM + h * 128;
    const bf16_t* HI = (const bf16_t*)(ws + G_HI) + (size_t)bl * SEQ * DM + h * 128;
    bf16_t* HO = (bf16_t*)(ws + (dir ? G_HOB : G_HOF)) + (size_t)bl * SEQ * DM + h * 128;
    __syncthreads();
    for (int i = tid; i < 128 * 136 / 2; i += NTHREADS) ((unsigned*)StT)[i] = 0u;
    if (w < 4) {
        const int d2 = tid >> 2, tg = tid & 3, vt = tid & 31, veg = tid >> 5;
        HgRaw RA, RB;
        hgrn_load(RA, HQ, LF, HI, 0, dir, d2, tg, vt, veg);
        hgrn_load(RB, HQ, LF, HI, 1, dir, d2, tg, vt, veg);
        hgrn_prep(RA, Qe2, Ke2, KdT2, decs2, VTs2, d2, tg, vt, veg, lane);
        __syncthreads();
#define HG_PROD(c, RP, RL) do { \
            if ((c) + 2 < 64) hgrn_load(RL, HQ, LF, HI, (c) + 2, dir, d2, tg, vt, veg); \
            if ((c) + 1 < 64) { const int pb = ((c) + 1) & 1; \
                hgrn_prep(RP, Qe2 + pb * (32 * 136), Ke2 + pb * (32 * 136), KdT2 + pb * (128 * 40), decs2 + pb * 128, VTs2 + pb * (128 * 40), d2, tg, vt, veg, lane); } \
            __syncthreads(); __syncthreads(); } while (0)
        for (int c = 0; c < 64; c += 2) { HG_PROD(c, RB, RA); HG_PROD(c + 1, RA, RB); }
#undef HG_PROD
    } else {
        const int cw = w - 4;
        const int oti = cw >> 1, otj = cw & 1;
        f32x4 st[2][8];
#pragma unroll
        for (int dj = 0; dj < 2; ++dj)
#pragma unroll
            for (int j = 0; j < 8; ++j) st[dj][j] = (f32x4){0.f, 0.f, 0.f, 0.f};
        __syncthreads();
        for (int c = 0; c < 64; ++c) {
            const int pb = c & 1;
            const bf16_t* Qe = Qe2 + pb * (32 * 136); const bf16_t* Ke = Ke2 + pb * (32 * 136); const bf16_t* KdT = KdT2 + pb * (128 * 40);
            const bf16_t* VTs = VTs2 + pb * (128 * 40); const float* decs = decs2 + pb * 128;
            f32x4 ao[2][2];
#pragma unroll
            for (int ej = 0; ej < 2; ++ej)
#pragma unroll
                for (int ti = 0; ti < 2; ++ti) ao[ej][ti] = (f32x4){0.f, 0.f, 0.f, 0.f};
#pragma unroll
            for (int ks = 0; ks < 4; ++ks) { bf16x8 sf[2], qf2[2];
#pragma unroll
                for (int ej = 0; ej < 2; ++ej) sf[ej] = *(const bf16x8*)(StT + (16 * (2 * cw + ej) + l15) * 136 + ks * 32 + quad * 8);
#pragma unroll
                for (int ti = 0; ti < 2; ++ti) qf2[ti] = *(const bf16x8*)(Qe + (16 * ti + l15) * 136 + ks * 32 + quad * 8);
#pragma unroll
                for (int ej = 0; ej < 2; ++ej)
#pragma unroll
                    for (int ti = 0; ti < 2; ++ti) ao[ej][ti] = mfma16(sf[ej], qf2[ti], ao[ej][ti]); }
            { f32x4 acc = {0.f, 0.f, 0.f, 0.f};
#pragma unroll
              for (int ks = 0; ks < 4; ++ks) { const bf16x8 a = *(const bf16x8*)(Qe + (16 * oti + l15) * 136 + ks * 32 + quad * 8); const bf16x8 bb = *(const bf16x8*)(Ke + (16 * otj + l15) * 136 + ks * 32 + quad * 8); acc = mfma16(bb, a, acc); }
              const int t = 16 * oti + l15, s0 = 16 * otj + 4 * quad;
              *(u32x2*)(Ps + t * 40 + s0) = (u32x2){cvtpk(s0 <= t ? acc[0] : 0.f, s0 + 1 <= t ? acc[1] : 0.f), cvtpk(s0 + 2 <= t ? acc[2] : 0.f, s0 + 3 <= t ? acc[3] : 0.f)}; }
            { bf16x8 kf[2]; f32x4 dc[2];
#pragma unroll
              for (int dj = 0; dj < 2; ++dj) { kf[dj] = *(const bf16x8*)(KdT + (16 * (2 * cw + dj) + l15) * 40 + quad * 8); dc[dj] = *(const f32x4*)(decs + 16 * (2 * cw + dj) + 4 * quad); }
#pragma unroll
              for (int j = 0; j < 8; ++j) { const bf16x8 vf = *(const bf16x8*)(VTs + (16 * j + l15) * 40 + quad * 8);
#pragma unroll
                  for (int dj = 0; dj < 2; ++dj) st[dj][j] = mfma16(kf[dj], vf, st[dj][j] * dc[dj]); } }
            __syncthreads();
            { bf16x8 pf[2];
#pragma unroll
              for (int ti = 0; ti < 2; ++ti) pf[ti] = *(const bf16x8*)(Ps + (16 * ti + l15) * 40 + quad * 8);
#pragma unroll
              for (int ej = 0; ej < 2; ++ej) { const bf16x8 vf = *(const bf16x8*)(VTs + (16 * (2 * cw + ej) + l15) * 40 + quad * 8);
#pragma unroll
                  for (int ti = 0; ti < 2; ++ti) { ao[ej][ti] = mfma16(vf, pf[ti], ao[ej][ti]);
                      const int tau = 32 * c + 16 * ti + l15, s = dir ? (SEQ - 1 - tau) : tau;
                      *(u32x2*)(HO + (size_t)s * DM + 16 * (2 * cw + ej) + 4 * quad) = (u32x2){cvtpk(ao[ej][ti][0], ao[ej][ti][1]), cvtpk(ao[ej][ti][2], ao[ej][ti][3])}; } } }
#pragma unroll
            for (int dj = 0; dj < 2; ++dj)
#pragma unroll
                for (int j = 0; j < 8; ++j)
                    *(u32x2*)(StT + (16 * j + l15) * 136 + 16 * (2 * cw + dj) + 4 * quad) = (u32x2){cvtpk(st[dj][j][0], st[dj][j][1]), cvtpk(st[dj][j][2], st[dj][j][3])};
            __syncthreads();
        }
    }
}

__device__ __forceinline__ void seq_combine(const bf16_t* OZ, const bf16_t* PQT, bf16_t* YF) {
    constexpr int LD = NB * 1024;
    const int tid = otid(), gt = obid() * NTHREADS + tid, NT = ogrid() * NTHREADS;
    for (int it = gt; it < 1024 * LD / 8; it += NT) { const int sp = it / (LD / 8), n0 = (it % (LD / 8)) * 8, bl = n0 >> 10, gc = n0 & 1023;
        float av[8], bv[8]; ld8(OZ + (size_t)sp * LD + n0, av); ld8(OZ + (size_t)(1024 + sp) * LD + n0, bv);
        const f32x4 a0 = {av[0], av[1], av[2], av[3]}, a1 = {av[4], av[5], av[6], av[7]}, b0 = {bv[0], bv[1], bv[2], bv[3]}, b1 = {bv[4], bv[5], bv[6], bv[7]};
        *(u32x4*)(YF + ((size_t)(bl * SEQ + sp)) * DM + gc) = (u32x4){pk2(a0[0] + b0[0], a0[1] + b0[1]), pk2(a0[2] + b0[2], a0[3] + b0[3]), pk2(a1[0] + b1[0], a1[1] + b1[1]), pk2(a1[2] + b1[2], a1[3] + b1[3])};
        if (sp > 0) *(u32x4*)(YF + ((size_t)(bl * SEQ + SEQ - sp)) * DM + gc) = (u32x4){pk2(a0[0] - b0[0], a0[1] - b0[1]), pk2(a0[2] - b0[2], a0[3] - b0[3]), pk2(a1[0] - b1[0], a1[1] - b1[1]), pk2(a1[2] - b1[2], a1[3] - b1[3])}; }
    const int lane = tid & 63, gw = obid() * 8 + (tid >> 6), NGW = ogrid() * 8;
    for (int n = gw; n < LD; n += NGW) { const bf16_t* pr = PQT + (size_t)n * 4096 + lane * 32; float s = 0.f;
#pragma unroll
        for (int q = 0; q < 4; ++q) { float v[8]; ld8(pr + 8 * q, v); s += (v[0] - v[1]) + (v[2] - v[3]) + (v[4] - v[5]) + (v[6] - v[7]); }
        s = wave_sum(s, lane);
        if (lane == 0) YF[((size_t)((n >> 10) * SEQ + 1024)) * DM + (n & 1023)] = (bf16_t)f2bf(s * 0.02209708691207961f); }
}

__device__ __forceinline__ void mix_combine(const bf16_t* F1, const bf16_t* F2, bf16_t* MIX, int rank, int nblk) {
    const int gt = rank * NTHREADS + otid(), NT = nblk * NTHREADS;
    for (int it = gt; it < TG * DM / 8; it += NT) { const size_t o = (size_t)it * 8; float a[8], b[8]; ld8(F1 + o, a); ld8(F2 + o, b);
        *(u32x4*)(MIX + o) = (u32x4){pk2(a[0] + b[0], a[1] + b[1]), pk2(a[2] + b[2], a[3] + b[3]), pk2(a[4] + b[4], a[5] + b[5]), pk2(a[6] + b[6], a[7] + b[7])}; }
}

__device__ __forceinline__ void hgrn_combine(const Params& p, int l) {
    unsigned char* ws = p.ws;
    const int tid = otid(), lane = tid & 63, gw = obid() * 8 + (tid >> 6), NGW = ogrid() * 8;
    const bf16_t* HOF = (const bf16_t*)(ws + G_HOF); const bf16_t* HOB = (const bf16_t*)(ws + G_HOB); bf16_t* SG = (bf16_t*)(ws + G_SGH);
    const float* nw = p.hgrn_norm_w + (size_t)l * 128;
    float nwv[2][8];
#pragma unroll
    for (int i = 0; i < 2; ++i)
#pragma unroll
        for (int j = 0; j < 8; ++j) nwv[i][j] = nw[(((lane + 64 * i) * 8) & 127) + j];
    for (int m0 = gw; m0 < TG; m0 += 2 * NGW) {
        u32x4 av[2][2], bv[2][2], gv[2][2];
#pragma unroll
        for (int r = 0; r < 2; ++r) { const int m = m0 + r * NGW;
#pragma unroll
            for (int i = 0; i < 2; ++i) { const size_t o = (size_t)m * DM + (lane + 64 * i) * 8;
                if (m < TG) { av[r][i] = *(const u32x4*)(HOF + o); bv[r][i] = *(const u32x4*)(HOB + o); gv[r][i] = *(const u32x4*)(SG + o); } } }
#pragma unroll
        for (int r = 0; r < 2; ++r) { const int m = m0 + r * NGW;
            if (m < TG) {
#pragma unroll
                for (int i = 0; i < 2; ++i) { const size_t o = (size_t)m * DM + (lane + 64 * i) * 8;
                    const unsigned aw[4] = {av[r][i].x, av[r][i].y, av[r][i].z, av[r][i].w}, bw[4] = {bv[r][i].x, bv[r][i].y, bv[r][i].z, bv[r][i].w}, gw4[4] = {gv[r][i].x, gv[r][i].y, gv[r][i].z, gv[r][i].w};
                    float a[8]; float ss = 0.f;
#pragma unroll
                    for (int q = 0; q < 4; ++q) { a[2 * q] = bflo(aw[q]) + bflo(bw[q]); a[2 * q + 1] = bfhi(aw[q]) + bfhi(bw[q]); ss += a[2 * q] * a[2 * q] + a[2 * q + 1] * a[2 * q + 1]; }
                    ss += shx(ss, 1, lane); ss += shx(ss, 2, lane); ss += shx(ss, 4, lane); ss += shx(ss, 8, lane);
                    const float rr = rsqrtf(ss * (1.f / 128.f) + EPS); unsigned ow[4];
#pragma unroll
                    for (int q = 0; q < 4; ++q) ow[q] = pk2(a[2 * q] * rr * nwv[i][2 * q] * bflo(gw4[q]), a[2 * q + 1] * rr * nwv[i][2 * q + 1] * bfhi(gw4[q]));
                    *(u32x4*)(SG + o) = (u32x4){ow[0], ow[1], ow[2], ow[3]}; } } }
    }
}

#define XB_TMO      128
#define XB_XCNT(j)  (256  + 64 * (j))
#define XB_XSUB(j)  (1280 + 64 * (j))
#define XB_XGEN(j)  (2304 + 64 * (j))
#define XB_TOP      3328
#define XB_TOPGEN   3392
#define XCD_BAR_WORDS 3456
#define XB_SPIN_CAP (1u << 22)
__device__ __forceinline__ unsigned xb_ld(unsigned* p)              { return __hip_atomic_load(p, __ATOMIC_RELAXED, __HIP_MEMORY_SCOPE_AGENT); }
__device__ __forceinline__ unsigned xb_add(unsigned* p, unsigned v) { return __hip_atomic_fetch_add(p, v, __ATOMIC_RELAXED, __HIP_MEMORY_SCOPE_AGENT); }
__device__ __forceinline__ unsigned xb_xcc_id() { return (unsigned)__builtin_amdgcn_s_getreg((3 << 11) | 20) & 0xFu; }
#define XB_SPIN(cond, bar) do { unsigned _sp = 0; while (cond) { __builtin_amdgcn_s_sleep(1); \
    if ((++_sp & 255u) == 0u) { if (xb_ld(&(bar)[XB_TMO])) break; if (_sp > XB_SPIN_CAP) { atomicAdd(&(bar)[XB_TMO], 1u); break; } } } } while (0)
__device__ __forceinline__ void xcd_barrier_complete(unsigned* bar, unsigned x, unsigned G, unsigned& nloc, unsigned& nx) {
    unsigned sum, cnt, mine, sp = 0u;
    for (;;) {
        sum = 0u; cnt = 0u; mine = 0u;
#pragma unroll
        for (unsigned j = 0; j < 16; ++j) { const unsigned c = xb_ld(&bar[XB_XCNT(j)]); sum += c; cnt += (c > 0u) ? 1u : 0u; mine = (j == x) ? c : mine; }
        if (sum == G) break;
        __builtin_amdgcn_s_sleep(1);
        if ((++sp & 255u) == 0u) { if (xb_ld(&bar[XB_TMO])) break; if (sp > XB_SPIN_CAP) { atomicAdd(&bar[XB_TMO], 1u); break; } }
    }
    nloc = mine > 0u ? mine : 1u; nx = cnt > 0u ? cnt : 1u;
}
__device__ __forceinline__ void xcd_barrier(unsigned* bar, volatile LAS unsigned* st, unsigned nparts) {
    asm volatile("s_waitcnt vmcnt(0)" ::: "memory");
    __syncthreads();
    if (threadIdx.x == 0) {
        const unsigned x = xb_xcc_id();
        __builtin_amdgcn_s_waitcnt(0);
        unsigned nloc = st[0], nx = st[1];
        if (nloc == 0u) { xcd_barrier_complete(bar, x, nparts, nloc, nx); st[0] = nloc; st[1] = nx; }
        const unsigned old = xb_add(&bar[XB_XSUB(x)], 1u);
        const unsigned gen = old / nloc;
        if (old + 1u == (gen + 1u) * nloc) {
            __builtin_amdgcn_fence(__ATOMIC_RELEASE, "agent");
            asm volatile("s_waitcnt vmcnt(0)" ::: "memory");
            const unsigned og = xb_add(&bar[XB_TOP], 1u);
            const unsigned tg = og / nx;
            if (og + 1u == (tg + 1u) * nx) xb_add(&bar[XB_TOPGEN], 1u);
            else XB_SPIN(xb_ld(&bar[XB_TOPGEN]) == tg, bar);
            __builtin_amdgcn_fence(__ATOMIC_ACQUIRE, "agent");
            xb_add(&bar[XB_XGEN(x)], 1u);
            asm volatile("s_waitcnt vmcnt(0)" ::: "memory");
        } else {
            XB_SPIN(xb_ld(&bar[XB_XGEN(x)]) == gen, bar);
            __builtin_amdgcn_fence(__ATOMIC_ACQUIRE, "agent");
            asm volatile("s_waitcnt vmcnt(0)" ::: "memory");
        }
    }
    __syncthreads();
}

typedef const Params __attribute__((address_space(4)))* KParams;
__global__ void __launch_bounds__(NTHREADS, 2) fwd_kernel(Params pk) {
    extern __shared__ __attribute__((aligned(16))) unsigned char lds_raw[];
    LAS unsigned char* lds = (LAS unsigned char*)lds_raw;
    cg::grid_group grid = cg::this_grid();
    volatile LAS unsigned* bst = (volatile LAS unsigned*)(lds + LDS_BYTES - 16);
    unsigned* gbar = (unsigned*)(pk.ws + WS_BAR);
    volatile LAS unsigned* bst2 = (volatile LAS unsigned*)(lds + LDS_BYTES - 32);
    constexpr int NHG = NB * 8 * 2;
    const bool coop = (pk.ph_hi - pk.ph_lo > 1);
    if (coop) {
        if (threadIdx.x == 0) { bst[0] = 0u; bst[1] = 0u; bst2[0] = 0u; bst2[1] = 0u; (void)xb_add(&gbar[XB_XCNT(xb_xcc_id())], 1u);
            if ((int)blockIdx.x >= NHG) (void)xb_add(&gbar[4096 + XB_XCNT(xb_xcc_id())], 1u); }
        __syncthreads();
    }
    const int lo = pk.ph_lo, hi = pk.ph_hi;
    int ph = 0;
#define PH_BEGIN if (ph >= lo && ph < hi) { KParams kp = (KParams)__builtin_amdgcn_kernarg_segment_ptr(); asm volatile("" : "+s"(kp)); Params p; __builtin_memcpy(&p, (const void __attribute__((address_space(4)))*)kp, sizeof(Params)); \
        unsigned char* ws = p.ws; const int G = ogrid(), cb = obid(); const float* xsrc = (l == 0) ? p.x : p.out; const float* nw = p.norm_w + (size_t)l * 4 * DM;
#define PH_END   if (ph + 1 < hi) { if (lo < 0) grid.sync(); else xcd_barrier((unsigned*)(ws + WS_BAR), bst, gridDim.x); } } ++ph;

    for (int l = 0; l < DEPTH; ++l) {
        if (l == 0) {
        PH_BEGIN
            prep_tables(p); rms_rows(p.x, nw, (bf16_t*)(ws + WS_MIXIN), TA);
            prep_weights(p, 0, lds);
        PH_END
        }
        for (int g = 0; g < NGRP; ++g) {
            const int tok0 = g * TG;
            PH_BEGIN
                const bf16_t* XN = (const bf16_t*)(ws + WS_MIXIN) + (size_t)tok0 * DM;
                if (g > 0 && cb >= (G >> 1)) mix_combine((const bf16_t*)(ws + G_F1), (const bf16_t*)(ws + G_F2), (bf16_t*)(ws + WS_MIXIN) + (size_t)(tok0 - TG) * DM, cb - (G >> 1), G - (G >> 1));
                __syncthreads();
                { pg8::Gemm gm{XN, (const bf16_t*)(ws + WS_WIN), DM, DM, DM}; pg8::SchedInProj S; S.init(G, cb);
                  pg8::EpiInProj E{ws, (const float*)(ws + WS_ROPE), (const float*)(ws + WS_LB), tok0};
                  pg8::gemm_phase<pg8::EpiInProj, pg8::SchedInProj>(lds, gm, S, E); }
                __syncthreads();
                { pg8::Gemm gm{(const bf16_t*)(ws + WS_WIN) + (size_t)2048 * DM, XN, DM, DM, DM}; pg8::SchedPlain S; S.init(2048, TG, DM, DM, G, cb);
                  pg8::EpiBf16<TG> E{(bf16_t*)(ws + G_VT)};
                  pg8::gemm_phase<pg8::EpiBf16<TG>, pg8::SchedPlain>(lds, gm, S, E); }
            PH_END
            PH_BEGIN
                const bool split = coop && G > 2 * NHG;
                int chG = G, chC = cb, chBase = 0, chLim = 4 * 2 * (TG / 256); bool chDo = true;
                const bool xaware = split && G == 256 && NB == 4;
                if (split && cb < NHG) { hgrn_item(p, lds_raw, cb);
                    if (xaware) { chG = NHG; chC = cb; chBase = 0; chLim = 2 * NHG; }
                    else chDo = false; }
                else {
                    const int Gs = split ? G - NHG : G, cs = split ? cb - NHG : cb;
                    if (!split) for (int it = cb; it < NB * 8 * 2; it += G) hgrn_item(p, lds_raw, it);
                    for (int it = cs; it < NB * 4 * 6 * 4; it += Gs) ret_local(p, lds_raw, it);
                    if (split) xcd_barrier((unsigned*)(ws + WS_BAR) + 4096, bst2, (unsigned)Gs);
                    else if (coop) xcd_barrier((unsigned*)(ws + WS_BAR), bst, gridDim.x);
                    constexpr int NRI = NB * 4 * 32;
                    if (xaware) {
                        const int x = cb & 7, j = cs >> 3;
                        for (int idx = j; idx < 64; idx += 24) ret_item(p, lds_raw, (2 * x) * 32 + idx);
                        chDo = j >= 16; chG = 64; chC = (j - 16) * 8 + x; chBase = 2 * NHG; chLim = 4 * NHG;
                    } else {
                        for (int it = cs; it < NRI; it += Gs) ret_item(p, lds_raw, it);
                        const int nfull = split ? NRI % Gs : 0;
                        chDo = cs >= nfull; chG = Gs - nfull; chC = cs - nfull;
                    }
                }
                __syncthreads();
                if (chDo) { pg8::Gemm gm{(const bf16_t*)(ws + WS_CDFT), (const bf16_t*)(ws + G_FU), 256, DM, 256}; pg8::SchedChan S; S.init(chG, chC, chBase, chLim);
                  pg8::EpiChan E{(bf16_t*)(ws + G_PQT)};
                  pg8::gemm_phase<pg8::EpiChan, pg8::SchedChan>(lds, gm, S, E); }
            PH_END
            PH_BEGIN
                hgrn_combine(p, l);
                __syncthreads();
                const int half = G >> 1;
                if (cb < half) { pg8::Gemm gm{(const bf16_t*)(ws + WS_DSEQ), (const bf16_t*)(ws + G_PQT), 4096, 4096, 2048}; pg8::SchedSeqH S; S.init(half, cb);
                  pg8::EpiSeqH E{(bf16_t*)(ws + G_SQ)};
                  pg8::gemm_phase<pg8::EpiSeqH, pg8::SchedSeqH>(lds, gm, S, E); }
                else { pg8::Gemm gm{(const bf16_t*)(ws + G_SGR), (const bf16_t*)(ws + WS_WRET), 2048, 2048, 2048}; pg8::SchedPlain S; S.init(TG, DM, 2048, 2048, G - half, cb - half);
                  pg8::EpiMix<0> E{(bf16_t*)(ws + G_F1), (const bf16_t*)(ws + G_GATES)};
                  pg8::gemm_phase<pg8::EpiMix<0>, pg8::SchedPlain>(lds, gm, S, E); }
            PH_END
            PH_BEGIN
                seq_combine((const bf16_t*)(ws + G_SQ), (const bf16_t*)(ws + G_PQT), (bf16_t*)(ws + G_YF));
            PH_END
            PH_BEGIN
                __syncthreads();
                const int half = G >> 1;
                if (cb < half) { pg8::Gemm gm{(const bf16_t*)(ws + G_SGH), (const bf16_t*)(ws + WS_WHG), DM, DM, DM}; pg8::SchedPlain S; S.init(TG, DM, DM, DM, half, cb);
                  pg8::EpiMix<1> E{(bf16_t*)(ws + G_F1), (const bf16_t*)(ws + G_GATES) + 1024};
                  pg8::gemm_phase<pg8::EpiMix<1>, pg8::SchedPlain>(lds, gm, S, E); }
                else { pg8::Gemm gm{(const bf16_t*)(ws + G_YF), (const bf16_t*)(ws + WS_WFN), DM, DM, DM}; pg8::SchedPlain S; S.init(TG, DM, DM, DM, G - half, cb - half);
                  pg8::EpiMix<0> E{(bf16_t*)(ws + G_F2), (const bf16_t*)(ws + G_GATES) + 2048};
                  pg8::gemm_phase<pg8::EpiMix<0>, pg8::SchedPlain>(lds, gm, S, E); }
            PH_END
            if (g == NGRP - 1) {
            PH_BEGIN
                mix_combine((const bf16_t*)(ws + G_F1), (const bf16_t*)(ws + G_F2), (bf16_t*)(ws + WS_MIXIN) + (size_t)tok0 * DM, cb, G);
            PH_END
            }
        }
        PH_BEGIN
            __syncthreads();
            { pg8::Gemm gm{(const bf16_t*)(ws + WS_MIXIN), (const bf16_t*)(ws + WS_WOUT), DM, DM, DM}; pg8::SchedPlain S; S.init(TA, DM, DM, DM, G, cb);
              pg8::EpiBf16<DM> E{(bf16_t*)(ws + A_MIXO)};
              pg8::gemm_phase<pg8::EpiBf16<DM>, pg8::SchedPlain>(lds, gm, S, E); }
        PH_END
        PH_BEGIN
            resid_rows((const bf16_t*)(ws + A_MIXO), xsrc, p.out, nw + DM, nw + 2 * DM, (bf16_t*)(ws + A_HN));
        PH_END
        PH_BEGIN
            __syncthreads();
            { pg8::Gemm gm{(const bf16_t*)(ws + A_HN), (const bf16_t*)(ws + WS_WUP), DM, DM, DM}; pg8::SchedPlain S; S.init(TA, 2 * DFF, DM, DM, G, cb);
              pg8::EpiBf16<2 * DFF> E{(bf16_t*)(ws + A_H)};
              pg8::gemm_phase<pg8::EpiBf16<2 * DFF>, pg8::SchedPlain>(lds, gm, S, E); }
        PH_END
        PH_BEGIN
            conv_phase((const bf16_t*)(ws + A_H), p.conv_w + (size_t)l * 3 * 2 * DFF, p.conv_b + (size_t)l * 2 * DFF, (bf16_t*)(ws + A_ACT));
        PH_END
        PH_BEGIN
            __syncthreads();
            { pg8::Gemm gm{(const bf16_t*)(ws + A_ACT), (const bf16_t*)(ws + WS_WDN), DFF, DFF, DFF}; pg8::SchedPlain S; S.init(TA, DM, DFF, DFF, G, cb);
              pg8::EpiBf16<DM> E{(bf16_t*)(ws + A_FFO)};
              pg8::gemm_phase<pg8::EpiBf16<DM>, pg8::SchedPlain>(lds, gm, S, E); }
        PH_END
        PH_BEGIN
            if (l + 1 < DEPTH) { resid_rows((const bf16_t*)(ws + A_FFO), p.out, p.out, nw + 3 * DM, nw + 4 * DM, (bf16_t*)(ws + WS_MIXIN));
                                 prep_weights(p, l + 1, lds); }
            else resid_rows((const bf16_t*)(ws + A_FFO), p.out, p.out, nw + 3 * DM, nullptr, nullptr);
        PH_END
    }
#undef PH_BEGIN
#undef PH_END
}
constexpr int NPHASES = 1 + DEPTH * (NGRP * 5 + 1 + 6);

extern "C" void kernel_launch(void* const* d_in, const int* in_sizes, int n_in, void* d_out, int out_size, void* d_ws, size_t ws_size, hipStream_t stream) {
    static int grid = 0;
    if (grid == 0) {
        int dev = 0, cus = 0, per_cu = 0;
        hipGetDevice(&dev);
        hipDeviceGetAttribute(&cus, hipDeviceAttributeMultiprocessorCount, dev);
        if (hipFuncSetAttribute((const void*)fwd_kernel, hipFuncAttributeMaxDynamicSharedMemorySize, LDS_BYTES) != hipSuccess) fprintf(stderr, "hipFuncSetAttribute failed\n");
        if (hipOccupancyMaxActiveBlocksPerMultiprocessor(&per_cu, (const void*)fwd_kernel, NTHREADS, LDS_BYTES) != hipSuccess || per_cu < 1) { fprintf(stderr, "occupancy query: %d\n", per_cu); per_cu = 1; }
        (void)hipGetLastError();
        grid = cus * 1;
        if (ws_size < 480 * MiB) fprintf(stderr, "kernel_launch: workspace %zu too small\n", ws_size);
    }
    Params p{};
    p.x = (const float*)d_in[0]; p.pos = (const int*)d_in[1]; p.norm_w = (const float*)d_in[2]; p.w_in = (const float*)d_in[3]; p.lb_logits = (const float*)d_in[4];
    p.hgrn_norm_w = (const float*)d_in[5]; p.w_ret_o = (const float*)d_in[6]; p.w_hgrn_o = (const float*)d_in[7]; p.w_fnet = (const float*)d_in[8]; p.w_out = (const float*)d_in[9];
    p.w_up = (const float*)d_in[10]; p.conv_w = (const float*)d_in[11]; p.conv_b = (const float*)d_in[12]; p.w_down = (const float*)d_in[13];
    p.out = (float*)d_out; p.ws = (unsigned char*)d_ws;
    (void)hipMemsetAsync((unsigned char*)d_ws + WS_BAR, 0, 32768, stream);
#if MK_MULTI
    for (int ph = 0; ph < NPHASES; ++ph) { p.ph_lo = ph; p.ph_hi = ph + 1; hipLaunchKernelGGL(fwd_kernel, dim3(grid), dim3(NTHREADS), LDS_BYTES, stream, p); }
#else
    p.ph_lo = 0; p.ph_hi = NPHASES;
    void* args[] = {&p};
    hipError_t e = hipLaunchCooperativeKernel((const void*)fwd_kernel, dim3(grid), dim3(NTHREADS), args, LDS_BYTES, stream);
    if (e != hipSuccess) fprintf(stderr, "cooperative launch failed: %s (grid %d)\n", hipGetErrorString(e), grid);
#endif
}
```

```cpp
#include <hip/hip_runtime.h>
#include <hip/hip_cooperative_groups.h>
#include <cstdio>
#include <cstdint>
namespace cg = cooperative_groups;

#ifndef MK_MULTI
#define MK_MULTI 0
#endif

#define LAS __attribute__((address_space(3)))
typedef unsigned short bf16_t;
typedef short bf16x8 __attribute__((ext_vector_type(8)));
typedef float f32x4 __attribute__((ext_vector_type(4)));
typedef float f32x2 __attribute__((ext_vector_type(2)));
typedef unsigned u32x4 __attribute__((ext_vector_type(4)));
typedef unsigned u32x2 __attribute__((ext_vector_type(2)));

constexpr int BATCH = 8, SEQ = 2048, DM = 1024, DEPTH = 2, DIN = 15360, DFF = 2816;
constexpr int NB = 4;
constexpr int NGRP = BATCH / NB;
constexpr int TG = NB * SEQ;
constexpr int TA = BATCH * SEQ;
constexpr float EPS = 1e-6f;
constexpr int NTHREADS = 512;
constexpr int LDS_BYTES = 156 * 1024;

constexpr size_t MiB = 1u << 20;
constexpr size_t WS_WIN = 0;
constexpr size_t WS_WRET = WS_WIN + (size_t)DIN * DM * 2;
constexpr size_t WS_WHG = WS_WRET + (size_t)DM * 2048 * 2;
constexpr size_t WS_WFN = WS_WHG + (size_t)DM * DM * 2;
constexpr size_t WS_WOUT = WS_WFN + (size_t)DM * DM * 2;
constexpr size_t WS_WUP = WS_WOUT + (size_t)DM * DM * 2;
constexpr size_t WS_WDN = WS_WUP + (size_t)2 * DFF * DM * 2;
constexpr size_t WS_WEND = WS_WDN + (size_t)DM * DFF * 2;
static_assert(WS_WEND <= 58 * MiB, "weights");
constexpr size_t WS_DSEQ = 58 * MiB;
constexpr size_t WS_CDFT = 74 * MiB;
constexpr size_t WS_LB = WS_CDFT + 512 * 1024;
constexpr size_t WS_BAR = WS_CDFT + 640 * 1024;
constexpr size_t WS_ROPE = 75 * MiB;
constexpr size_t WS_MIXIN = 91 * MiB;
constexpr size_t WS_G = 123 * MiB;
constexpr size_t G_HOF = WS_G + 0 * MiB;
constexpr size_t G_Q = WS_G + 16 * MiB;
constexpr size_t G_K = WS_G + 32 * MiB;
constexpr size_t G_VT = WS_G + 48 * MiB;
constexpr size_t G_SGR = WS_G + 80 * MiB;
constexpr size_t G_HQ = WS_G + 112 * MiB;
constexpr size_t G_LFF = WS_G + 128 * MiB;
constexpr size_t G_LFB = WS_G + 144 * MiB;
constexpr size_t G_HI = WS_G + 160 * MiB;
constexpr size_t G_SGH = WS_G + 176 * MiB;
constexpr size_t G_FU = WS_G + 192 * MiB;
constexpr size_t G_GATES = WS_G + 208 * MiB;
constexpr size_t G_PQT = WS_G + 256 * MiB;
constexpr size_t G_SQ = WS_G + 16 * MiB;
constexpr size_t G_F1 = WS_G + 320 * MiB;
constexpr size_t G_F2 = WS_G + 336 * MiB;
constexpr size_t G_YF = WS_G + 288 * MiB;
constexpr size_t G_HOB = WS_G + 304 * MiB;
constexpr size_t G_END = WS_G + 320 * MiB;
constexpr size_t A_HN = WS_G + 0 * MiB;
constexpr size_t A_MIXO = WS_G + 32 * MiB;
constexpr size_t A_H = WS_G + 96 * MiB;
constexpr size_t A_FFO = A_H;
constexpr size_t A_ACT = WS_MIXIN;
constexpr size_t A_END = A_H + (size_t)TA * 2 * DFF * 2;
static_assert(G_END <= 480 * MiB && A_END <= 480 * MiB, "ws");
static_assert(A_ACT + (size_t)TA * DFF * 2 <= A_H, "act overlay");

__device__ __forceinline__ unsigned f2bf(float f) { unsigned u = __builtin_bit_cast(unsigned, f); return (u + 0x7fffu + ((u >> 16) & 1u)) >> 16; }
__device__ __forceinline__ unsigned pk2(float lo, float hi) { return f2bf(lo) | (f2bf(hi) << 16); }
__device__ __forceinline__ float bf2f(unsigned short h) { return __builtin_bit_cast(float, (unsigned)h << 16); }
__device__ __forceinline__ float bflo(unsigned w) { return __builtin_bit_cast(float, w << 16); }
__device__ __forceinline__ float bfhi(unsigned w) { return __builtin_bit_cast(float, w & 0xffff0000u); }
__device__ __forceinline__ float shx(float v, int o, int lane) { return __builtin_bit_cast(float, __builtin_amdgcn_ds_bpermute((lane ^ o) << 2, __builtin_bit_cast(int, v))); }
__device__ __forceinline__ float wave_sum(float v, int lane) {
#pragma unroll
    for (int o = 1; o < 64; o <<= 1) v += shx(v, o, lane);
    return v;
}
__device__ __forceinline__ int otid() { int t = threadIdx.x; asm volatile("" : "+v"(t)); return t; }
__device__ __forceinline__ int obid() { int t = blockIdx.x; asm volatile("" : "+s"(t)); return t; }
__device__ __forceinline__ int ogrid() { int t = gridDim.x; asm volatile("" : "+s"(t)); return t; }
typedef __bf16 bf16x2_t __attribute__((ext_vector_type(2)));
__device__ __forceinline__ unsigned cvtpk(float lo, float hi) { const f32x2 v = {lo, hi}; const bf16x2_t b = __builtin_convertvector(v, bf16x2_t); return __builtin_bit_cast(unsigned, b); }
__device__ __forceinline__ float silu_f(float x) { return x * __builtin_amdgcn_rcpf(1.f + __builtin_amdgcn_exp2f(-1.4426950408889634f * x)); }
__device__ __forceinline__ float sigm_f(float x) { return __builtin_amdgcn_rcpf(1.f + __builtin_amdgcn_exp2f(-1.4426950408889634f * x)); }
__device__ __forceinline__ f32x4 mfma16(bf16x8 a, bf16x8 b, f32x4 c) { return __builtin_amdgcn_mfma_f32_16x16x32_bf16(a, b, c, 0, 0, 0); }

namespace pg8 {
constexpr int BM = 256, BK = 64, HALF = 128, HTB = HALF * BK * 2, STAGE_BYTES = 8 * HTB, NXCD = 8, WGM = 8;
__host__ __device__ __forceinline__ int lds_byte(int r, int c) { const int st = (r >> 4) * 2 + (c >> 5), rr = r & 15, cc = c & 31, ob = rr * 64 + cc * 2; return st * 1024 + (ob ^ (((ob >> 9) & 1) << 5)); }
__host__ __device__ __forceinline__ void stage_rc(int b, int& R, int& C) { const int st = b / 1024, sb = b % 1024, swz = sb ^ (((sb >> 9) & 1) << 5); R = (st >> 1) * 16 + swz / 64; C = (st & 1) * 32 + (swz % 64) / 2; }
__host__ __device__ __forceinline__ int perm32(int rho) { const int n = rho >> 4, i = rho & 15; return 8 * (i >> 2) + 4 * n + (i & 3); }

struct Unit { int pm, pn, z; size_t offA, offB; };
struct Gemm { const bf16_t* A; const bf16_t* Bt; int lda, ldb, K; };

struct StaticOrder {
    int nM, nN, nwg, G, c;
    __device__ __forceinline__ void init(int nM_, int nN_, int G_, int c_) { nM = nM_; nN = nN_; nwg = nM * nN; G = G_; c = c_; }
    __device__ __forceinline__ bool next(int i, int& pm, int& pn) const {
        const long L = (long)i * G + c; if (L >= nwg) return false;
        int wgid = (int)L; { const int q = nwg / NXCD, r = nwg % NXCD, xcd = wgid % NXCD, off = wgid / NXCD; wgid = (xcd < r ? xcd * (q + 1) : r * (q + 1) + (xcd - r) * q) + off; }
        const int nig = WGM * nN, gid = wgid / nig, fm = gid * WGM, gsz = (nM - fm) < WGM ? (nM - fm) : WGM;
        pm = fm + ((wgid % nig) % gsz); pn = (wgid % nig) / gsz; return true;
    }
};
struct SchedPlain {
    StaticOrder o; size_t tA, tB;
    __device__ __forceinline__ void init(int M, int N, int lda, int ldb, int G, int c) { o.init(M / BM, N / BM, G, c); tA = (size_t)BM * lda * 2; tB = (size_t)BM * ldb * 2; }
    __device__ __forceinline__ bool next(int i, Unit& u) const { int pm, pn; if (!o.next(i, pm, pn)) return false; u.pm = pm; u.pn = pn; u.z = 0; u.offA = pm * tA; u.offB = pn * tB; return true; }
};
struct SchedInProj {
    StaticOrder o; size_t tA, tB;
    __device__ __forceinline__ void init(int G, int c) { o.init(TG / BM, 52, G, c); tA = (size_t)BM * DM * 2; tB = (size_t)BM * DM * 2; }
    __device__ __forceinline__ bool next(int i, Unit& u) const { int pm, pn; if (!o.next(i, pm, pn)) return false; if (pn >= 8) pn += 8; u.pm = pm; u.pn = pn; u.z = 0; u.offA = pm * tA; u.offB = pn * tB; return true; }
};
struct SchedChan {
    int G, c, base, lim;
    __device__ __forceinline__ void init(int G_, int c_, int base_ = 0, int lim_ = 4 * 2 * (TG / BM)) { G = G_; c = c_; base = base_; lim = lim_; }
    __device__ __forceinline__ bool next(int i, Unit& u) const {
        const int L = base + i * G + c; constexpr int NT = TG / BM; if (L >= lim) return false;
        const int g = L / (2 * NT), r = L % (2 * NT); u.z = g; u.pm = r / NT; u.pn = r % NT;
        u.offA = (size_t)u.pm * BM * 256 * 2; u.offB = ((size_t)u.pn * BM * DM + g * 256) * 2; return true;
    }
};

struct SchedSeqH {
    int G, c;
    __device__ __forceinline__ void init(int G_, int c_) { G = G_; c = c_; }
    __device__ __forceinline__ bool next(int i, Unit& u) const {
        const int L = i * G + c; constexpr int NN = NB * 1024 / BM; if (L >= 2 * 4 * NN) return false;
        const int z = L / (4 * NN), r = L % (4 * NN); u.z = z; u.pm = r / NN; u.pn = r % NN;
        u.offA = ((size_t)u.pm * BM * 4096 + z * 2048) * 2; u.offB = ((size_t)u.pn * BM * 4096 + z * 2048) * 2; return true;
    }
};
__device__ __forceinline__ unsigned cvt_pk_bf16(float lo, float hi) { return cvtpk(lo, hi); }

template <class Epi, class Sched, bool ALIGN_EPI = true, bool SP2 = true>
__device__ __forceinline__ void gemm_phase(LAS unsigned char* lds, const Gemm g, const Sched& S, const Epi& E) {
    int tid_ = threadIdx.x; asm volatile("" : "+v"(tid_));
    const int tid = tid_, wid = __builtin_amdgcn_readfirstlane(tid >> 6), lane = tid & 63, wr = wid >> 2, wc = wid & 3, fr = lane & 15, fq = lane >> 4;
    const int K = g.K, nt = K / BK;
    unsigned voffA[2], voffB[2];
#pragma unroll
    for (int i = 0; i < 2; ++i) { int R, C; stage_rc(tid * 16 + i * 8192, R, C); const int Rb = Epi::PERM ? ((R & ~31) + perm32(R & 31)) : R;
        voffA[i] = (unsigned)(R * g.lda + C) * 2u; voffB[i] = (unsigned)(Rb * g.ldb + C) * 2u; }
    const size_t kstep = (size_t)(BK * 2);
    const size_t hstepA = (size_t)HALF * g.lda * 2, hstepB = (size_t)HALF * g.ldb * 2;
    const unsigned ldsw = (unsigned)wid * 1024u;
    const int aoff = lds_byte(wr * 64 + fr, fq * 8), boff = lds_byte(wc * 32 + fr, fq * 8);
#define PG8_SA(b, h) (((b) * 2 + (h)) * HTB)
#define PG8_SB(b, h) ((4 + (b) * 2 + (h)) * HTB)
#define PG8_STAGE(bufoff, gbase, voff) do { const char* _gb = (const char*)(gbase); asm volatile("" : "+s"(_gb));     \
        _Pragma("unroll") for (int _i = 0; _i < 2; ++_i) \
        __builtin_amdgcn_global_load_lds((const unsigned*)(_gb + (voff)[_i]), (LAS unsigned*)(lds + (bufoff) + ldsw + _i * 8192), 16, 0, 0); } while (0)
#define PG8_LDA(dst, b, h) do { _Pragma("unroll") for (int m = 0; m < 4; ++m) _Pragma("unroll") for (int k = 0; k < 2; ++k) dst[m][k] = *(const LAS bf16x8*)(lds + PG8_SA(b, h) + aoff + m * 2048 + k * 1024); } while (0)
#define PG8_LDB(dst, b, h) do { _Pragma("unroll") for (int n = 0; n < 2; ++n) _Pragma("unroll") for (int k = 0; k < 2; ++k) dst[n][k] = *(const LAS bf16x8*)(lds + PG8_SB(b, h) + boff + n * 2048 + k * 1024); } while (0)
#define PG8_MMA(ai, bj, At, Bt) do { __builtin_amdgcn_s_setprio(1); _Pragma("unroll") for (int m = 0; m < 4; ++m) _Pragma("unroll") for (int n = 0; n < 2; ++n) _Pragma("unroll") for (int k = 0; k < 2; ++k) \
        acc[ai][bj][m][n] = __builtin_amdgcn_mfma_f32_16x16x32_bf16(Bt[n][k], At[m][k], acc[ai][bj][m][n], 0, 0, 0); __builtin_amdgcn_s_setprio(0); } while (0)
#define PG8_WAIT_V(n) asm volatile("s_waitcnt vmcnt(" #n ")" ::: "memory")
#define PG8_WAIT_L(n) asm volatile("s_waitcnt lgkmcnt(" #n ")" ::: "memory")
#define PG8_BAR __builtin_amdgcn_s_barrier()
#define PG8_SCHED __builtin_amdgcn_sched_barrier(0)
    Unit cur, nxt; int ui = 0;
    if (!S.next(0, cur)) return;
    f32x4 acc[2][2][4][2];
#pragma unroll
    for (int a = 0; a < 2; ++a)
#pragma unroll
        for (int b = 0; b < 2; ++b)
#pragma unroll
            for (int m = 0; m < 4; ++m)
#pragma unroll
                for (int n = 0; n < 2; ++n) acc[a][b][m][n] = (f32x4){0.f, 0.f, 0.f, 0.f};
    bf16x8 At[4][2], B0[2][2], B1[2][2];
    const char* cA = (const char*)g.A + cur.offA; const char* cB = (const char*)g.Bt + cur.offB;
    if constexpr (SP2) {
        PG8_STAGE(PG8_SB(0, 0), cB, voffB); PG8_STAGE(PG8_SB(0, 1), cB + hstepB, voffB); PG8_STAGE(PG8_SA(0, 0), cA, voffA); PG8_STAGE(PG8_SA(0, 1), cA + hstepA, voffA);
        if (wr == 1) PG8_BAR;
        PG8_WAIT_V(2); PG8_BAR;
        PG8_STAGE(PG8_SB(1, 0), cB + kstep, voffB); PG8_STAGE(PG8_SA(1, 0), cA + kstep, voffA); PG8_STAGE(PG8_SB(1, 1), cB + hstepB + kstep, voffB);
        PG8_WAIT_V(6); PG8_BAR;
    } else {
        PG8_STAGE(PG8_SB(0, 0), cB, voffB); PG8_STAGE(PG8_SA(0, 0), cA, voffA); PG8_STAGE(PG8_SB(0, 1), cB + hstepB, voffB); PG8_STAGE(PG8_SA(0, 1), cA + hstepA, voffA);
        if (wr == 1) PG8_BAR;
        PG8_WAIT_V(4); PG8_BAR;
        PG8_STAGE(PG8_SB(1, 0), cB + kstep, voffB); PG8_STAGE(PG8_SA(1, 0), cA + kstep, voffA); PG8_STAGE(PG8_SB(1, 1), cB + hstepB + kstep, voffB);
        PG8_WAIT_V(6); PG8_BAR;
    }
    for (;;) {
        const bool has_next = S.next(ui + 1, nxt);
        const char* nA = has_next ? (const char*)g.A + nxt.offA : cA; const char* nB = has_next ? (const char*)g.Bt + nxt.offB : cB;
        for (int t = 0; t < nt; t += 2) {
            const bool last = (t == nt - 2);
            const char* a1 = cA + (size_t)(t + 1) * kstep;
            const char* a2 = last ? nA : cA + (size_t)(t + 2) * kstep; const char* b2 = last ? nB : cB + (size_t)(t + 2) * kstep;
            const char* a3 = a2 + kstep; const char* b3 = b2 + kstep;
            if constexpr (SP2) {
            PG8_LDB(B0, 0, 0); PG8_LDB(B1, 0, 1); PG8_SCHED; PG8_LDA(At, 0, 0); PG8_STAGE(PG8_SA(1, 1), a1 + hstepA, voffA);
            PG8_WAIT_V(8); PG8_WAIT_L(0); PG8_BAR; PG8_MMA(0, 0, At, B0); PG8_MMA(0, 1, At, B1); PG8_BAR; PG8_SCHED;
            PG8_LDA(At, 0, 1); PG8_STAGE(PG8_SB(0, 0), b2, voffB); PG8_STAGE(PG8_SB(0, 1), b2 + hstepB, voffB); PG8_STAGE(PG8_SA(0, 0), a2, voffA);
            PG8_WAIT_V(8); PG8_WAIT_L(0); PG8_BAR; PG8_MMA(1, 0, At, B0); PG8_MMA(1, 1, At, B1); PG8_BAR; PG8_SCHED;
            PG8_LDB(B0, 1, 0); PG8_LDB(B1, 1, 1); PG8_SCHED; PG8_LDA(At, 1, 0); PG8_STAGE(PG8_SA(0, 1), a2 + hstepA, voffA);
            PG8_WAIT_V(8); PG8_WAIT_L(0); PG8_BAR; PG8_MMA(0, 0, At, B0); PG8_MMA(0, 1, At, B1); PG8_BAR; PG8_SCHED;
            PG8_LDA(At, 1, 1); PG8_STAGE(PG8_SB(1, 0), b3, voffB); PG8_STAGE(PG8_SB(1, 1), b3 + hstepB, voffB); PG8_STAGE(PG8_SA(1, 0), a3, voffA);
            PG8_WAIT_V(8); PG8_WAIT_L(0); PG8_BAR; PG8_MMA(1, 0, At, B0); PG8_MMA(1, 1, At, B1); PG8_BAR; PG8_SCHED;
            } else {
            PG8_LDB(B0, 0, 0); PG8_SCHED; PG8_LDA(At, 0, 0); PG8_STAGE(PG8_SA(1, 1), a1 + hstepA, voffA);
            PG8_WAIT_L(8); PG8_BAR; PG8_WAIT_L(0); PG8_MMA(0, 0, At, B0); PG8_BAR; PG8_SCHED;
            PG8_LDB(B1, 0, 1); PG8_STAGE(PG8_SB(0, 0), b2, voffB);
            PG8_BAR; PG8_WAIT_L(0); PG8_MMA(0, 1, At, B1); PG8_BAR;
            PG8_LDA(At, 0, 1); PG8_STAGE(PG8_SA(0, 0), a2, voffA);
            PG8_BAR; PG8_WAIT_L(0); PG8_MMA(1, 0, At, B0); PG8_BAR; PG8_SCHED;
            PG8_STAGE(PG8_SB(0, 1), b2 + hstepB, voffB);
            PG8_WAIT_V(6); PG8_BAR; PG8_MMA(1, 1, At, B1); PG8_BAR;
            PG8_LDB(B0, 1, 0); PG8_SCHED; PG8_LDA(At, 1, 0); PG8_STAGE(PG8_SA(0, 1), a2 + hstepA, voffA);
            PG8_WAIT_L(8); PG8_BAR; PG8_WAIT_L(0); PG8_MMA(0, 0, At, B0); PG8_BAR; PG8_SCHED;
            PG8_LDB(B1, 1, 1); PG8_STAGE(PG8_SB(1, 0), b3, voffB);
            PG8_BAR; PG8_WAIT_L(0); PG8_MMA(0, 1, At, B1); PG8_BAR;
            PG8_LDA(At, 1, 1); PG8_STAGE(PG8_SA(1, 0), a3, voffA);
            PG8_BAR; PG8_WAIT_L(0); PG8_MMA(1, 0, At, B0); PG8_BAR; PG8_SCHED;
            PG8_STAGE(PG8_SB(1, 1), b3 + hstepB, voffB);
            PG8_WAIT_V(6); PG8_BAR; PG8_MMA(1, 1, At, B1); PG8_BAR;
            }
        }
        if constexpr (ALIGN_EPI) { if (wr == 0) PG8_BAR; }
        { int t2 = tid; asm volatile("" : "+v"(t2));
          const int w2 = t2 >> 6, l2 = t2 & 63; E(acc, cur, w2 >> 2, w2 & 3, l2 & 15, l2 >> 4); }
        if (!has_next) break;
#pragma unroll
        for (int a = 0; a < 2; ++a)
#pragma unroll
            for (int b = 0; b < 2; ++b)
#pragma unroll
                for (int m = 0; m < 4; ++m)
#pragma unroll
                    for (int n = 0; n < 2; ++n) acc[a][b][m][n] = (f32x4){0.f, 0.f, 0.f, 0.f};
        cur = nxt; cA = nA; cB = nB; ++ui;
        if constexpr (ALIGN_EPI) { if (wr == 1) PG8_BAR; }
    }
    PG8_WAIT_V(0);
    if constexpr (!ALIGN_EPI) { if (wr == 0) PG8_BAR; }
    PG8_BAR;
#undef PG8_SA
#undef PG8_SB
#undef PG8_STAGE
#undef PG8_LDA
#undef PG8_LDB
#undef PG8_MMA
#undef PG8_WAIT_V
#undef PG8_WAIT_L
#undef PG8_BAR
#undef PG8_SCHED
}

typedef f32x4 Acc[2][2][4][2];
#define EPI_ROW_FENCE __builtin_amdgcn_sched_barrier(0)
__device__ __forceinline__ u32x4 pack8(const f32x4 v0, const f32x4 v1) { u32x4 w; w.x = cvt_pk_bf16(v0[0], v0[1]); w.y = cvt_pk_bf16(v0[2], v0[3]); w.z = cvt_pk_bf16(v1[0], v1[1]); w.w = cvt_pk_bf16(v1[2], v1[3]); return w; }

template <int LDC> __device__ __forceinline__ void store_tile_bf16(const Acc& acc, bf16_t* base) {
#pragma unroll
    for (int ai = 0; ai < 2; ++ai)
#pragma unroll
        for (int m = 0; m < 4; ++m) { bf16_t* rowp = base + (size_t)(ai * HALF + m * 16) * LDC;
#pragma unroll
            for (int bj = 0; bj < 2; ++bj) *(u32x4*)(rowp + bj * HALF) = pack8(acc[ai][bj][m][0], acc[ai][bj][m][1]);
            EPI_ROW_FENCE; }
}
template <int LDC> struct EpiBf16 {
    static constexpr bool PERM = true;
    bf16_t* O;
    __device__ __forceinline__ void operator()(const Acc& acc, const Unit& u, int wr, int wc, int fr, int fq) const {
        store_tile_bf16<LDC>(acc, O + (size_t)(u.pm * BM + wr * 64 + fr) * LDC + u.pn * BM + wc * 32 + 8 * fq);
    }
};
struct EpiF32 {
    static constexpr bool PERM = false;
    float* O;
    __device__ __forceinline__ void operator()(const Acc& acc, const Unit& u, int wr, int wc, int fr, int fq) const {
        float* base = O + (size_t)(u.pm * BM + wr * 64 + fr) * DM + u.pn * BM + wc * 32 + 4 * fq;
#pragma unroll
        for (int ai = 0; ai < 2; ++ai)
#pragma unroll
            for (int m = 0; m < 4; ++m) { float* rowp = base + (size_t)(ai * HALF + m * 16) * DM;
#pragma unroll
                for (int bj = 0; bj < 2; ++bj)
#pragma unroll
                    for (int n = 0; n < 2; ++n) *(f32x4*)(rowp + bj * HALF + 16 * n) = acc[ai][bj][m][n];
                EPI_ROW_FENCE; }
    }
};
struct EpiSeqH {
    static constexpr bool PERM = true;
    bf16_t* O;
    __device__ __forceinline__ void operator()(const Acc& acc, const Unit& u, int wr, int wc, int fr, int fq) const {
        constexpr int LD = NB * 1024;
        store_tile_bf16<LD>(acc, O + ((size_t)u.z * 1024 + u.pm * BM + wr * 64 + fr) * LD + u.pn * BM + wc * 32 + 8 * fq);
    }
};
template <int MODE> struct EpiMix {
    static constexpr bool PERM = false;
    bf16_t* F; const bf16_t* gates;
    __device__ __forceinline__ void operator()(const Acc& acc, const Unit& u, int wr, int wc, int fr, int fq) const {
        const size_t row0 = u.pm * BM + wr * 64 + fr; const int col0 = u.pn * BM + wc * 32 + 4 * fq;
        bf16_t* fb = F + row0 * DM + col0; const bf16_t* gb = gates + row0 * 3072 + col0;
#pragma unroll
        for (int ai = 0; ai < 2; ++ai) {
            u32x2 gw[4][4], ow[4][4];
#pragma unroll
            for (int m = 0; m < 4; ++m)
#pragma unroll
                for (int q = 0; q < 4; ++q) { const int ro = ai * HALF + m * 16, co = (q >> 1) * HALF + 16 * (q & 1);
                    gw[m][q] = *(const u32x2*)(gb + (size_t)ro * 3072 + co);
                    if (MODE >= 1) ow[m][q] = *(const u32x2*)(fb + (size_t)ro * DM + co); }
#pragma unroll
            for (int m = 0; m < 4; ++m)
#pragma unroll
                for (int q = 0; q < 4; ++q) { const int ro = ai * HALF + m * 16, co = (q >> 1) * HALF + 16 * (q & 1);
                    f32x4 v = acc[ai][q >> 1][m][q & 1]; v[0] *= bflo(gw[m][q].x); v[1] *= bfhi(gw[m][q].x); v[2] *= bflo(gw[m][q].y); v[3] *= bfhi(gw[m][q].y);
                    if (MODE >= 1) { v[0] += bflo(ow[m][q].x); v[1] += bfhi(ow[m][q].x); v[2] += bflo(ow[m][q].y); v[3] += bfhi(ow[m][q].y); }
                    u32x2 w; w.x = cvt_pk_bf16(v[0], v[1]); w.y = cvt_pk_bf16(v[2], v[3]); *(u32x2*)(fb + (size_t)ro * DM + co) = w; }
            EPI_ROW_FENCE; }
    }
};
struct EpiChan {
    static constexpr bool PERM = true;
    bf16_t* PQT;
    __device__ __forceinline__ void operator()(const Acc& acc, const Unit& u, int wr, int wc, int fr, int fq) const {
        const int tok0 = u.pn * BM, bl = tok0 >> 11, s0 = (tok0 & (SEQ - 1)) + wc * 32 + 8 * fq;
        store_tile_bf16<4096>(acc, PQT + ((size_t)(bl * 1024 + u.z * 256 + wr * 64 + fr)) * 4096 + u.pm * 2048 + s0);
    }
};
struct EpiSeq {
    static constexpr bool PERM = true;
    bf16_t* YF;
    __device__ __forceinline__ void operator()(const Acc& acc, const Unit& u, int wr, int wc, int fr, int fq) const {
        const int bl = u.pn >> 2, gc0 = (u.pn & 3) * 256 + wc * 32 + 8 * fq;
        store_tile_bf16<DM>(acc, YF + ((size_t)(bl * SEQ + u.pm * BM + wr * 64 + fr)) * DM + gc0);
    }
};
template <int KIND, int LDC> __device__ __forceinline__ void store_act(const Acc& acc, bf16_t* base, const float* lbp) {
    f32x4 lbv4[2][2];
#pragma unroll
    for (int bj = 0; bj < 2; ++bj)
#pragma unroll
        for (int n = 0; n < 2; ++n) lbv4[bj][n] = (KIND == 4) ? *(const f32x4*)(lbp + bj * HALF + 4 * n) : (f32x4){0.f, 0.f, 0.f, 0.f};
#pragma unroll
    for (int ai = 0; ai < 2; ++ai)
#pragma unroll
        for (int m = 0; m < 4; ++m) { bf16_t* rowp = base + (size_t)(ai * HALF + m * 16) * LDC;
#pragma unroll
            for (int bj = 0; bj < 2; ++bj) { f32x4 v[2] = {acc[ai][bj][m][0], acc[ai][bj][m][1]};
#pragma unroll
                for (int n = 0; n < 2; ++n) { const f32x4 lb = lbv4[bj][n];
#pragma unroll
                    for (int j = 0; j < 4; ++j) { float x = v[n][j];
                        if (KIND == 2) x = silu_f(x);
                        else if (KIND == 3) x = silu_f(x) * 0.08838834764831845f;
                        else if (KIND == 7) x = sigm_f(x);
                        else if (KIND == 4) { const float l = lb[j], e = __expf(-fabsf(x));
                            const float f = (x >= 0.f ? (1.f + l * e) : (e + l)) * __builtin_amdgcn_rcpf(1.f + e); x = fmaxf(__builtin_amdgcn_logf(f), -115.f); }
                        v[n][j] = x; } }
                *(u32x4*)(rowp + bj * HALF) = pack8(v[0], v[1]); }
            EPI_ROW_FENCE; }
}
struct EpiInProj {
    static constexpr bool PERM = true;
    unsigned char* ws; const float* rope; const float* lbv; int tok0;
    __device__ __forceinline__ void operator()(const Acc& acc, const Unit& u, int wr, int wc, int fr, int fq) const {
        const int pn = u.pn;
        const size_t row0 = u.pm * BM + wr * 64 + fr;
        const int cin = wc * 32 + 8 * fq;
        if (pn < 8) {
            const float sc = pn >= 4 ? 0.0625f : 1.0f;
            bf16_t* base = (bf16_t*)(ws + (pn >= 4 ? G_K : G_Q)) + row0 * DM + (pn & 3) * BM + cin;
            const float* rb = rope + ((size_t)(tok0 + row0) * 128 + cin) * 2;
#pragma unroll
            for (int ai = 0; ai < 2; ++ai) {
                f32x4 cs[4][4];
#pragma unroll
                for (int m = 0; m < 4; ++m) { const f32x4* rp = (const f32x4*)(rb + (size_t)(ai * HALF + m * 16) * 256);
#pragma unroll
                    for (int q = 0; q < 4; ++q) cs[m][q] = rp[q]; }
#pragma unroll
                for (int m = 0; m < 4; ++m) { const int ro = ai * HALF + m * 16;
                    f32x4 o1[2], o2[2];
#pragma unroll
                    for (int n = 0; n < 2; ++n) { const f32x4 cs0 = cs[m][2 * n], cs1 = cs[m][2 * n + 1];
                        const f32x4 x1 = acc[ai][0][m][n], x2 = acc[ai][1][m][n];
                        o1[n][0] = (x1[0] * cs0[0] - x2[0] * cs0[1]) * sc; o2[n][0] = (x1[0] * cs0[1] + x2[0] * cs0[0]) * sc;
                        o1[n][1] = (x1[1] * cs0[2] - x2[1] * cs0[3]) * sc; o2[n][1] = (x1[1] * cs0[3] + x2[1] * cs0[2]) * sc;
                        o1[n][2] = (x1[2] * cs1[0] - x2[2] * cs1[1]) * sc; o2[n][2] = (x1[2] * cs1[1] + x2[2] * cs1[0]) * sc;
                        o1[n][3] = (x1[3] * cs1[2] - x2[3] * cs1[3]) * sc; o2[n][3] = (x1[3] * cs1[3] + x2[3] * cs1[2]) * sc; }
                    bf16_t* rowp = base + (size_t)ro * DM;
                    *(u32x4*)rowp = pack8(o1[0], o1[1]);
                    *(u32x4*)(rowp + HALF) = pack8(o2[0], o2[1]); }
                EPI_ROW_FENCE; }
            return;
        }
        if (pn < 24) store_act<2, 2048>(acc, (bf16_t*)(ws + G_SGR) + row0 * 2048 + (pn - 16) * BM + cin, nullptr);
        else if (pn < 28) store_act<3, DM>(acc, (bf16_t*)(ws + G_HQ) + row0 * DM + (pn - 24) * BM + cin, nullptr);
        else if (pn < 32) store_act<4, DM>(acc, (bf16_t*)(ws + G_LFF) + row0 * DM + (pn - 28) * BM + cin, lbv + (pn - 28) * BM + cin);
        else if (pn < 36) store_act<4, DM>(acc, (bf16_t*)(ws + G_LFB) + row0 * DM + (pn - 32) * BM + cin, lbv + 1024 + (pn - 32) * BM + cin);
        else if (pn < 40) store_act<6, DM>(acc, (bf16_t*)(ws + G_HI) + row0 * DM + (pn - 36) * BM + cin, nullptr);
        else if (pn < 44) store_act<2, DM>(acc, (bf16_t*)(ws + G_SGH) + row0 * DM + (pn - 40) * BM + cin, nullptr);
        else if (pn < 48) store_act<6, DM>(acc, (bf16_t*)(ws + G_FU) + row0 * DM + (pn - 44) * BM + cin, nullptr);
        else store_act<7, 3072>(acc, (bf16_t*)(ws + G_GATES) + row0 * 3072 + (pn - 48) * BM + cin, nullptr);
    }
};
}

struct Params {
    const float* x; const int* pos; const float* norm_w; const float* w_in; const float* lb_logits; const float* hgrn_norm_w;
    const float* w_ret_o; const float* w_hgrn_o; const float* w_fnet; const float* w_out; const float* w_up; const float* conv_w; const float* conv_b; const float* w_down;
    float* out; unsigned char* ws; int ph_lo, ph_hi;
};

__device__ __forceinline__ void transpose_item(const float* W, int K, int N, bf16_t* WT, LAS float* scr, int item, int lane) {
    const int nblk = N / 32, kb = item / nblk, nb = item % nblk, k0 = 64 * kb, n0 = 32 * nb;
#pragma unroll 8
    for (int i = 0; i < 32; ++i) { const int kk = 2 * i + (lane >> 5); scr[kk * 33 + (lane & 31)] = W[(size_t)(k0 + kk) * N + n0 + (lane & 31)]; }
    asm volatile("s_waitcnt lgkmcnt(0)" ::: "memory");
    const int c = lane & 7;
#pragma unroll
    for (int j = 0; j < 4; ++j) { const int n = (lane >> 3) + 8 * j; const LAS float* s = scr + (8 * c) * 33 + n;
        u32x4 o; o.x = pk2(s[0 * 33], s[1 * 33]); o.y = pk2(s[2 * 33], s[3 * 33]); o.z = pk2(s[4 * 33], s[5 * 33]); o.w = pk2(s[6 * 33], s[7 * 33]);
        *(u32x4*)(WT + (size_t)(n0 + n) * K + k0 + 8 * c) = o; }
    asm volatile("s_waitcnt lgkmcnt(0)" ::: "memory");
}

__device__ __forceinline__ void prep_weights(const Params& p, int l, LAS unsigned char* lds) {
    const int tid = otid(), lane = tid & 63, wave = tid >> 6;
    LAS float* scr = (LAS float*)(lds + wave * 16384);
    const int gw = obid() * 8 + wave, NGW = ogrid() * 8;
    unsigned char* ws = p.ws;
    constexpr int I_IN = (DM / 64) * (DIN / 32), I_RET = (2048 / 64) * (DM / 32), I_SQ = (DM / 64) * (DM / 32), I_UP = (DM / 64) * (2 * DFF / 32), I_DN = (DFF / 64) * (DM / 32);
    constexpr int NITEMS = I_IN + I_RET + 3 * I_SQ + I_UP + I_DN;
    for (int it = gw; it < NITEMS; it += NGW) {
        int r = it;
        if (r < I_IN) { transpose_item(p.w_in + (size_t)l * DM * DIN, DM, DIN, (bf16_t*)(ws + WS_WIN), scr, r, lane); continue; } r -= I_IN;
        if (r < I_RET) { transpose_item(p.w_ret_o + (size_t)l * 2048 * DM, 2048, DM, (bf16_t*)(ws + WS_WRET), scr, r, lane); continue; } r -= I_RET;
        if (r < I_SQ) { transpose_item(p.w_hgrn_o + (size_t)l * DM * DM, DM, DM, (bf16_t*)(ws + WS_WHG), scr, r, lane); continue; } r -= I_SQ;
        if (r < I_SQ) { transpose_item(p.w_fnet + (size_t)l * DM * DM, DM, DM, (bf16_t*)(ws + WS_WFN), scr, r, lane); continue; } r -= I_SQ;
        if (r < I_SQ) { transpose_item(p.w_out + (size_t)l * DM * DM, DM, DM, (bf16_t*)(ws + WS_WOUT), scr, r, lane); continue; } r -= I_SQ;
        if (r < I_UP) { transpose_item(p.w_up + (size_t)l * DM * 2 * DFF, DM, 2 * DFF, (bf16_t*)(ws + WS_WUP), scr, r, lane); continue; } r -= I_UP;
        transpose_item(p.w_down + (size_t)l * DFF * DM, DFF, DM, (bf16_t*)(ws + WS_WDN), scr, r, lane);
    }
    const int gt = obid() * NTHREADS + tid;
    if (gt < 2 * DM) { const int dir = gt / DM, c = gt % DM;
        float lg[DEPTH], mx = -1e30f;
#pragma unroll
        for (int j = 0; j < DEPTH; ++j) { lg[j] = p.lb_logits[((size_t)dir * DEPTH + j) * DM + c]; mx = fmaxf(mx, lg[j]); }
        float den = 0.f, num = 0.f;
#pragma unroll
        for (int j = 0; j < DEPTH; ++j) { const float e = expf(lg[j] - mx); den += e; if (j >= 1 && j <= l) num += e; }
        ((float*)(ws + WS_LB))[gt] = fmaxf(num / den, 1e-30f); }
}

__device__ __forceinline__ void prep_tables(const Params& p) {
    const int gt = obid() * NTHREADS + otid(), NT = ogrid() * NTHREADS;
    unsigned char* ws = p.ws;
    bf16_t* dseq = (bf16_t*)(ws + WS_DSEQ);
    const float sc1 = 0.02209708691207961f;
    for (int it = gt; it < 2048 * 512; it += NT) { const int sp = it / 512, k0 = (it % 512) * 8;
        unsigned w[4];
#pragma unroll
        for (int h = 0; h < 4; ++h) { float v[2];
#pragma unroll
            for (int q = 0; q < 2; ++q) { const int kc = k0 + 2 * h + q, s = kc & 2047; const int ph = (s * sp) & 2047; const float a = (float)ph * (1.f / 1024.f);
                v[q] = (kc >> 11) ? -sinpif(a) * sc1 : cospif(a) * sc1; }
            w[h] = pk2(v[0], v[1]); }
        *(u32x4*)(dseq + (size_t)sp * 4096 + k0) = (u32x4){w[0], w[1], w[2], w[3]}; }
    bf16_t* cd = (bf16_t*)(ws + WS_CDFT);
    for (int it = gt; it < 512 * 256; it += NT) { const int r = it / 256, c = it % 256, cp = r & 255; const int ph = (c * cp) & 255; const float a = (float)ph * (1.f / 128.f);
        const float v = (r >> 8) ? sinpif(a) : cospif(a); cd[it] = (bf16_t)f2bf(v * 0.0625f); }
    f32x2* rope = (f32x2*)(ws + WS_ROPE);
    for (int it = gt; it < TA * 128; it += NT) { const int tok = it >> 7, i = it & 127;
        const float inv = powf(10000.f, -(float)i * (1.f / 128.f));
        const float ang = (float)p.pos[tok] * inv;
        double t = (double)ang * 0.31830988618379067; t -= 2.0 * rint(t * 0.5); const float tf = (float)t;
        rope[it] = (f32x2){cospif(tf), sinpif(tf)}; }
}

__device__ __forceinline__ void rms_rows(const float* xsrc, const float* w, bf16_t* XN, int nrows) {
    const int tid = otid(), lane = tid & 63, gw = obid() * 8 + (tid >> 6), NGW = ogrid() * 8;
    f32x4 wv[4];
#pragma unroll
    for (int j = 0; j < 4; ++j) wv[j] = ((const f32x4*)w)[lane + 64 * j];
    for (int m = gw; m < nrows; m += NGW) {
        const f32x4* xr = (const f32x4*)(xsrc + (size_t)m * DM); f32x4 v[4]; float ss = 0.f;
#pragma unroll
        for (int j = 0; j < 4; ++j) { v[j] = xr[lane + 64 * j]; ss += (v[j][0] * v[j][0] + v[j][1] * v[j][1]) + (v[j][2] * v[j][2] + v[j][3] * v[j][3]); }
        const float r = rsqrtf(wave_sum(ss, lane) * (1.f / DM) + EPS);
        u32x2* o = (u32x2*)(XN + (size_t)m * DM);
#pragma unroll
        for (int j = 0; j < 4; ++j) { const f32x4 y = v[j] * r * wv[j]; o[lane + 64 * j] = (u32x2){pk2(y[0], y[1]), pk2(y[2], y[3])}; }
    }
}
__device__ __forceinline__ void resid_rows(const bf16_t* V, const float* xsrc, float* out, const float* w1, const float* w2, bf16_t* HN) {
    const int tid = otid(), lane = tid & 63, gw = obid() * 8 + (tid >> 6), NGW = ogrid() * 8;
    for (int m = gw; m < TA; m += NGW) {
        const u32x2* vr = (const u32x2*)(V + (size_t)m * DM); const f32x4* xr = (const f32x4*)(xsrc + (size_t)m * DM); f32x4 v[4]; float ss = 0.f;
#pragma unroll
        for (int j = 0; j < 4; ++j) { const u32x2 vw = vr[lane + 64 * j]; v[j] = (f32x4){bflo(vw.x), bfhi(vw.x), bflo(vw.y), bfhi(vw.y)}; ss += (v[j][0] * v[j][0] + v[j][1] * v[j][1]) + (v[j][2] * v[j][2] + v[j][3] * v[j][3]); }
        const float r = rsqrtf(wave_sum(ss, lane) * (1.f / DM) + EPS); float s2 = 0.f;
#pragma unroll
        for (int j = 0; j < 4; ++j) { v[j] = xr[lane + 64 * j] + v[j] * r * ((const f32x4*)w1)[lane + 64 * j]; ((f32x4*)(out + (size_t)m * DM))[lane + 64 * j] = v[j];
            s2 += (v[j][0] * v[j][0] + v[j][1] * v[j][1]) + (v[j][2] * v[j][2] + v[j][3] * v[j][3]); }
        if (HN) { const float r2 = rsqrtf(wave_sum(s2, lane) * (1.f / DM) + EPS); u32x2* o = (u32x2*)(HN + (size_t)m * DM);
#pragma unroll
            for (int j = 0; j < 4; ++j) { const f32x4 y = v[j] * r2 * ((const f32x4*)w2)[lane + 64 * j]; o[lane + 64 * j] = (u32x2){pk2(y[0], y[1]), pk2(y[2], y[3])}; } }
    }
}

__device__ __forceinline__ float gelu_tanh(float x) { const float y = 0.7978845608028654f * (x + 0.044715f * x * x * x); const float t = 1.f - 2.f * __builtin_amdgcn_rcpf(1.f + __builtin_amdgcn_exp2f(2.8853900817779268f * y)); return 0.5f * x * (1.f + t); }
__device__ __forceinline__ void ld8(const bf16_t* p, float (&v)[8]) { const u32x4 w = *(const u32x4*)p; v[0] = bflo(w.x); v[1] = bfhi(w.x); v[2] = bflo(w.y); v[3] = bfhi(w.y); v[4] = bflo(w.z); v[5] = bfhi(w.z); v[6] = bflo(w.w); v[7] = bfhi(w.w); }
__device__ __forceinline__ void conv_phase(const bf16_t* H, const float* cw, const float* cb, bf16_t* ACT) {
    constexpr int RB = 16, NCH = DFF / 8;
    const int gt = obid() * NTHREADS + otid(), NT = ogrid() * NTHREADS;
    for (int it = gt; it < (TA / RB) * NCH; it += NT) {
        const int ch = it % NCH, rb = it / NCH, c0 = ch * 8, m0 = rb * RB, s0 = m0 % SEQ;
        float wg[3][8], wu[3][8], bg[8], bu[8];
#pragma unroll
        for (int t = 0; t < 3; ++t)
#pragma unroll
            for (int j = 0; j < 8; ++j) { wg[t][j] = cw[(size_t)t * 2 * DFF + c0 + j]; wu[t][j] = cw[(size_t)t * 2 * DFF + DFF + c0 + j]; }
#pragma unroll
        for (int j = 0; j < 8; ++j) { bg[j] = cb[c0 + j]; bu[j] = cb[DFF + c0 + j]; }
        float g0[8], g1[8], g2[8], u0[8], u1[8], u2[8];
        if (s0 > 0) { ld8(H + (size_t)(m0 - 1) * 2 * DFF + c0, g0); ld8(H + (size_t)(m0 - 1) * 2 * DFF + DFF + c0, u0); }
        else {
#pragma unroll
            for (int j = 0; j < 8; ++j) { g0[j] = 0.f; u0[j] = 0.f; } }
        ld8(H + (size_t)m0 * 2 * DFF + c0, g1); ld8(H + (size_t)m0 * 2 * DFF + DFF + c0, u1);
        for (int r = 0; r < RB; ++r) { const int m = m0 + r;
            if (s0 + r + 1 < SEQ) { ld8(H + (size_t)(m + 1) * 2 * DFF + c0, g2); ld8(H + (size_t)(m + 1) * 2 * DFF + DFF + c0, u2); }
            else {
#pragma unroll
                for (int j = 0; j < 8; ++j) { g2[j] = 0.f; u2[j] = 0.f; } }
            float o[8];
#pragma unroll
            for (int j = 0; j < 8; ++j) { const float gg = bg[j] + g0[j] * wg[0][j] + g1[j] * wg[1][j] + g2[j] * wg[2][j]; const float uu = bu[j] + u0[j] * wu[0][j] + u1[j] * wu[1][j] + u2[j] * wu[2][j]; o[j] = gelu_tanh(gg) * uu; }
            *(u32x4*)(ACT + (size_t)m * DFF + c0) = (u32x4){pk2(o[0], o[1]), pk2(o[2], o[3]), pk2(o[4], o[5]), pk2(o[6], o[7])};
#pragma unroll
            for (int j = 0; j < 8; ++j) { g0[j] = g1[j]; g1[j] = g2[j]; u0[j] = u1[j]; u1[j] = u2[j]; }
        }
    }
}

constexpr size_t G_RL = WS_G + 320 * MiB;
static_assert(G_RL + 32 * MiB <= 480 * MiB, "ws");
__device__ __forceinline__ void ret_local(const Params& p, unsigned char* lds, int item) {
    unsigned char* ws = p.ws;
    int tid_ = threadIdx.x; asm volatile("" : "+v"(tid_));
    const int tid = tid_, lane = tid & 63, w = tid >> 6, l15 = lane & 15, quad = lane >> 4;
    const int eq = item & 3, idx = (item >> 2) % 6, bh = (item >> 2) / 6, bl = bh >> 2, h = bh & 3;
    const int dirb = idx >= 3, m = dirb ? idx - 2 : idx;
    const float lg2 = log2f(1.f - exp2f(-5.f - (float)h));
    bf16_t* KT = (bf16_t*)lds;
    bf16_t* VTx = (bf16_t*)(lds + 20480);
    const bf16_t* Kg = (const bf16_t*)(ws + G_K) + ((size_t)(bl * SEQ + m * 512)) * DM + h * 256;
    const bf16_t* VT = (const bf16_t*)(ws + G_VT) + ((size_t)(h * 512 + eq * 128)) * TG + bl * SEQ + m * 512;
    const int kj = tid & 31, kc8 = (tid >> 5) * 8;
    const int ve = tid >> 2, vj8 = (tid & 3) * 8;
    f32x4 af[2][8];
#pragma unroll
    for (int i = 0; i < 2; ++i)
#pragma unroll
        for (int j = 0; j < 8; ++j) af[i][j] = (f32x4){0.f, 0.f, 0.f, 0.f};
    u32x4 kr0[2], kr1[2], kr2[2], kr3[2], vr0, vr1, vr2, vr3;
#define RL_LOAD(s, KR, VR) do { const int s_ = (s) < 16 ? (s) : 15; \
        _Pragma("unroll") for (int i = 0; i < 2; ++i) KR[i] = *(const u32x4*)(Kg + (size_t)(32 * s_ + kj) * DM + kc8 + 128 * i); \
        VR = *(const u32x4*)(VT + (size_t)ve * TG + 32 * s_ + vj8); } while (0)
    RL_LOAD(0, kr0, vr0); RL_LOAD(1, kr1, vr1); RL_LOAD(2, kr2, vr2);
    const int et0 = 2 * (w & 3), dt0 = 8 * (w >> 2);
    __syncthreads();
#define RL_STEP(s, KR, VR, KN, VN) do { \
        _Pragma("unroll") for (int i = 0; i < 2; ++i) { const int j = kj, c0 = kc8 + 128 * i; const unsigned wv[4] = {KR[i].x, KR[i].y, KR[i].z, KR[i].w}; \
            _Pragma("unroll") for (int q = 0; q < 4; ++q) { KT[(c0 + 2 * q) * 40 + j] = (bf16_t)(wv[q] & 0xffffu); KT[(c0 + 2 * q + 1) * 40 + j] = (bf16_t)(wv[q] >> 16); } } \
        { const unsigned wv[4] = {VR.x, VR.y, VR.z, VR.w}; unsigned ov[4]; \
          _Pragma("unroll") for (int q = 0; q < 4; ++q) { const int jj = 32 * (s) + vj8 + 2 * q; const float v0 = bflo(wv[q]), v1 = bfhi(wv[q]); \
              const float e0 = dirb ? (float)jj : (float)(511 - jj), e1 = dirb ? (float)(jj + 1) : (float)(510 - jj); \
              ov[q] = cvtpk(v0 * __builtin_amdgcn_exp2f(lg2 * e0), v1 * __builtin_amdgcn_exp2f(lg2 * e1)); } \
          *(u32x4*)(VTx + ve * 40 + vj8) = (u32x4){ov[0], ov[1], ov[2], ov[3]}; } \
        __syncthreads(); \
        RL_LOAD((s) + 3, KN, VN); \
        bf16x8 a0[2]; \
        _Pragma("unroll") for (int i = 0; i < 2; ++i) a0[i] = *(const bf16x8*)(VTx + (16 * (et0 + i) + l15) * 40 + quad * 8); \
        _Pragma("unroll") for (int j = 0; j < 8; ++j) { const bf16x8 b = *(const bf16x8*)(KT + (16 * (dt0 + j) + l15) * 40 + quad * 8); \
            _Pragma("unroll") for (int i = 0; i < 2; ++i) af[i][j] = mfma16(b, a0[i], af[i][j]); }       \
        __syncthreads(); } while (0)
    for (int s = 0; s < 16; s += 4) { RL_STEP(s, kr0, vr0, kr3, vr3); RL_STEP(s + 1, kr1, vr1, kr0, vr0); RL_STEP(s + 2, kr2, vr2, kr1, vr1); RL_STEP(s + 3, kr3, vr3, kr2, vr2); }
#undef RL_LOAD
#undef RL_STEP
    bf16_t* L = (bf16_t*)(ws + G_RL) + ((size_t)((bh * 4 + m) * 2 + dirb) * 512 + eq * 128) * 256;
#pragma unroll
    for (int i = 0; i < 2; ++i)
#pragma unroll
        for (int j = 0; j < 8; ++j)
            *(u32x2*)(L + (size_t)(16 * (et0 + i) + l15) * 256 + 16 * (dt0 + j) + 4 * quad) = (u32x2){cvtpk(af[i][j][0], af[i][j][1]), cvtpk(af[i][j][2], af[i][j][3])};
}

__device__ __forceinline__ void ret_item(const Params& p, unsigned char* lds, int item) {
    unsigned char* ws = p.ws;
    int tid_ = threadIdx.x; asm volatile("" : "+v"(tid_));
    const int tid = tid_, lane = tid & 63, w = tid >> 6, l15 = lane & 15, quad = lane >> 4;
    const int bh = item >> 5, bl = bh >> 2, h = bh & 3, qt = item & 31, cq = qt >> 3, kt0 = 8 * cq;
    const float lg2 = log2f(1.f - exp2f(-5.f - (float)h));
    bf16_t* Ks = (bf16_t*)lds;
    bf16_t* Ps = (bf16_t*)(lds + 67584);
    float* red = (float*)(lds + 86016);
    float* rstd = (float*)(lds + 88064);
    const bf16_t* Q = (const bf16_t*)(ws + G_Q) + ((size_t)(bl * SEQ + qt * 64)) * DM + h * 256;
    const bf16_t* Kg = (const bf16_t*)(ws + G_K) + ((size_t)(bl * SEQ)) * DM + h * 256;
    const bf16_t* VTw = (const bf16_t*)(ws + G_VT) + ((size_t)(h * 512 + 64 * w + l15)) * TG + bl * SEQ + quad * 16;
    const bf16_t* Lw = (const bf16_t*)(ws + G_RL) + ((size_t)(bh * 4) * 2 * 512 + 64 * w + l15) * 256 + quad * 16;
    const int ti = w >> 1, tj0 = (w & 1) * 2;
    bf16_t* Qs = (bf16_t*)(lds + 88320);
    const int kr = tid >> 5, kc = (tid & 31) * 8;
    const int prow = tid >> 3, pc8 = (tid & 7) * 8;
    const int pos = (qt & 7) * 64 + prow;
    u32x4 kA[4], kB[4], VA[8], VB[8];
#define RET_LOADV(g, V) do { if ((g) < 8) { const bf16_t* s_ = VTw + (kt0 + (g)) * 64; \
            _Pragma("unroll") for (int j = 0; j < 4; ++j) _Pragma("unroll") for (int kk = 0; kk < 2; ++kk) V[j * 2 + kk] = *(const u32x4*)(s_ + (size_t)(16 * j) * TG + kk * 8); } \
        else if ((g) < 20) { const int st_ = (g) - 8, mi_ = st_ >> 2, m_ = mi_ + (mi_ >= cq ? 1 : 0), ds_ = st_ & 3; \
            const bf16_t* s_ = Lw + ((size_t)(m_ * 2 + (m_ < cq ? 0 : 1)) * 512) * 256 + ds_ * 64; \
            _Pragma("unroll") for (int j = 0; j < 4; ++j) _Pragma("unroll") for (int kk = 0; kk < 2; ++kk) V[j * 2 + kk] = *(const u32x4*)(s_ + (size_t)(16 * j) * 256 + kk * 8); } } while (0)
#define RET_PV(Pw, V) do { _Pragma("unroll") for (int kk = 0; kk < 2; ++kk) { bf16x8 a[4]; \
            _Pragma("unroll") for (int i = 0; i < 4; ++i) a[i] = *(const bf16x8*)((Pw) + (16 * i + l15) * 72 + quad * 16 + kk * 8); \
            _Pragma("unroll") for (int i = 0; i < 4; ++i) _Pragma("unroll") for (int j = 0; j < 4; ++j) o[i][j] = mfma16(__builtin_bit_cast(bf16x8, V[j * 2 + kk]), a[i], o[i][j]); } } while (0)
#define RET_TILE(g, VCU, VN, KW) do { const int kt = kt0 + (g); const bf16_t* Kc = Ks + ((g) & 1) * (64 * 264); bf16_t* Pw = Ps + ((g) & 1) * (64 * 72); \
        f32x4 s0 = {0.f, 0.f, 0.f, 0.f}, s1 = {0.f, 0.f, 0.f, 0.f}; \
        _Pragma("unroll") for (int ks = 0; ks < 8; ++ks) { \
            const bf16x8 b0 = *(const bf16x8*)(Kc + (16 * tj0 + l15) * 264 + ks * 32 + quad * 8); \
            const bf16x8 b1 = *(const bf16x8*)(Kc + (16 * (tj0 + 1) + l15) * 264 + ks * 32 + quad * 8); \
            const bf16x8 qa = *(const bf16x8*)(Qs + (16 * ti + l15) * 264 + ks * 32 + quad * 8); \
            s0 = mfma16(qa, b0, s0); s1 = mfma16(qa, b1, s1); } \
        _Pragma("unroll") for (int r = 0; r < 4; ++r) { const int row = 16 * ti + 4 * quad + r, qpos = qt * 64 + row; \
            const int c0 = 16 * tj0 + l15, c1 = c0 + 16; \
            const float d0 = fabsf((float)(qpos - (kt * 64 + c0))), d1 = fabsf((float)(qpos - (kt * 64 + c1))); \
            Pw[row * 72 + c0] = (bf16_t)cvtpk(s0[r] * __builtin_amdgcn_exp2f(lg2 * d0), 0.f); \
            Pw[row * 72 + c1] = (bf16_t)cvtpk(s1[r] * __builtin_amdgcn_exp2f(lg2 * d1), 0.f); } \
        if ((g) + 1 < 8) { bf16_t* Kn = Ks + (((g) + 1) & 1) * (64 * 264); \
            _Pragma("unroll") for (int i = 0; i < 4; ++i) *(u32x4*)(Kn + (kr + 16 * i) * 264 + kc) = KW[i]; } \
        __syncthreads(); \
        RET_LOADV((g) + 1, VN); \
        if ((g) + 3 < 8) { _Pragma("unroll") for (int i = 0; i < 4; ++i) KW[i] = *(const u32x4*)(Kg + (size_t)((kt + 3) * 64 + kr + 16 * i) * DM + kc); } \
        RET_PV(Pw, VCU); } while (0)
#define RET_STATE(g, VCU, VN) do { bf16_t* Pw = Ps + ((g) & 1) * (64 * 72); \
        { const int mi = ((g) - 8) >> 2, m = mi + (mi >= cq ? 1 : 0); \
          const float ex = (m < cq) ? (float)(pos + 1 + (cq - 1 - m) * 512) : (float)(512 - pos + (m - cq - 1) * 512); \
          const float rs = __builtin_amdgcn_exp2f(lg2 * ex); const u32x4 qreg = *(const u32x4*)(Qs + prow * 264 + (((g) - 8) & 3) * 64 + pc8); \
          *(u32x4*)(Pw + prow * 72 + pc8) = (u32x4){cvtpk(bflo(qreg.x) * rs, bfhi(qreg.x) * rs), cvtpk(bflo(qreg.y) * rs, bfhi(qreg.y) * rs), cvtpk(bflo(qreg.z) * rs, bfhi(qreg.z) * rs), cvtpk(bflo(qreg.w) * rs, bfhi(qreg.w) * rs)}; } \
        __syncthreads(); \
        RET_LOADV((g) + 1, VN); \
        RET_PV(Pw, VCU); } while (0)
    __syncthreads();
#pragma unroll
    for (int i = 0; i < 4; ++i) { *(u32x4*)(Ks + (kr + 16 * i) * 264 + kc) = *(const u32x4*)(Kg + (size_t)(kt0 * 64 + kr + 16 * i) * DM + kc);
        *(u32x4*)(Qs + (kr + 16 * i) * 264 + kc) = *(const u32x4*)(Q + (size_t)(kr + 16 * i) * DM + kc); }
    RET_LOADV(0, VA);
#pragma unroll
    for (int i = 0; i < 4; ++i) { kB[i] = *(const u32x4*)(Kg + (size_t)((kt0 + 1) * 64 + kr + 16 * i) * DM + kc);
        kA[i] = *(const u32x4*)(Kg + (size_t)((kt0 + 2) * 64 + kr + 16 * i) * DM + kc); }
    f32x4 o[4][4];
#pragma unroll
    for (int i = 0; i < 4; ++i)
#pragma unroll
        for (int j = 0; j < 4; ++j) o[i][j] = (f32x4){0.f, 0.f, 0.f, 0.f};
    __syncthreads();
#define RET_STEP(g, VCUR, VNXT, KW) do { if ((g) < 8) RET_TILE(g, VCUR, VNXT, KW); else RET_STATE(g, VCUR, VNXT); } while (0)
    for (int g = 0; g < 20; g += 2) { RET_STEP(g, VA, VB, kB); RET_STEP(g + 1, VB, VA, kA); }
#undef RET_STEP
#undef RET_LOADV
#undef RET_PV
#undef RET_TILE
#undef RET_STATE
#pragma unroll
    for (int i = 0; i < 4; ++i) { float s = 0.f;
#pragma unroll
        for (int j = 0; j < 4; ++j)
#pragma unroll
            for (int r = 0; r < 4; ++r) s += o[i][j][r] * o[i][j][r];
        s += shx(s, 16, lane); s += shx(s, 32, lane);
        if (quad == 0) red[w * 64 + 16 * i + l15] = s; }
    __syncthreads();
    if (tid < 64) { float s = 0.f;
#pragma unroll
        for (int ww = 0; ww < 8; ++ww) s += red[ww * 64 + tid];
        rstd[tid] = rsqrtf(s * (1.f / 512.f) + EPS); }
    __syncthreads();
    bf16_t* RO = (bf16_t*)(ws + G_SGR) + ((size_t)(bl * SEQ + qt * 64)) * 2048 + h * 512 + 64 * w + 4 * quad;
    u32x2 gv[4][4];
#pragma unroll
    for (int i = 0; i < 4; ++i)
#pragma unroll
        for (int j = 0; j < 4; ++j) gv[i][j] = *(const u32x2*)(RO + (size_t)(16 * i + l15) * 2048 + 16 * j);
#pragma unroll
    for (int i = 0; i < 4; ++i) { const float rs = rstd[16 * i + l15];
#pragma unroll
        for (int j = 0; j < 4; ++j) { const f32x4 v = o[i][j] * rs;
            *(u32x2*)(RO + (size_t)(16 * i + l15) * 2048 + 16 * j) = (u32x2){cvtpk(v[0] * bflo(gv[i][j].x), v[1] * bfhi(gv[i][j].x)), cvtpk(v[2] * bflo(gv[i][j].y), v[3] * bfhi(gv[i][j].y))}; } }
}

struct HgRaw { unsigned q[8], l[8]; u32x4 v0, v1; };
__device__ __forceinline__ void hgrn_load(HgRaw& R, const bf16_t* HQ, const bf16_t* LF, const bf16_t* HI, int c, int dir, int d2, int tg, int vt, int veg) {
#pragma unroll
    for (int i = 0; i < 8; ++i) { const int tau = 32 * c + 8 * tg + i, s = dir ? (SEQ - 1 - tau) : tau; R.q[i] = *(const unsigned*)(HQ + (size_t)s * DM + 2 * d2); R.l[i] = *(const unsigned*)(LF + (size_t)s * DM + 2 * d2); }
    { const int tau = 32 * c + vt, s = dir ? (SEQ - 1 - tau) : tau; R.v0 = *(const u32x4*)(HI + (size_t)s * DM + veg * 16); R.v1 = *(const u32x4*)(HI + (size_t)s * DM + veg * 16 + 8); }
}
__device__ __forceinline__ void hgrn_prep(const HgRaw& R, bf16_t* Qe, bf16_t* Ke, bf16_t* KdT, float* decs, bf16_t* VTs, int d2, int tg, int vt, int veg, int lane) {
    float b0[8], b1[8], l0[8], l1[8]; float run0 = 0.f, run1 = 0.f;
#pragma unroll
    for (int i = 0; i < 8; ++i) { l0[i] = bflo(R.l[i]); l1[i] = bfhi(R.l[i]); run0 += l0[i]; run1 += l1[i]; b0[i] = run0; b1[i] = run1; }
    float pre0, pre1, bl0, bl1;
    { const float r1 = shx(run0, 1, lane), s2 = run0 + r1, s2x = shx(s2, 2, lane); bl0 = s2 + s2x; pre0 = ((tg & 1) ? r1 : 0.f) + ((tg & 2) ? s2x : 0.f); }
    { const float r1 = shx(run1, 1, lane), s2 = run1 + r1, s2x = shx(s2, 2, lane); bl1 = s2 + s2x; pre1 = ((tg & 1) ? r1 : 0.f) + ((tg & 2) ? s2x : 0.f); }
    const float c30 = __builtin_amdgcn_exp2f(bl0), c31 = __builtin_amdgcn_exp2f(bl1);
    float kd0[8], kd1[8];
#pragma unroll
    for (int i = 0; i < 8; ++i) { const int t = 8 * tg + i;
        const float bb0 = b0[i] + pre0, bb1 = b1[i] + pre1;
        const float k0 = 1.f - __builtin_amdgcn_exp2f(l0[i]), k1 = 1.f - __builtin_amdgcn_exp2f(l1[i]);
        const float ke0 = k0 * __builtin_amdgcn_exp2f(fminf(-bb0, 115.f)), ke1 = k1 * __builtin_amdgcn_exp2f(fminf(-bb1, 115.f));
        *(unsigned*)(Qe + t * 136 + 2 * d2) = cvtpk(bflo(R.q[i]) * __builtin_amdgcn_exp2f(bb0), bfhi(R.q[i]) * __builtin_amdgcn_exp2f(bb1));
        *(unsigned*)(Ke + t * 136 + 2 * d2) = cvtpk(ke0, ke1);
        kd0[i] = ke0 * c30; kd1[i] = ke1 * c31;
        if (__builtin_expect(!(bl0 > -86.f && bl1 > -86.f), 0)) { kd0[i] = k0 * __builtin_amdgcn_exp2f(bl0 - bb0); kd1[i] = k1 * __builtin_amdgcn_exp2f(bl1 - bb1); } }
    *(u32x4*)(KdT + (2 * d2) * 40 + 8 * tg) = (u32x4){cvtpk(kd0[0], kd0[1]), cvtpk(kd0[2], kd0[3]), cvtpk(kd0[4], kd0[5]), cvtpk(kd0[6], kd0[7])};
    *(u32x4*)(KdT + (2 * d2 + 1) * 40 + 8 * tg) = (u32x4){cvtpk(kd1[0], kd1[1]), cvtpk(kd1[2], kd1[3]), cvtpk(kd1[4], kd1[5]), cvtpk(kd1[6], kd1[7])};
    if (tg == 0) { decs[2 * d2] = c30; decs[2 * d2 + 1] = c31; }
    { const unsigned wv[8] = {R.v0.x, R.v0.y, R.v0.z, R.v0.w, R.v1.x, R.v1.y, R.v1.z, R.v1.w};
#pragma unroll
      for (int q = 0; q < 8; ++q) { VTs[(16 * veg + 2 * q) * 40 + vt] = (bf16_t)(wv[q] & 0xffffu); VTs[(16 * veg + 2 * q + 1) * 40 + vt] = (bf16_t)(wv[q] >> 16); } }
}
__device__ __forceinline__ void hgrn_item(const Params& p, unsigned char* lds, int item) {
    unsigned char* ws = p.ws;
    int tid_ = threadIdx.x; asm volatile("" : "+v"(tid_));
    const int tid = tid_, lane = tid & 63, w = tid >> 6, l15 = lane & 15, quad = lane >> 4;
    const int dir = item & 1, h = (item >> 1) & 7, bl = item >> 4;
    bf16_t* Qe2 = (bf16_t*)lds;
    bf16_t* Ke2 = (bf16_t*)(lds + 17408);
    bf16_t* KdT2 = (bf16_t*)(lds + 34816);
    bf16_t* VTs2 = (bf16_t*)(lds + 55296);
    float* decs2 = (float*)(lds + 75776);
    bf16_t* Ps = (bf16_t*)(lds + 76800);
    bf16_t* StT = (bf16_t*)(lds + 79360);
    const bf16_t* HQ = (const bf16_t*)(ws + G_HQ) + (size_t)bl * SEQ * DM + h * 128;
    const bf16_t* LF = (const bf16_t*)(ws + (dir ? G_LFB : G_LFF)) + (size_t)bl * SEQ * DM + h * 128;
    const bf16_t* HI = (const bf16_t*)(ws + G_HI) + (size_t)bl * SEQ * DM + h * 128;
    bf16_t* HO = (bf16_t*)(ws + (dir ? G_HOB : G_HOF)) + (size_t)bl * SEQ * DM + h * 128;
    __syncthreads();
    for (int i = tid; i < 128 * 136 / 2; i += NTHREADS) ((unsigned*)StT)[i] = 0u;
    if (w < 4) {
        const int d2 = tid >> 2, tg = tid & 3, vt = tid & 31, veg = tid >> 5;
        HgRaw RA, RB;
        hgrn_load(RA, HQ, LF, HI, 0, dir, d2, tg, vt, veg);
        hgrn_load(RB, HQ, LF, HI, 1, dir, d2, tg, vt, veg);
        hgrn_prep(RA, Qe2, Ke2, KdT2, decs2, VTs2, d2, tg, vt, veg, lane);
        __syncthreads();
#define HG_PROD(c, RP, RL) do { \
            if ((c) + 2 < 64) hgrn_load(RL, HQ, LF, HI, (c) + 2, dir, d2, tg, vt, veg); \
            if ((c) + 1 < 64) { const int pb = ((c) + 1) & 1; \
                hgrn_prep(RP, Qe2 + pb * (32 * 136), Ke2 + pb * (32 * 136), KdT2 + pb * (128 * 40), decs2 + pb * 128, VTs2 + pb * (128 * 40), d2, tg, vt, veg, lane); } \
            __syncthreads(); __syncthreads(); } while (0)
        for (int c = 0; c < 64; c += 2) { HG_PROD(c, RB, RA); HG_PROD(c + 1, RA, RB); }
#undef HG_PROD
    } else {
        const int cw = w - 4;
        const int oti = cw >> 1, otj = cw & 1;
        f32x4 st[2][8];
#pragma unroll
        for (int dj = 0; dj < 2; ++dj)
#pragma unroll
            for (int j = 0; j < 8; ++j) st[dj][j] = (f32x4){0.f, 0.f, 0.f, 0.f};
        __syncthreads();
        for (int c = 0; c < 64; ++c) {
            const int pb = c & 1;
            const bf16_t* Qe = Qe2 + pb * (32 * 136); const bf16_t* Ke = Ke2 + pb * (32 * 136); const bf16_t* KdT = KdT2 + pb * (128 * 40);
            const bf16_t* VTs = VTs2 + pb * (128 * 40); const float* decs = decs2 + pb * 128;
            f32x4 ao[2][2];
#pragma unroll
            for (int ej = 0; ej < 2; ++ej)
#pragma unroll
                for (int ti = 0; ti < 2; ++ti) ao[ej][ti] = (f32x4){0.f, 0.f, 0.f, 0.f};
#pragma unroll
            for (int ks = 0; ks < 4; ++ks) { bf16x8 sf[2], qf2[2];
#pragma unroll
                for (int ej = 0; ej < 2; ++ej) sf[ej] = *(const bf16x8*)(StT + (16 * (2 * cw + ej) + l15) * 136 + ks * 32 + quad * 8);
#pragma unroll
                for (int ti = 0; ti < 2; ++ti) qf2[ti] = *(const bf16x8*)(Qe + (16 * ti + l15) * 136 + ks * 32 + quad * 8);
#pragma unroll
                for (int ej = 0; ej < 2; ++ej)
#pragma unroll
                    for (int ti = 0; ti < 2; ++ti) ao[ej][ti] = mfma16(sf[ej], qf2[ti], ao[ej][ti]); }
            { f32x4 acc = {0.f, 0.f, 0.f, 0.f};
#pragma unroll
              for (int ks = 0; ks < 4; ++ks) { const bf16x8 a = *(const bf16x8*)(Qe + (16 * oti + l15) * 136 + ks * 32 + quad * 8); const bf16x8 bb = *(const bf16x8*)(Ke + (16 * otj + l15) * 136 + ks * 32 + quad * 8); acc = mfma16(bb, a, acc); }
              const int t = 16 * oti + l15, s0 = 16 * otj + 4 * quad;
              *(u32x2*)(Ps + t * 40 + s0) = (u32x2){cvtpk(s0 <= t ? acc[0] : 0.f, s0 + 1 <= t ? acc[1] : 0.f), cvtpk(s0 + 2 <= t ? acc[2] : 0.f, s0 + 3 <= t ? acc[3] : 0.f)}; }
            { bf16x8 kf[2]; f32x4 dc[2];
#pragma unroll
              for (int dj = 0; dj < 2; ++dj) { kf[dj] = *(const bf16x8*)(KdT + (16 * (2 * cw + dj) + l15) * 40 + quad * 8); dc[dj] = *(const f32x4*)(decs + 16 * (2 * cw + dj) + 4 * quad); }
#pragma unroll
              for (int j = 0; j < 8; ++j) { const bf16x8 vf = *(const bf16x8*)(VTs + (16 * j + l15) * 40 + quad * 8);
#pragma unroll
                  for (int dj = 0; dj < 2; ++dj) st[dj][j] = mfma16(kf[dj], vf, st[dj][j] * dc[dj]); } }
            __syncthreads();
            { bf16x8 pf[2];
#pragma unroll
              for (int ti = 0; ti < 2; ++ti) pf[ti] = *(const bf16x8*)(Ps + (16 * ti + l15) * 40 + quad * 8);
#pragma unroll
              for (int ej = 0; ej < 2; ++ej) { const bf16x8 vf = *(const bf16x8*)(VTs + (16 * (2 * cw + ej) + l15) * 40 + quad * 8);
#pragma unroll
                  for (int ti = 0; ti < 2; ++ti) { ao[ej][ti] = mfma16(vf, pf[ti], ao[ej][ti]);
                      const int tau = 32 * c + 16 * ti + l15, s = dir ? (SEQ - 1 - tau) : tau;
                      *(u32x2*)(HO + (size_t)s * DM + 16 * (2 * cw + ej) + 4 * quad) = (u32x2){cvtpk(ao[ej][ti][0], ao[ej][ti][1]), cvtpk(ao[ej][ti][2], ao[ej][ti][3])}; } } }
#pragma unroll
            for (int dj = 0; dj < 2; ++dj)
#pragma unroll
                for (int j = 0; j < 8; ++j)
                    *(u32x2*)(StT + (16 * j + l15) * 136 + 16 * (2 * cw + dj) + 4 * quad) = (u32x2){cvtpk(st[dj][j][0], st[dj][j][1]), cvtpk(st[dj][j][2], st[dj][j][3])};
            __syncthreads();
        }
    }
}

__device__ __forceinline__ void seq_combine(const bf16_t* OZ, const bf16_t* PQT, bf16_t* YF) {
    constexpr int LD = NB * 1024;
    const int tid = otid(), gt = obid() * NTHREADS + tid, NT = ogrid() * NTHREADS;
    for (int it = gt; it < 1024 * LD / 8; it += NT) { const int sp = it / (LD / 8), n0 = (it % (LD / 8)) * 8, bl = n0 >> 10, gc = n0 & 1023;
        float av[8], bv[8]; ld8(OZ + (size_t)sp * LD + n0, av); ld8(OZ + (size_t)(1024 + sp) * LD + n0, bv);
        const f32x4 a0 = {av[0], av[1], av[2], av[3]}, a1 = {av[4], av[5], av[6], av[7]}, b0 = {bv[0], bv[1], bv[2], bv[3]}, b1 = {bv[4], bv[5], bv[6], bv[7]};
        *(u32x4*)(YF + ((size_t)(bl * SEQ + sp)) * DM + gc) = (u32x4){pk2(a0[0] + b0[0], a0[1] + b0[1]), pk2(a0[2] + b0[2], a0[3] + b0[3]), pk2(a1[0] + b1[0], a1[1] + b1[1]), pk2(a1[2] + b1[2], a1[3] + b1[3])};
        if (sp > 0) *(u32x4*)(YF + ((size_t)(bl * SEQ + SEQ - sp)) * DM + gc) = (u32x4){pk2(a0[0] - b0[0], a0[1] - b0[1]), pk2(a0[2] - b0[2], a0[3] - b0[3]), pk2(a1[0] - b1[0], a1[1] - b1[1]), pk2(a1[2] - b1[2], a1[3] - b1[3])}; }
    const int lane = tid & 63, gw = obid() * 8 + (tid >> 6), NGW = ogrid() * 8;
    for (int n = gw; n < LD; n += NGW) { const bf16_t* pr = PQT + (size_t)n * 4096 + lane * 32; float s = 0.f;
#pragma unroll
        for (int q = 0; q < 4; ++q) { float v[8]; ld8(pr + 8 * q, v); s += (v[0] - v[1]) + (v[2] - v[3]) + (v[4] - v[5]) + (v[6] - v[7]); }
        s = wave_sum(s, lane);
        if (lane == 0) YF[((size_t)((n >> 10) * SEQ + 1024)) * DM + (n & 1023)] = (bf16_t)f2bf(s * 0.02209708691207961f); }
}

__device__ __forceinline__ void mix_combine(const bf16_t* F1, const bf16_t* F2, bf16_t* MIX, int rank, int nblk) {
    const int gt = rank * NTHREADS + otid(), NT = nblk * NTHREADS;
    for (int it = gt; it < TG * DM / 8; it += NT) { const size_t o = (size_t)it * 8; float a[8], b[8]; ld8(F1 + o, a); ld8(F2 + o, b);
        *(u32x4*)(MIX + o) = (u32x4){pk2(a[0] + b[0], a[1] + b[1]), pk2(a[2] + b[2], a[3] + b[3]), pk2(a[4] + b[4], a[5] + b[5]), pk2(a[6] + b[6], a[7] + b[7])}; }
}

__device__ __forceinline__ void hgrn_combine(const Params& p, int l) {
    unsigned char* ws = p.ws;
    const int tid = otid(), lane = tid & 63, gw = obid() * 8 + (tid >> 6), NGW = ogrid() * 8;
    const bf16_t* HOF = (const bf16_t*)(ws + G_HOF); const bf16_t* HOB = (const bf16_t*)(ws + G_HOB); bf16_t* SG = (bf16_t*)(ws + G_SGH);
    const float* nw = p.hgrn_norm_w + (size_t)l * 128;
    float nwv[2][8];
#pragma unroll
    for (int i = 0; i < 2; ++i)
#pragma unroll
        for (int j = 0; j < 8; ++j) nwv[i][j] = nw[(((lane + 64 * i) * 8) & 127) + j];
    for (int m0 = gw; m0 < TG; m0 += 2 * NGW) {
        u32x4 av[2][2], bv[2][2], gv[2][2];
#pragma unroll
        for (int r = 0; r < 2; ++r) { const int m = m0 + r * NGW;
#pragma unroll
            for (int i = 0; i < 2; ++i) { const size_t o = (size_t)m * DM + (lane + 64 * i) * 8;
                if (m < TG) { av[r][i] = *(const u32x4*)(HOF + o); bv[r][i] = *(const u32x4*)(HOB + o); gv[r][i] = *(const u32x4*)(SG + o); } } }
#pragma unroll
        for (int r = 0; r < 2; ++r) { const int m = m0 + r * NGW;
            if (m < TG) {
#pragma unroll
                for (int i = 0; i < 2; ++i) { const size_t o = (size_t)m * DM + (lane + 64 * i) * 8;
                    const unsigned aw[4] = {av[r][i].x, av[r][i].y, av[r][i].z, av[r][i].w}, bw[4] = {bv[r][i].x, bv[r][i].y, bv[r][i].z, bv[r][i].w}, gw4[4] = {gv[r][i].x, gv[r][i].y, gv[r][i].z, gv[r][i].w};
                    float a[8]; float ss = 0.f;
#pragma unroll
                    for (int q = 0; q < 4; ++q) { a[2 * q] = bflo(aw[q]) + bflo(bw[q]); a[2 * q + 1] = bfhi(aw[q]) + bfhi(bw[q]); ss += a[2 * q] * a[2 * q] + a[2 * q + 1] * a[2 * q + 1]; }
                    ss += shx(ss, 1, lane); ss += shx(ss, 2, lane); ss += shx(ss, 4, lane); ss += shx(ss, 8, lane);
                    const float rr = rsqrtf(ss * (1.f / 128.f) + EPS); unsigned ow[4];
#pragma unroll
                    for (int q = 0; q < 4; ++q) ow[q] = pk2(a[2 * q] * rr * nwv[i][2 * q] * bflo(gw4[q]), a[2 * q + 1] * rr * nwv[i][2 * q + 1] * bfhi(gw4[q]));
                    *(u32x4*)(SG + o) = (u32x4){ow[0], ow[1], ow[2], ow[3]}; } } }
    }
}

#define XB_TMO      128
#define XB_XCNT(j)  (256  + 64 * (j))
#define XB_XSUB(j)  (1280 + 64 * (j))
#define XB_XGEN(j)  (2304 + 64 * (j))
#define XB_TOP      3328
#define XB_TOPGEN   3392
#define XCD_BAR_WORDS 3456
#define XB_SPIN_CAP (1u << 22)
__device__ __forceinline__ unsigned xb_ld(unsigned* p)              { return __hip_atomic_load(p, __ATOMIC_RELAXED, __HIP_MEMORY_SCOPE_AGENT); }
__device__ __forceinline__ unsigned xb_add(unsigned* p, unsigned v) { return __hip_atomic_fetch_add(p, v, __ATOMIC_RELAXED, __HIP_MEMORY_SCOPE_AGENT); }
__device__ __forceinline__ unsigned xb_xcc_id() { return (unsigned)__builtin_amdgcn_s_getreg((3 << 11) | 20) & 0xFu; }
#define XB_SPIN(cond, bar) do { unsigned _sp = 0; while (cond) { __builtin_amdgcn_s_sleep(1); \
    if ((++_sp & 255u) == 0u) { if (xb_ld(&(bar)[XB_TMO])) break; if (_sp > XB_SPIN_CAP) { atomicAdd(&(bar)[XB_TMO], 1u); break; } } } } while (0)
__device__ __forceinline__ void xcd_barrier_complete(unsigned* bar, unsigned x, unsigned G, unsigned& nloc, unsigned& nx) {
    unsigned sum, cnt, mine, sp = 0u;
    for (;;) {
        sum = 0u; cnt = 0u; mine = 0u;
#pragma unroll
        for (unsigned j = 0; j < 16; ++j) { const unsigned c = xb_ld(&bar[XB_XCNT(j)]); sum += c; cnt += (c > 0u) ? 1u : 0u; mine = (j == x) ? c : mine; }
        if (sum == G) break;
        __builtin_amdgcn_s_sleep(1);
        if ((++sp & 255u) == 0u) { if (xb_ld(&bar[XB_TMO])) break; if (sp > XB_SPIN_CAP) { atomicAdd(&bar[XB_TMO], 1u); break; } }
    }
    nloc = mine > 0u ? mine : 1u; nx = cnt > 0u ? cnt : 1u;
}
__device__ __forceinline__ void xcd_barrier(unsigned* bar, volatile LAS unsigned* st, unsigned nparts) {
    asm volatile("s_waitcnt vmcnt(0)" ::: "memory");
    __syncthreads();
    if (threadIdx.x == 0) {
        const unsigned x = xb_xcc_id();
        __builtin_amdgcn_s_waitcnt(0);
        unsigned nloc = st[0], nx = st[1];
        if (nloc == 0u) { xcd_barrier_complete(bar, x, nparts, nloc, nx); st[0] = nloc; st[1] = nx; }
        const unsigned old = xb_add(&bar[XB_XSUB(x)], 1u);
        const unsigned gen = old / nloc;
        if (old + 1u == (gen + 1u) * nloc) {
            __builtin_amdgcn_fence(__ATOMIC_RELEASE, "agent");
            asm volatile("s_waitcnt vmcnt(0)" ::: "memory");
            const unsigned og = xb_add(&bar[XB_TOP], 1u);
            const unsigned tg = og / nx;
            if (og + 1u == (tg + 1u) * nx) xb_add(&bar[XB_TOPGEN], 1u);
            else XB_SPIN(xb_ld(&bar[XB_TOPGEN]) == tg, bar);
            __builtin_amdgcn_fence(__ATOMIC_ACQUIRE, "agent");
            xb_add(&bar[XB_XGEN(x)], 1u);
            asm volatile("s_waitcnt vmcnt(0)" ::: "memory");
        } else {
            XB_SPIN(xb_ld(&bar[XB_XGEN(x)]) == gen, bar);
            __builtin_amdgcn_fence(__ATOMIC_ACQUIRE, "agent");
            asm volatile("s_waitcnt vmcnt(0)" ::: "memory");
        }
    }
    __syncthreads();
}

typedef const Params __attribute__((address_space(4)))* KParams;
__global__ void __launch_bounds__(NTHREADS, 2) fwd_kernel(Params pk) {
    extern __shared__ __attribute__((aligned(16))) unsigned char lds_raw[];
    LAS unsigned char* lds = (LAS unsigned char*)lds_raw;
    cg::grid_group grid = cg::this_grid();
    volatile LAS unsigned* bst = (volatile LAS unsigned*)(lds + LDS_BYTES - 16);
    unsigned* gbar = (unsigned*)(pk.ws + WS_BAR);
    volatile LAS unsigned* bst2 = (volatile LAS unsigned*)(lds + LDS_BYTES - 32);
    constexpr int NHG = NB * 8 * 2;
    const bool coop = (pk.ph_hi - pk.ph_lo > 1);
    if (coop) {
        if (threadIdx.x == 0) { bst[0] = 0u; bst[1] = 0u; bst2[0] = 0u; bst2[1] = 0u; (void)xb_add(&gbar[XB_XCNT(xb_xcc_id())], 1u);
            if ((int)blockIdx.x >= NHG) (void)xb_add(&gbar[4096 + XB_XCNT(xb_xcc_id())], 1u); }
        __syncthreads();
    }
    const int lo = pk.ph_lo, hi = pk.ph_hi;
    int ph = 0;
#define PH_BEGIN if (ph >= lo && ph < hi) { KParams kp = (KParams)__builtin_amdgcn_kernarg_segment_ptr(); asm volatile("" : "+s"(kp)); Params p; __builtin_memcpy(&p, (const void __attribute__((address_space(4)))*)kp, sizeof(Params)); \
        unsigned char* ws = p.ws; const int G = ogrid(), cb = obid(); const float* xsrc = (l == 0) ? p.x : p.out; const float* nw = p.norm_w + (size_t)l * 4 * DM;
#define PH_END   if (ph + 1 < hi) { if (lo < 0) grid.sync(); else xcd_barrier((unsigned*)(ws + WS_BAR), bst, gridDim.x); } } ++ph;

    for (int l = 0; l < DEPTH; ++l) {
        if (l == 0) {
        PH_BEGIN
            prep_tables(p); rms_rows(p.x, nw, (bf16_t*)(ws + WS_MIXIN), TA);
            prep_weights(p, 0, lds);
        PH_END
        }
        for (int g = 0; g < NGRP; ++g) {
            const int tok0 = g * TG;
            PH_BEGIN
                const bf16_t* XN = (const bf16_t*)(ws + WS_MIXIN) + (size_t)tok0 * DM;
                if (g > 0 && cb >= (G >> 1)) mix_combine((const bf16_t*)(ws + G_F1), (const bf16_t*)(ws + G_F2), (bf16_t*)(ws + WS_MIXIN) + (size_t)(tok0 - TG) * DM, cb - (G >> 1), G - (G >> 1));
                __syncthreads();
                { pg8::Gemm gm{XN, (const bf16_t*)(ws + WS_WIN), DM, DM, DM}; pg8::SchedInProj S; S.init(G, cb);
                  pg8::EpiInProj E{ws, (const float*)(ws + WS_ROPE), (const float*)(ws + WS_LB), tok0};
                  pg8::gemm_phase<pg8::EpiInProj, pg8::SchedInProj>(lds, gm, S, E); }
                __syncthreads();
                { pg8::Gemm gm{(const bf16_t*)(ws + WS_WIN) + (size_t)2048 * DM, XN, DM, DM, DM}; pg8::SchedPlain S; S.init(2048, TG, DM, DM, G, cb);
                  pg8::EpiBf16<TG> E{(bf16_t*)(ws + G_VT)};
                  pg8::gemm_phase<pg8::EpiBf16<TG>, pg8::SchedPlain>(lds, gm, S, E); }
            PH_END
            PH_BEGIN
                const bool split = coop && G > 2 * NHG;
                int chG = G, chC = cb, chBase = 0, chLim = 4 * 2 * (TG / 256); bool chDo = true;
                const bool xaware = split && G == 256 && NB == 4;
                if (split && cb < NHG) { hgrn_item(p, lds_raw, cb);
                    if (xaware) { chG = NHG; chC = cb; chBase = 0; chLim = 2 * NHG; }
                    else chDo = false; }
                else {
                    const int Gs = split ? G - NHG : G, cs = split ? cb - NHG : cb;
                    if (!split) for (int it = cb; it < NB * 8 * 2; it += G) hgrn_item(p, lds_raw, it);
                    for (int it = cs; it < NB * 4 * 6 * 4; it += Gs) ret_local(p, lds_raw, it);
                    if (split) xcd_barrier((unsigned*)(ws + WS_BAR) + 4096, bst2, (unsigned)Gs);
                    else if (coop) xcd_barrier((unsigned*)(ws + WS_BAR), bst, gridDim.x);
                    constexpr int NRI = NB * 4 * 32;
                    if (xaware) {
                        const int x = cb & 7, j = cs >> 3;
                        for (int idx = j; idx < 64; idx += 24) ret_item(p, lds_raw, (2 * x) * 32 + idx);
                        chDo = j >= 16; chG = 64; chC = (j - 16) * 8 + x; chBase = 2 * NHG; chLim = 4 * NHG;
                    } else {
                        for (int it = cs; it < NRI; it += Gs) ret_item(p, lds_raw, it);
                        const int nfull = split ? NRI % Gs : 0;
                        chDo = cs >= nfull; chG = Gs - nfull; chC = cs - nfull;
                    }
                }
                __syncthreads();
                if (chDo) { pg8::Gemm gm{(const bf16_t*)(ws + WS_CDFT), (const bf16_t*)(ws + G_FU), 256, DM, 256}; pg8::SchedChan S; S.init(chG, chC, chBase, chLim);
                  pg8::EpiChan E{(bf16_t*)(ws + G_PQT)};
                  pg8::gemm_phase<pg8::EpiChan, pg8::SchedChan>(lds, gm, S, E); }
            PH_END
            PH_BEGIN
                hgrn_combine(p, l);
                __syncthreads();
                const int half = G >> 1;
                if (cb < half) { pg8::Gemm gm{(const bf16_t*)(ws + WS_DSEQ), (const bf16_t*)(ws + G_PQT), 4096, 4096, 2048}; pg8::SchedSeqH S; S.init(half, cb);
                  pg8::EpiSeqH E{(bf16_t*)(ws + G_SQ)};
                  pg8::gemm_phase<pg8::EpiSeqH, pg8::SchedSeqH>(lds, gm, S, E); }
                else { pg8::Gemm gm{(const bf16_t*)(ws + G_SGR), (const bf16_t*)(ws + WS_WRET), 2048, 2048, 2048}; pg8::SchedPlain S; S.init(TG, DM, 2048, 2048, G - half, cb - half);
                  pg8::EpiMix<0> E{(bf16_t*)(ws + G_F1), (const bf16_t*)(ws + G_GATES)};
                  pg8::gemm_phase<pg8::EpiMix<0>, pg8::SchedPlain>(lds, gm, S, E); }
            PH_END
            PH_BEGIN
                seq_combine((const bf16_t*)(ws + G_SQ), (const bf16_t*)(ws + G_PQT), (bf16_t*)(ws + G_YF));
            PH_END
            PH_BEGIN
                __syncthreads();
                const int half = G >> 1;
                if (cb < half) { pg8::Gemm gm{(const bf16_t*)(ws + G_SGH), (const bf16_t*)(ws + WS_WHG), DM, DM, DM}; pg8::SchedPlain S; S.init(TG, DM, DM, DM, half, cb);
                  pg8::EpiMix<1> E{(bf16_t*)(ws + G_F1), (const bf16_t*)(ws + G_GATES) + 1024};
                  pg8::gemm_phase<pg8::EpiMix<1>, pg8::SchedPlain>(lds, gm, S, E); }
                else { pg8::Gemm gm{(const bf16_t*)(ws + G_YF), (const bf16_t*)(ws + WS_WFN), DM, DM, DM}; pg8::SchedPlain S; S.init(TG, DM, DM, DM, G - half, cb - half);
                  pg8::EpiMix<0> E{(bf16_t*)(ws + G_F2), (const bf16_t*)(ws + G_GATES) + 2048};
                  pg8::gemm_phase<pg8::EpiMix<0>, pg8::SchedPlain>(lds, gm, S, E); }
            PH_END
            if (g == NGRP - 1) {
            PH_BEGIN
                mix_combine((const bf16_t*)(ws + G_F1), (const bf16_t*)(ws + G_F2), (bf16_t*)(ws + WS_MIXIN) + (size_t)tok0 * DM, cb, G);
            PH_END
            }
        }
        PH_BEGIN
            __syncthreads();
            { pg8::Gemm gm{(const bf16_t*)(ws + WS_MIXIN), (const bf16_t*)(ws + WS_WOUT), DM, DM, DM}; pg8::SchedPlain S; S.init(TA, DM, DM, DM, G, cb);
              pg8::EpiBf16<DM> E{(bf16_t*)(ws + A_MIXO)};
              pg8::gemm_phase<pg8::EpiBf16<DM>, pg8::SchedPlain>(lds, gm, S, E); }
        PH_END
        PH_BEGIN
            resid_rows((const bf16_t*)(ws + A_MIXO), xsrc, p.out, nw + DM, nw + 2 * DM, (bf16_t*)(ws + A_HN));
        PH_END
        PH_BEGIN
            __syncthreads();
            { pg8::Gemm gm{(const bf16_t*)(ws + A_HN), (const bf16_t*)(ws + WS_WUP), DM, DM, DM}; pg8::SchedPlain S; S.init(TA, 2 * DFF, DM, DM, G, cb);
              pg8::EpiBf16<2 * DFF> E{(bf16_t*)(ws + A_H)};
              pg8::gemm_phase<pg8::EpiBf16<2 * DFF>, pg8::SchedPlain>(lds, gm, S, E); }
        PH_END
        PH_BEGIN
            conv_phase((const bf16_t*)(ws + A_H), p.conv_w + (size_t)l * 3 * 2 * DFF, p.conv_b + (size_t)l * 2 * DFF, (bf16_t*)(ws + A_ACT));
        PH_END
        PH_BEGIN
            __syncthreads();
            { pg8::Gemm gm{(const bf16_t*)(ws + A_ACT), (const bf16_t*)(ws + WS_WDN), DFF, DFF, DFF}; pg8::SchedPlain S; S.init(TA, DM, DFF, DFF, G, cb);
              pg8::EpiBf16<DM> E{(bf16_t*)(ws + A_FFO)};
              pg8::gemm_phase<pg8::EpiBf16<DM>, pg8::SchedPlain>(lds, gm, S, E); }
        PH_END
        PH_BEGIN
            if (l + 1 < DEPTH) { resid_rows((const bf16_t*)(ws + A_FFO), p.out, p.out, nw + 3 * DM, nw + 4 * DM, (bf16_t*)(ws + WS_MIXIN));
                                 prep_weights(p, l + 1, lds); }
            else resid_rows((const bf16_t*)(ws + A_FFO), p.out, p.out, nw + 3 * DM, nullptr, nullptr);
        PH_END
    }
#undef PH_BEGIN
#undef PH_END
}
constexpr int NPHASES = 1 + DEPTH * (NGRP * 5 + 1 + 6);

extern "C" void kernel_launch(void* const* d_in, const int* in_sizes, int n_in, void* d_out, int out_size, void* d_ws, size_t ws_size, hipStream_t stream) {
    static int grid = 0;
    if (grid == 0) {
        int dev = 0, cus = 0, per_cu = 0;
        hipGetDevice(&dev);
        hipDeviceGetAttribute(&cus, hipDeviceAttributeMultiprocessorCount, dev);
        if (hipFuncSetAttribute((const void*)fwd_kernel, hipFuncAttributeMaxDynamicSharedMemorySize, LDS_BYTES) != hipSuccess) fprintf(stderr, "hipFuncSetAttribute failed\n");
        if (hipOccupancyMaxActiveBlocksPerMultiprocessor(&per_cu, (const void*)fwd_kernel, NTHREADS, LDS_BYTES) != hipSuccess || per_cu < 1) { fprintf(stderr, "occupancy query: %d\n", per_cu); per_cu = 1; }
        (void)hipGetLastError();
        grid = cus * 1;
        if (ws_size < 480 * MiB) fprintf(stderr, "kernel_launch: workspace %zu too small\n", ws_size);
    }
    Params p{};
    p.x = (const float*)d_in[0]; p.pos = (const int*)d_in[1]; p.norm_w = (const float*)d_in[2]; p.w_in = (const float*)d_in[3]; p.lb_logits = (const float*)d_in[4];
    p.hgrn_norm_w = (const float*)d_in[5]; p.w_ret_o = (const float*)d_in[6]; p.w_hgrn_o = (const float*)d_in[7]; p.w_fnet = (const float*)d_in[8]; p.w_out = (const float*)d_in[9];
    p.w_up = (const float*)d_in[10]; p.conv_w = (const float*)d_in[11]; p.conv_b = (const float*)d_in[12]; p.w_down = (const float*)d_in[13];
    p.out = (float*)d_out; p.ws = (unsigned char*)d_ws;
    (void)hipMemsetAsync((unsigned char*)d_ws + WS_BAR, 0, 32768, stream);
#if MK_MULTI
    for (int ph = 0; ph < NPHASES; ++ph) { p.ph_lo = ph; p.ph_hi = ph + 1; hipLaunchKernelGGL(fwd_kernel, dim3(grid), dim3(NTHREADS), LDS_BYTES, stream, p); }
#else
    p.ph_lo = 0; p.ph_hi = NPHASES;
    void* args[] = {&p};
    hipError_t e = hipLaunchCooperativeKernel((const void*)fwd_kernel, dim3(grid), dim3(NTHREADS), args, LDS_BYTES, stream);
    if (e != hipSuccess) fprintf(stderr, "cooperative launch failed: %s (grid %d)\n", hipGetErrorString(e), grid);
#endif
}
```

```cpp
#include <hip/hip_runtime.h>
#include <hip/hip_cooperative_groups.h>
#include <cstdio>
#include <cstdint>
namespace cg = cooperative_groups;

#ifndef MK_MULTI
#define MK_MULTI 0
#endif

#define LAS __attribute__((address_space(3)))
typedef unsigned short bf16_t;
typedef short bf16x8 __attribute__((ext_vector_type(8)));
typedef float f32x4 __attribute__((ext_vector_type(4)));
typedef float f32x2 __attribute__((ext_vector_type(2)));
typedef unsigned u32x4 __attribute__((ext_vector_type(4)));
typedef unsigned u32x2 __attribute__((ext_vector_type(2)));

constexpr int BATCH = 8, SEQ = 2048, DM = 1024, DEPTH = 2, DIN = 15360, DFF = 2816;
constexpr int NB = 4;
constexpr int NGRP = BATCH / NB;
constexpr int TG = NB * SEQ;
constexpr int TA = BATCH * SEQ;
constexpr float EPS = 1e-6f;
constexpr int NTHREADS = 512;
constexpr int LDS_BYTES = 156 * 1024;

constexpr size_t MiB = 1u << 20;
constexpr size_t WS_WIN = 0;
constexpr size_t WS_WRET = WS_WIN + (size_t)DIN * DM * 2;
constexpr size_t WS_WHG = WS_WRET + (size_t)DM * 2048 * 2;
constexpr size_t WS_WFN = WS_WHG + (size_t)DM * DM * 2;
constexpr size_t WS_WOUT = WS_WFN + (size_t)DM * DM * 2;
constexpr size_t WS_WUP = WS_WOUT + (size_t)DM * DM * 2;
constexpr size_t WS_WDN = WS_WUP + (size_t)2 * DFF * DM * 2;
constexpr size_t WS_WEND = WS_WDN + (size_t)DM * DFF * 2;
static_assert(WS_WEND <= 58 * MiB, "weights");
constexpr size_t WS_DSEQ = 58 * MiB;
constexpr size_t WS_CDFT = 74 * MiB;
constexpr size_t WS_LB = WS_CDFT + 512 * 1024;
constexpr size_t WS_BAR = WS_CDFT + 640 * 1024;
constexpr size_t WS_ROPE = 75 * MiB;
constexpr size_t WS_MIXIN = 91 * MiB;
constexpr size_t WS_G = 123 * MiB;
constexpr size_t G_HOF = WS_G + 0 * MiB;
constexpr size_t G_Q = WS_G + 16 * MiB;
constexpr size_t G_K = WS_G + 32 * MiB;
constexpr size_t G_VT = WS_G + 48 * MiB;
constexpr size_t G_SGR = WS_G + 80 * MiB;
constexpr size_t G_HQ = WS_G + 112 * MiB;
constexpr size_t G_LFF = WS_G + 128 * MiB;
constexpr size_t G_LFB = WS_G + 144 * MiB;
constexpr size_t G_HI = WS_G + 160 * MiB;
constexpr size_t G_SGH = WS_G + 176 * MiB;
constexpr size_t G_FU = WS_G + 192 * MiB;
constexpr size_t G_GATES = WS_G + 208 * MiB;
constexpr size_t G_PQT = WS_G + 256 * MiB;
constexpr size_t G_SQ = WS_G + 16 * MiB;
constexpr size_t G_F1 = WS_G + 320 * MiB;
constexpr size_t G_F2 = WS_G + 336 * MiB;
constexpr size_t G_YF = WS_G + 288 * MiB;
constexpr size_t G_HOB = WS_G + 304 * MiB;
constexpr size_t G_END = WS_G + 320 * MiB;
constexpr size_t A_HN = WS_G + 0 * MiB;
constexpr size_t A_MIXO = WS_G + 32 * MiB;
constexpr size_t A_H = WS_G + 96 * MiB;
constexpr size_t A_FFO = A_H;
constexpr size_t A_ACT = WS_MIXIN;
constexpr size_t A_END = A_H + (size_t)TA * 2 * DFF * 2;
static_assert(G_END <= 480 * MiB && A_END <= 480 * MiB, "ws");
static_assert(A_ACT + (size_t)TA * DFF * 2 <= A_H, "act overlay");

__device__ __forceinline__ unsigned f2bf(float f) { unsigned u = __builtin_bit_cast(unsigned, f); return (u + 0x7fffu + ((u >> 16) & 1u)) >> 16; }
__device__ __forceinline__ unsigned pk2(float lo, float hi) { return f2bf(lo) | (f2bf(hi) << 16); }
__device__ __forceinline__ float bf2f(unsigned short h) { return __builtin_bit_cast(float, (unsigned)h << 16); }
__device__ __forceinline__ float bflo(unsigned w) { return __builtin_bit_cast(float, w << 16); }
__device__ __forceinline__ float bfhi(unsigned w) { return __builtin_bit_cast(float, w & 0xffff0000u); }
__device__ __forceinline__ float shx(float v, int o, int lane) { return __builtin_bit_cast(float, __builtin_amdgcn_ds_bpermute((lane ^ o) << 2, __builtin_bit_cast(int, v))); }
__device__ __forceinline__ float wave_sum(float v, int lane) {
#pragma unroll
    for (int o = 1; o < 64; o <<= 1) v += shx(v, o, lane);
    return v;
}
__device__ __forceinline__ int otid() { int t = threadIdx.x; asm volatile("" : "+v"(t)); return t; }
__device__ __forceinline__ int obid() { int t = blockIdx.x; asm volatile("" : "+s"(t)); return t; }
__device__ __forceinline__ int ogrid() { int t = gridDim.x; asm volatile("" : "+s"(t)); return t; }
typedef __bf16 bf16x2_t __attribute__((ext_vector_type(2)));
__device__ __forceinline__ unsigned cvtpk(float lo, float hi) { const f32x2 v = {lo, hi}; const bf16x2_t b = __builtin_convertvector(v, bf16x2_t); return __builtin_bit_cast(unsigned, b); }
__device__ __forceinline__ float silu_f(float x) { return x * __builtin_amdgcn_rcpf(1.f + __builtin_amdgcn_exp2f(-1.4426950408889634f * x)); }
__device__ __forceinline__ float sigm_f(float x) { return __builtin_amdgcn_rcpf(1.f + __builtin_amdgcn_exp2f(-1.4426950408889634f * x)); }
__device__ __forceinline__ f32x4 mfma16(bf16x8 a, bf16x8 b, f32x4 c) { return __builtin_amdgcn_mfma_f32_16x16x32_bf16(a, b, c, 0, 0, 0); }

namespace pg8 {
constexpr int BM = 256, BK = 64, HALF = 128, HTB = HALF * BK * 2, STAGE_BYTES = 8 * HTB, NXCD = 8, WGM = 8;
__host__ __device__ __forceinline__ int lds_byte(int r, int c) { const int st = (r >> 4) * 2 + (c >> 5), rr = r & 15, cc = c & 31, ob = rr * 64 + cc * 2; return st * 1024 + (ob ^ (((ob >> 9) & 1) << 5)); }
__host__ __device__ __forceinline__ void stage_rc(int b, int& R, int& C) { const int st = b / 1024, sb = b % 1024, swz = sb ^ (((sb >> 9) & 1) << 5); R = (st >> 1) * 16 + swz / 64; C = (st & 1) * 32 + (swz % 64) / 2; }
__host__ __device__ __forceinline__ int perm32(int rho) { const int n = rho >> 4, i = rho & 15; return 8 * (i >> 2) + 4 * n + (i & 3); }

struct Unit { int pm, pn, z; size_t offA, offB; };
struct Gemm { const bf16_t* A; const bf16_t* Bt; int lda, ldb, K; };

struct StaticOrder {
    int nM, nN, nwg, G, c;
    __device__ __forceinline__ void init(int nM_, int nN_, int G_, int c_) { nM = nM_; nN = nN_; nwg = nM * nN; G = G_; c = c_; }
    __device__ __forceinline__ bool next(int i, int& pm, int& pn) const {
        const long L = (long)i * G + c; if (L >= nwg) return false;
        int wgid = (int)L; { const int q = nwg / NXCD, r = nwg % NXCD, xcd = wgid % NXCD, off = wgid / NXCD; wgid = (xcd < r ? xcd * (q + 1) : r * (q + 1) + (xcd - r) * q) + off; }
        const int nig = WGM * nN, gid = wgid / nig, fm = gid * WGM, gsz = (nM - fm) < WGM ? (nM - fm) : WGM;
        pm = fm + ((wgid % nig) % gsz); pn = (wgid % nig) / gsz; return true;
    }
};
struct SchedPlain {
    StaticOrder o; size_t tA, tB;
    __device__ __forceinline__ void init(int M, int N, int lda, int ldb, int G, int c) { o.init(M / BM, N / BM, G, c); tA = (size_t)BM * lda * 2; tB = (size_t)BM * ldb * 2; }
    __device__ __forceinline__ bool next(int i, Unit& u) const { int pm, pn; if (!o.next(i, pm, pn)) return false; u.pm = pm; u.pn = pn; u.z = 0; u.offA = pm * tA; u.offB = pn * tB; return true; }
};
struct SchedInProj {
    StaticOrder o; size_t tA, tB;
    __device__ __forceinline__ void init(int G, int c) { o.init(TG / BM, 52, G, c); tA = (size_t)BM * DM * 2; tB = (size_t)BM * DM * 2; }
    __device__ __forceinline__ bool next(int i, Unit& u) const { int pm, pn; if (!o.next(i, pm, pn)) return false; if (pn >= 8) pn += 8; u.pm = pm; u.pn = pn; u.z = 0; u.offA = pm * tA; u.offB = pn * tB; return true; }
};
struct SchedChan {
    int G, c, base, lim;
    __device__ __forceinline__ void init(int G_, int c_, int base_ = 0, int lim_ = 4 * 2 * (TG / BM)) { G = G_; c = c_; base = base_; lim = lim_; }
    __device__ __forceinline__ bool next(int i, Unit& u) const {
        const int L = base + i * G + c; constexpr int NT = TG / BM; if (L >= lim) return false;
        const int g = L / (2 * NT), r = L % (2 * NT); u.z = g; u.pm = r / NT; u.pn = r % NT;
        u.offA = (size_t)u.pm * BM * 256 * 2; u.offB = ((size_t)u.pn * BM * DM + g * 256) * 2; return true;
    }
};

struct SchedSeqH {
    int G, c;
    __device__ __forceinline__ void init(int G_, int c_) { G = G_; c = c_; }
    __device__ __forceinline__ bool next(int i, Unit& u) const {
        const int L = i * G + c; constexpr int NN = NB * 1024 / BM; if (L >= 2 * 4 * NN) return false;
        const int z = L / (4 * NN), r = L % (4 * NN); u.z = z; u.pm = r / NN; u.pn = r % NN;
        u.offA = ((size_t)u.pm * BM * 4096 + z * 2048) * 2; u.offB = ((size_t)u.pn * BM * 4096 + z * 2048) * 2; return true;
    }
};
__device__ __forceinline__ unsigned cvt_pk_bf16(float lo, float hi) { return cvtpk(lo, hi); }

template <class Epi, class Sched, bool ALIGN_EPI = true, bool SP2 = true>
__device__ __forceinline__ void gemm_phase(LAS unsigned char* lds, const Gemm g, const Sched& S, const Epi& E) {
    int tid_ = threadIdx.x; asm volatile("" : "+v"(tid_));
    const int tid = tid_, wid = __builtin_amdgcn_readfirstlane(tid >> 6), lane = tid & 63, wr = wid >> 2, wc = wid & 3, fr = lane & 15, fq = lane >> 4;
    const int K = g.K, nt = K / BK;
    unsigned voffA[2], voffB[2];
#pragma unroll
    for (int i = 0; i < 2; ++i) { int R, C; stage_rc(tid * 16 + i * 8192, R, C); const int Rb = Epi::PERM ? ((R & ~31) + perm32(R & 31)) : R;
        voffA[i] = (unsigned)(R * g.lda + C) * 2u; voffB[i] = (unsigned)(Rb * g.ldb + C) * 2u; }
    const size_t kstep = (size_t)(BK * 2);
    const size_t hstepA = (size_t)HALF * g.lda * 2, hstepB = (size_t)HALF * g.ldb * 2;
    const unsigned ldsw = (unsigned)wid * 1024u;
    const int aoff = lds_byte(wr * 64 + fr, fq * 8), boff = lds_byte(wc * 32 + fr, fq * 8);
#define PG8_SA(b, h) (((b) * 2 + (h)) * HTB)
#define PG8_SB(b, h) ((4 + (b) * 2 + (h)) * HTB)
#define PG8_STAGE(bufoff, gbase, voff) do { const char* _gb = (const char*)(gbase); asm volatile("" : "+s"(_gb));     \
        _Pragma("unroll") for (int _i = 0; _i < 2; ++_i) \
        __builtin_amdgcn_global_load_lds((const unsigned*)(_gb + (voff)[_i]), (LAS unsigned*)(lds + (bufoff) + ldsw + _i * 8192), 16, 0, 0); } while (0)
#define PG8_LDA(dst, b, h) do { _Pragma("unroll") for (int m = 0; m < 4; ++m) _Pragma("unroll") for (int k = 0; k < 2; ++k) dst[m][k] = *(const LAS bf16x8*)(lds + PG8_SA(b, h) + aoff + m * 2048 + k * 1024); } while (0)
#define PG8_LDB(dst, b, h) do { _Pragma("unroll") for (int n = 0; n < 2; ++n) _Pragma("unroll") for (int k = 0; k < 2; ++k) dst[n][k] = *(const LAS bf16x8*)(lds + PG8_SB(b, h) + boff + n * 2048 + k * 1024); } while (0)
#define PG8_MMA(ai, bj, At, Bt) do { __builtin_amdgcn_s_setprio(1); _Pragma("unroll") for (int m = 0; m < 4; ++m) _Pragma("unroll") for (int n = 0; n < 2; ++n) _Pragma("unroll") for (int k = 0; k < 2; ++k) \
        acc[ai][bj][m][n] = __builtin_amdgcn_mfma_f32_16x16x32_bf16(Bt[n][k], At[m][k], acc[ai][bj][m][n], 0, 0, 0); __builtin_amdgcn_s_setprio(0); } while (0)
#define PG8_WAIT_V(n) asm volatile("s_waitcnt vmcnt(" #n ")" ::: "memory")
#define PG8_WAIT_L(n) asm volatile("s_waitcnt lgkmcnt(" #n ")" ::: "memory")
#define PG8_BAR __builtin_amdgcn_s_barrier()
#define PG8_SCHED __builtin_amdgcn_sched_barrier(0)
    Unit cur, nxt; int ui = 0;
    if (!S.next(0, cur)) return;
    f32x4 acc[2][2][4][2];
#pragma unroll
    for (int a = 0; a < 2; ++a)
#pragma unroll
        for (int b = 0; b < 2; ++b)
#pragma unroll
            for (int m = 0; m < 4; ++m)
#pragma unroll
                for (int n = 0; n < 2; ++n) acc[a][b][m][n] = (f32x4){0.f, 0.f, 0.f, 0.f};
    bf16x8 At[4][2], B0[2][2], B1[2][2];
    const char* cA = (const char*)g.A + cur.offA; const char* cB = (const char*)g.Bt + cur.offB;
    if constexpr (SP2) {
        PG8_STAGE(PG8_SB(0, 0), cB, voffB); PG8_STAGE(PG8_SB(0, 1), cB + hstepB, voffB); PG8_STAGE(PG8_SA(0, 0), cA, voffA); PG8_STAGE(PG8_SA(0, 1), cA + hstepA, voffA);
        if (wr == 1) PG8_BAR;
        PG8_WAIT_V(2); PG8_BAR;
        PG8_STAGE(PG8_SB(1, 0), cB + kstep, voffB); PG8_STAGE(PG8_SA(1, 0), cA + kstep, voffA); PG8_STAGE(PG8_SB(1, 1), cB + hstepB + kstep, voffB);
        PG8_WAIT_V(6); PG8_BAR;
    } else {
        PG8_STAGE(PG8_SB(0, 0), cB, voffB); PG8_STAGE(PG8_SA(0, 0), cA, voffA); PG8_STAGE(PG8_SB(0, 1), cB + hstepB, voffB); PG8_STAGE(PG8_SA(0, 1), cA + hstepA, voffA);
        if (wr == 1) PG8_BAR;
        PG8_WAIT_V(4); PG8_BAR;
        PG8_STAGE(PG8_SB(1, 0), cB + kstep, voffB); PG8_STAGE(PG8_SA(1, 0), cA + kstep, voffA); PG8_STAGE(PG8_SB(1, 1), cB + hstepB + kstep, voffB);
        PG8_WAIT_V(6); PG8_BAR;
    }
    for (;;) {
        const bool has_next = S.next(ui + 1, nxt);
        const char* nA = has_next ? (const char*)g.A + nxt.offA : cA; const char* nB = has_next ? (const char*)g.Bt + nxt.offB : cB;
        for (int t = 0; t < nt; t += 2) {
            const bool last = (t == nt - 2);
            const char* a1 = cA + (size_t)(t + 1) * kstep;
            const char* a2 = last ? nA : cA + (size_t)(t + 2) * kstep; const char* b2 = last ? nB : cB + (size_t)(t + 2) * kstep;
            const char* a3 = a2 + kstep; const char* b3 = b2 + kstep;
            if constexpr (SP2) {
            PG8_LDB(B0, 0, 0); PG8_LDB(B1, 0, 1); PG8_SCHED; PG8_LDA(At, 0, 0); PG8_STAGE(PG8_SA(1, 1), a1 + hstepA, voffA);
            PG8_WAIT_V(8); PG8_WAIT_L(0); PG8_BAR; PG8_MMA(0, 0, At, B0); PG8_MMA(0, 1, At, B1); PG8_BAR; PG8_SCHED;
            PG8_LDA(At, 0, 1); PG8_STAGE(PG8_SB(0, 0), b2, voffB); PG8_STAGE(PG8_SB(0, 1), b2 + hstepB, voffB); PG8_STAGE(PG8_SA(0, 0), a2, voffA);
            PG8_WAIT_V(8); PG8_WAIT_L(0); PG8_BAR; PG8_MMA(1, 0, At, B0); PG8_MMA(1, 1, At, B1); PG8_BAR; PG8_SCHED;
            PG8_LDB(B0, 1, 0); PG8_LDB(B1, 1, 1); PG8_SCHED; PG8_LDA(At, 1, 0); PG8_STAGE(PG8_SA(0, 1), a2 + hstepA, voffA);
            PG8_WAIT_V(8); PG8_WAIT_L(0); PG8_BAR; PG8_MMA(0, 0, At, B0); PG8_MMA(0, 1, At, B1); PG8_BAR; PG8_SCHED;
            PG8_LDA(At, 1, 1); PG8_STAGE(PG8_SB(1, 0), b3, voffB); PG8_STAGE(PG8_SB(1, 1), b3 + hstepB, voffB); PG8_STAGE(PG8_SA(1, 0), a3, voffA);
            PG8_WAIT_V(8); PG8_WAIT_L(0); PG8_BAR; PG8_MMA(1, 0, At, B0); PG8_MMA(1, 1, At, B1); PG8_BAR; PG8_SCHED;
            } else {
            PG8_LDB(B0, 0, 0); PG8_SCHED; PG8_LDA(At, 0, 0); PG8_STAGE(PG8_SA(1, 1), a1 + hstepA, voffA);
            PG8_WAIT_L(8); PG8_BAR; PG8_WAIT_L(0); PG8_MMA(0, 0, At, B0); PG8_BAR; PG8_SCHED;
            PG8_LDB(B1, 0, 1); PG8_STAGE(PG8_SB(0, 0), b2, voffB);
            PG8_BAR; PG8_WAIT_L(0); PG8_MMA(0, 1, At, B1); PG8_BAR;
            PG8_LDA(At, 0, 1); PG8_STAGE(PG8_SA(0, 0), a2, voffA);
            PG8_BAR; PG8_WAIT_L(0); PG8_MMA(1, 0, At, B0); PG8_BAR; PG8_SCHED;
            PG8_STAGE(PG8_SB(0, 1), b2 + hstepB, voffB);
            PG8_WAIT_V(6); PG8_BAR; PG8_MMA(1, 1, At, B1); PG8_BAR;
            PG8_LDB(B0, 1, 0); PG8_SCHED; PG8_LDA(At, 1, 0); PG8_STAGE(PG8_SA(0, 1), a2 + hstepA, voffA);
            PG8_WAIT_L(8); PG8_BAR; PG8_WAIT_L(0); PG8_MMA(0, 0, At, B0); PG8_BAR; PG8_SCHED;
            PG8_LDB(B1, 1, 1); PG8_STAGE(PG8_SB(1, 0), b3, voffB);
            PG8_BAR; PG8_WAIT_L(0); PG8_MMA(0, 1, At, B1); PG8_BAR;
            PG8_LDA(At, 1, 1); PG8_STAGE(PG8_SA(1, 0), a3, voffA);
            PG8_BAR; PG8_WAIT_L(0); PG8_MMA(1, 0, At, B0); PG8_BAR; PG8_SCHED;
            PG8_STAGE(PG8_SB(1, 1), b3 + hstepB, voffB);
            PG8_WAIT_V(6); PG8_BAR; PG8_MMA(1, 1, At, B1); PG8_BAR;
            }
        }
        if constexpr (ALIGN_EPI) { if (wr == 0) PG8_BAR; }
        { int t2 = tid; asm volatile("" : "+v"(t2));
          const int w2 = t2 >> 6, l2 = t2 & 63; E(acc, cur, w2 >> 2, w2 & 3, l2 & 15, l2 >> 4); }
        if (!has_next) break;
#pragma unroll
        for (int a = 0; a < 2; ++a)
#pragma unroll
            for (int b = 0; b < 2; ++b)
#pragma unroll
                for (int m = 0; m < 4; ++m)
#pragma unroll
                    for (int n = 0; n < 2; ++n) acc[a][b][m][n] = (f32x4){0.f, 0.f, 0.f, 0.f};
        cur = nxt; cA = nA; cB = nB; ++ui;
        if constexpr (ALIGN_EPI) { if (wr == 1) PG8_BAR; }
    }
    PG8_WAIT_V(0);
    if constexpr (!ALIGN_EPI) { if (wr == 0) PG8_BAR; }
    PG8_BAR;
#undef PG8_SA
#undef PG8_SB
#undef PG8_STAGE
#undef PG8_LDA
#undef PG8_LDB
#undef PG8_MMA
#undef PG8_WAIT_V
#undef PG8_WAIT_L
#undef PG8_BAR
#undef PG8_SCHED
}

typedef f32x4 Acc[2][2][4][2];
#define EPI_ROW_FENCE __builtin_amdgcn_sched_barrier(0)
__device__ __forceinline__ u32x4 pack8(const f32x4 v0, const f32x4 v1) { u32x4 w; w.x = cvt_pk_bf16(v0[0], v0[1]); w.y = cvt_pk_bf16(v0[2], v0[3]); w.z = cvt_pk_bf16(v1[0], v1[1]); w.w = cvt_pk_bf16(v1[2], v1[3]); return w; }

template <int LDC> __device__ __forceinline__ void store_tile_bf16(const Acc& acc, bf16_t* base) {
#pragma unroll
    for (int ai = 0; ai < 2; ++ai)
#pragma unroll
        for (int m = 0; m < 4; ++m) { bf16_t* rowp = base + (size_t)(ai * HALF + m * 16) * LDC;
#pragma unroll
            for (int bj = 0; bj < 2; ++bj) *(u32x4*)(rowp + bj * HALF) = pack8(acc[ai][bj][m][0], acc[ai][bj][m][1]);
            EPI_ROW_FENCE; }
}
template <int LDC> struct EpiBf16 {
    static constexpr bool PERM = true;
    bf16_t* O;
    __device__ __forceinline__ void operator()(const Acc& acc, const Unit& u, int wr, int wc, int fr, int fq) const {
        store_tile_bf16<LDC>(acc, O + (size_t)(u.pm * BM + wr * 64 + fr) * LDC + u.pn * BM + wc * 32 + 8 * fq);
    }
};
struct EpiF32 {
    static constexpr bool PERM = false;
    float* O;
    __device__ __forceinline__ void operator()(const Acc& acc, const Unit& u, int wr, int wc, int fr, int fq) const {
        float* base = O + (size_t)(u.pm * BM + wr * 64 + fr) * DM + u.pn * BM + wc * 32 + 4 * fq;
#pragma unroll
        for (int ai = 0; ai < 2; ++ai)
#pragma unroll
            for (int m = 0; m < 4; ++m) { float* rowp = base + (size_t)(ai * HALF + m * 16) * DM;
#pragma unroll
                for (int bj = 0; bj < 2; ++bj)
#pragma unroll
                    for (int n = 0; n < 2; ++n) *(f32x4*)(rowp + bj * HALF + 16 * n) = acc[ai][bj][m][n];
                EPI_ROW_FENCE; }
    }
};
struct EpiSeqH {
    static constexpr bool PERM = true;
    bf16_t* O;
    __device__ __forceinline__ void operator()(const Acc& acc, const Unit& u, int wr, int wc, int fr, int fq) const {
        constexpr int LD = NB * 1024;
        store_tile_bf16<LD>(acc, O + ((size_t)u.z * 1024 + u.pm * BM + wr * 64 + fr) * LD + u.pn * BM + wc * 32 + 8 * fq);
    }
};
template <int MODE> struct EpiMix {
    static constexpr bool PERM = false;
    bf16_t* F; const bf16_t* gates;
    __device__ __forceinline__ void operator()(const Acc& acc, const Unit& u, int wr, int wc, int fr, int fq) const {
        const size_t row0 = u.pm * BM + wr * 64 + fr; const int col0 = u.pn * BM + wc * 32 + 4 * fq;
        bf16_t* fb = F + row0 * DM + col0; const bf16_t* gb = gates + row0 * 3072 + col0;
#pragma unroll
        for (int ai = 0; ai < 2; ++ai) {
            u32x2 gw[4][4], ow[4][4];
#pragma unroll
            for (int m = 0; m < 4; ++m)
#pragma unroll
                for (int q = 0; q < 4; ++q) { const int ro = ai * HALF + m * 16, co = (q >> 1) * HALF + 16 * (q & 1);
                    gw[m][q] = *(const u32x2*)(gb + (size_t)ro * 3072 + co);
                    if (MODE >= 1) ow[m][q] = *(const u32x2*)(fb + (size_t)ro * DM + co); }
#pragma unroll
            for (int m = 0; m < 4; ++m)
#pragma unroll
                for (int q = 0; q < 4; ++q) { const int ro = ai * HALF + m * 16, co = (q >> 1) * HALF + 16 * (q & 1);
                    f32x4 v = acc[ai][q >> 1][m][q & 1]; v[0] *= bflo(gw[m][q].x); v[1] *= bfhi(gw[m][q].x); v[2] *= bflo(gw[m][q].y); v[3] *= bfhi(gw[m][q].y);
                    if (MODE >= 1) { v[0] += bflo(ow[m][q].x); v[1] += bfhi(ow[m][q].x); v[2] += bflo(ow[m][q].y); v[3] += bfhi(ow[m][q].y); }
                    u32x2 w; w.x = cvt_pk_bf16(v[0], v[1]); w.y = cvt_pk_bf16(v[2], v[3]); *(u32x2*)(fb + (size_t)ro * DM + co) = w; }
            EPI_ROW_FENCE; }
    }
};
struct EpiChan {
    static constexpr bool PERM = true;
    bf16_t* PQT;
    __device__ __forceinline__ void operator()(const Acc& acc, const Unit& u, int wr, int wc, int fr, int fq) const {
        const int tok0 = u.pn * BM, bl = tok0 >> 11, s0 = (tok0 & (SEQ - 1)) + wc * 32 + 8 * fq;
        store_tile_bf16<4096>(acc, PQT + ((size_t)(bl * 1024 + u.z * 256 + wr * 64 + fr)) * 4096 + u.pm * 2048 + s0);
    }
};
struct EpiSeq {
    static constexpr bool PERM = true;
    bf16_t* YF;
    __device__ __forceinline__ void operator()(const Acc& acc, const Unit& u, int wr, int wc, int fr, int fq) const {
        const int bl = u.pn >> 2, gc0 = (u.pn & 3) * 256 + wc * 32 + 8 * fq;
        store_tile_bf16<DM>(acc, YF + ((size_t)(bl * SEQ + u.pm * BM + wr * 64 + fr)) * DM + gc0);
    }
};
template <int KIND, int LDC> __device__ __forceinline__ void store_act(const Acc& acc, bf16_t* base, const float* lbp) {
    f32x4 lbv4[2][2];
#pragma unroll
    for (int bj = 0; bj < 2; ++bj)
#pragma unroll
        for (int n = 0; n < 2; ++n) lbv4[bj][n] = (KIND == 4) ? *(const f32x4*)(lbp + bj * HALF + 4 * n) : (f32x4){0.f, 0.f, 0.f, 0.f};
#pragma unroll
    for (int ai = 0; ai < 2; ++ai)
#pragma unroll
        for (int m = 0; m < 4; ++m) { bf16_t* rowp = base + (size_t)(ai * HALF + m * 16) * LDC;
#pragma unroll
            for (int bj = 0; bj < 2; ++bj) { f32x4 v[2] = {acc[ai][bj][m][0], acc[ai][bj][m][1]};
#pragma unroll
                for (int n = 0; n < 2; ++n) { const f32x4 lb = lbv4[bj][n];
#pragma unroll
                    for (int j = 0; j < 4; ++j) { float x = v[n][j];
                        if (KIND == 2) x = silu_f(x);
                        else if (KIND == 3) x = silu_f(x) * 0.08838834764831845f;
                        else if (KIND == 7) x = sigm_f(x);
                        else if (KIND == 4) { const float l = lb[j], e = __expf(-fabsf(x));
                            const float f = (x >= 0.f ? (1.f + l * e) : (e + l)) * __builtin_amdgcn_rcpf(1.f + e); x = fmaxf(__builtin_amdgcn_logf(f), -115.f); }
                        v[n][j] = x; } }
                *(u32x4*)(rowp + bj * HALF) = pack8(v[0], v[1]); }
            EPI_ROW_FENCE; }
}
struct EpiInProj {
    static constexpr bool PERM = true;
    unsigned char* ws; const float* rope; const float* lbv; int tok0;
    __device__ __forceinline__ void operator()(const Acc& acc, const Unit& u, int wr, int wc, int fr, int fq) const {
        const int pn = u.pn;
        const size_t row0 = u.pm * BM + wr * 64 + fr;
        const int cin = wc * 32 + 8 * fq;
        if (pn < 8) {
            const float sc = pn >= 4 ? 0.0625f : 1.0f;
            bf16_t* base = (bf16_t*)(ws + (pn >= 4 ? G_K : G_Q)) + row0 * DM + (pn & 3) * BM + cin;
            const float* rb = rope + ((size_t)(tok0 + row0) * 128 + cin) * 2;
#pragma unroll
            for (int ai = 0; ai < 2; ++ai) {
                f32x4 cs[4][4];
#pragma unroll
                for (int m = 0; m < 4; ++m) { const f32x4* rp = (const f32x4*)(rb + (size_t)(ai * HALF + m * 16) * 256);
#pragma unroll
                    for (int q = 0; q < 4; ++q) cs[m][q] = rp[q]; }
#pragma unroll
                for (int m = 0; m < 4; ++m) { const int ro = ai * HALF + m * 16;
                    f32x4 o1[2], o2[2];
#pragma unroll
                    for (int n = 0; n < 2; ++n) { const f32x4 cs0 = cs[m][2 * n], cs1 = cs[m][2 * n + 1];
                        const f32x4 x1 = acc[ai][0][m][n], x2 = acc[ai][1][m][n];
                        o1[n][0] = (x1[0] * cs0[0] - x2[0] * cs0[1]) * sc; o2[n][0] = (x1[0] * cs0[1] + x2[0] * cs0[0]) * sc;
                        o1[n][1] = (x1[1] * cs0[2] - x2[1] * cs0[3]) * sc; o2[n][1] = (x1[1] * cs0[3] + x2[1] * cs0[2]) * sc;
                        o1[n][2] = (x1[2] * cs1[0] - x2[2] * cs1[1]) * sc; o2[n][2] = (x1[2] * cs1[1] + x2[2] * cs1[0]) * sc;
                        o1[n][3] = (x1[3] * cs1[2] - x2[3] * cs1[3]) * sc; o2[n][3] = (x1[3] * cs1[3] + x2[3] * cs1[2]) * sc; }
                    bf16_t* rowp = base + (size_t)ro * DM;
                    *(u32x4*)rowp = pack8(o1[0], o1[1]);
                    *(u32x4*)(rowp + HALF) = pack8(o2[0], o2[1]); }
                EPI_ROW_FENCE; }
            return;
        }
        if (pn < 24) store_act<2, 2048>(acc, (bf16_t*)(ws + G_SGR) + row0 * 2048 + (pn - 16) * BM + cin, nullptr);
        else if (pn < 28) store_act<3, DM>(acc, (bf16_t*)(ws + G_HQ) + row0 * DM + (pn - 24) * BM + cin, nullptr);
        else if (pn < 32) store_act<4, DM>(acc, (bf16_t*)(ws + G_LFF) + row0 * DM + (pn - 28) * BM + cin, lbv + (pn - 28) * BM + cin);
        else if (pn < 36) store_act<4, DM>(acc, (bf16_t*)(ws + G_LFB) + row0 * DM + (pn - 32) * BM + cin, lbv + 1024 + (pn - 32) * BM + cin);
        else if (pn < 40) store_act<6, DM>(acc, (bf16_t*)(ws + G_HI) + row0 * DM + (pn - 36) * BM + cin, nullptr);
        else if (pn < 44) store_act<2, DM>(acc, (bf16_t*)(ws + G_SGH) + row0 * DM + (pn - 40) * BM + cin, nullptr);
        else if (pn < 48) store_act<6, DM>(acc, (bf16_t*)(ws + G_FU) + row0 * DM + (pn - 44) * BM + cin, nullptr);
        else store_act<7, 3072>(acc, (bf16_t*)(ws + G_GATES) + row0 * 3072 + (pn - 48) * BM + cin, nullptr);
    }
};
}

struct Params {
    const float* x; const int* pos; const float* norm_w; const float* w_in; const float* lb_logits; const float* hgrn_norm_w;
    const float* w_ret_o; const float* w_hgrn_o; const float* w_fnet; const float* w_out; const float* w_up; const float* conv_w; const float* conv_b; const float* w_down;
    float* out; unsigned char* ws; int ph_lo, ph_hi;
};

__device__ __forceinline__ void transpose_item(const float* W, int K, int N, bf16_t* WT, LAS float* scr, int item, int lane) {
    const int nblk = N / 32, kb = item / nblk, nb = item % nblk, k0 = 64 * kb, n0 = 32 * nb;
#pragma unroll 8
    for (int i = 0; i < 32; ++i) { const int kk = 2 * i + (lane >> 5); scr[kk * 33 + (lane & 31)] = W[(size_t)(k0 + kk) * N + n0 + (lane & 31)]; }
    asm volatile("s_waitcnt lgkmcnt(0)" ::: "memory");
    const int c = lane & 7;
#pragma unroll
    for (int j = 0; j < 4; ++j) { const int n = (lane >> 3) + 8 * j; const LAS float* s = scr + (8 * c) * 33 + n;
        u32x4 o; o.x = pk2(s[0 * 33], s[1 * 33]); o.y = pk2(s[2 * 33], s[3 * 33]); o.z = pk2(s[4 * 33], s[5 * 33]); o.w = pk2(s[6 * 33], s[7 * 33]);
        *(u32x4*)(WT + (size_t)(n0 + n) * K + k0 + 8 * c) = o; }
    asm volatile("s_waitcnt lgkmcnt(0)" ::: "memory");
}

__device__ __forceinline__ void prep_weights(const Params& p, int l, LAS unsigned char* lds) {
    const int tid = otid(), lane = tid & 63, wave = tid >> 6;
    LAS float* scr = (LAS float*)(lds + wave * 16384);
    const int gw = obid() * 8 + wave, NGW = ogrid() * 8;
    unsigned char* ws = p.ws;
    constexpr int I_IN = (DM / 64) * (DIN / 32), I_RET = (2048 / 64) * (DM / 32), I_SQ = (DM / 64) * (DM / 32), I_UP = (DM / 64) * (2 * DFF / 32), I_DN = (DFF / 64) * (DM / 32);
    constexpr int NITEMS = I_IN + I_RET + 3 * I_SQ + I_UP + I_DN;
    for (int it = gw; it < NITEMS; it += NGW) {
        int r = it;
        if (r < I_IN) { transpose_item(p.w_in + (size_t)l * DM * DIN, DM, DIN, (bf16_t*)(ws + WS_WIN), scr, r, lane); continue; } r -= I_IN;
        if (r < I_RET) { transpose_item(p.w_ret_o + (size_t)l * 2048 * DM, 2048, DM, (bf16_t*)(ws + WS_WRET), scr, r, lane); continue; } r -= I_RET;
        if (r < I_SQ) { transpose_item(p.w_hgrn_o + (size_t)l * DM * DM, DM, DM, (bf16_t*)(ws + WS_WHG), scr, r, lane); continue; } r -= I_SQ;
        if (r < I_SQ) { transpose_item(p.w_fnet + (size_t)l * DM * DM, DM, DM, (bf16_t*)(ws + WS_WFN), scr, r, lane); continue; } r -= I_SQ;
        if (r < I_SQ) { transpose_item(p.w_out + (size_t)l * DM * DM, DM, DM, (bf16_t*)(ws + WS_WOUT), scr, r, lane); continue; } r -= I_SQ;
        if (r < I_UP) { transpose_item(p.w_up + (size_t)l * DM * 2 * DFF, DM, 2 * DFF, (bf16_t*)(ws + WS_WUP), scr, r, lane); continue; } r -= I_UP;
        transpose_item(p.w_down + (size_t)l * DFF * DM, DFF, DM, (bf16_t*)(ws + WS_WDN), scr, r, lane);
    }
    const int gt = obid() * NTHREADS + tid;
    if (gt < 2 * DM) { const int dir = gt / DM, c = gt % DM;
        float lg[DEPTH], mx = -1e30f;
#pragma unroll
        for (int j = 0; j < DEPTH; ++j) { lg[j] = p.lb_logits[((size_t)dir * DEPTH + j) * DM + c]; mx = fmaxf(mx, lg[j]); }
        float den = 0.f, num = 0.f;
#pragma unroll
        for (int j = 0; j < DEPTH; ++j) { const float e = expf(lg[j] - mx); den += e; if (j >= 1 && j <= l) num += e; }
        ((float*)(ws + WS_LB))[gt] = fmaxf(num / den, 1e-30f); }
}

__device__ __forceinline__ void prep_tables(const Params& p) {
    const int gt = obid() * NTHREADS + otid(), NT = ogrid() * NTHREADS;
    unsigned char* ws = p.ws;
    bf16_t* dseq = (bf16_t*)(ws + WS_DSEQ);
    const float sc1 = 0.02209708691207961f;
    for (int it = gt; it < 2048 * 512; it += NT) { const int sp = it / 512, k0 = (it % 512) * 8;
        unsigned w[4];
#pragma unroll
        for (int h = 0; h < 4; ++h) { float v[2];
#pragma unroll
            for (int q = 0; q < 2; ++q) { const int kc = k0 + 2 * h + q, s = kc & 2047; const int ph = (s * sp) & 2047; const float a = (float)ph * (1.f / 1024.f);
                v[q] = (kc >> 11) ? -sinpif(a) * sc1 : cospif(a) * sc1; }
            w[h] = pk2(v[0], v[1]); }
        *(u32x4*)(dseq + (size_t)sp * 4096 + k0) = (u32x4){w[0], w[1], w[2], w[3]}; }
    bf16_t* cd = (bf16_t*)(ws + WS_CDFT);
    for (int it = gt; it < 512 * 256; it += NT) { const int r = it / 256, c = it % 256, cp = r & 255; const int ph = (c * cp) & 255; const float a = (float)ph * (1.f / 128.f);
        const float v = (r >> 8) ? sinpif(a) : cospif(a); cd[it] = (bf16_t)f2bf(v * 0.0625f); }
    f32x2* rope = (f32x2*)(ws + WS_ROPE);
    for (int it = gt; it < TA * 128; it += NT) { const int tok = it >> 7, i = it & 127;
        const float inv = powf(10000.f, -(float)i * (1.f / 128.f));
        const float ang = (float)p.pos[tok] * inv;
        double t = (double)ang * 0.31830988618379067; t -= 2.0 * rint(t * 0.5); const float tf = (float)t;
        rope[it] = (f32x2){cospif(tf), sinpif(tf)}; }
}

__device__ __forceinline__ void rms_rows(const float* xsrc, const float* w, bf16_t* XN, int nrows) {
    const int tid = otid(), lane = tid & 63, gw = obid() * 8 + (tid >> 6), NGW = ogrid() * 8;
    f32x4 wv[4];
#pragma unroll
    for (int j = 0; j < 4; ++j) wv[j] = ((const f32x4*)w)[lane + 64 * j];
    for (int m = gw; m < nrows; m += NGW) {
        const f32x4* xr = (const f32x4*)(xsrc + (size_t)m * DM); f32x4 v[4]; float ss = 0.f;
#pragma unroll
        for (int j = 0; j < 4; ++j) { v[j] = xr[lane + 64 * j]; ss += (v[j][0] * v[j][0] + v[j][1] * v[j][1]) + (v[j][2] * v[j][2] + v[j][3] * v[j][3]); }
        const float r = rsqrtf(wave_sum(ss, lane) * (1.f / DM) + EPS);
        u32x2* o = (u32x2*)(XN + (size_t)m * DM);
#pragma unroll
        for (int j = 0; j < 4; ++j) { const f32x4 y = v[j] * r * wv[j]; o[lane + 64 * j] = (u32x2){pk2(y[0], y[1]), pk2(y[2], y[3])}; }
    }
}
__device__ __forceinline__ void resid_rows(const bf16_t* V, const float* xsrc, float* out, const float* w1, const float* w2, bf16_t* HN) {
    const int tid = otid(), lane = tid & 63, gw = obid() * 8 + (tid >> 6), NGW = ogrid() * 8;
    f32x4 w1v[4], w2v[4];
#pragma unroll
    for (int j = 0; j < 4; ++j) { w1v[j] = ((const f32x4*)w1)[lane + 64 * j]; w2v[j] = HN ? ((const f32x4*)w2)[lane + 64 * j] : (f32x4){0.f, 0.f, 0.f, 0.f}; }
    for (int m = gw; m < TA; m += NGW) {
        const u32x2* vr = (const u32x2*)(V + (size_t)m * DM); const f32x4* xr = (const f32x4*)(xsrc + (size_t)m * DM); f32x4 v[4]; float ss = 0.f;
#pragma unroll
        for (int j = 0; j < 4; ++j) { const u32x2 vw = vr[lane + 64 * j]; v[j] = (f32x4){bflo(vw.x), bfhi(vw.x), bflo(vw.y), bfhi(vw.y)}; ss += (v[j][0] * v[j][0] + v[j][1] * v[j][1]) + (v[j][2] * v[j][2] + v[j][3] * v[j][3]); }
        const float r = rsqrtf(wave_sum(ss, lane) * (1.f / DM) + EPS); float s2 = 0.f;
#pragma unroll
        for (int j = 0; j < 4; ++j) { v[j] = xr[lane + 64 * j] + v[j] * r * w1v[j]; ((f32x4*)(out + (size_t)m * DM))[lane + 64 * j] = v[j];
            s2 += (v[j][0] * v[j][0] + v[j][1] * v[j][1]) + (v[j][2] * v[j][2] + v[j][3] * v[j][3]); }
        if (HN) { const float r2 = rsqrtf(wave_sum(s2, lane) * (1.f / DM) + EPS); u32x2* o = (u32x2*)(HN + (size_t)m * DM);
#pragma unroll
            for (int j = 0; j < 4; ++j) { const f32x4 y = v[j] * r2 * w2v[j]; o[lane + 64 * j] = (u32x2){pk2(y[0], y[1]), pk2(y[2], y[3])}; } }
    }
}

__device__ __forceinline__ float gelu_tanh(float x) { const float y = 0.7978845608028654f * (x + 0.044715f * x * x * x); const float t = 1.f - 2.f * __builtin_amdgcn_rcpf(1.f + __builtin_amdgcn_exp2f(2.8853900817779268f * y)); return 0.5f * x * (1.f + t); }
__device__ __forceinline__ void ld8(const bf16_t* p, float (&v)[8]) { const u32x4 w = *(const u32x4*)p; v[0] = bflo(w.x); v[1] = bfhi(w.x); v[2] = bflo(w.y); v[3] = bfhi(w.y); v[4] = bflo(w.z); v[5] = bfhi(w.z); v[6] = bflo(w.w); v[7] = bfhi(w.w); }
__device__ __forceinline__ void conv_phase(const bf16_t* H, const float* cw, const float* cb, bf16_t* ACT) {
    constexpr int RB = 16, NCH = DFF / 8;
    const int gt = obid() * NTHREADS + otid(), NT = ogrid() * NTHREADS;
    for (int it = gt; it < (TA / RB) * NCH; it += NT) {
        const int ch = it % NCH, rb = it / NCH, c0 = ch * 8, m0 = rb * RB, s0 = m0 % SEQ;
        float wg[3][8], wu[3][8], bg[8], bu[8];
#pragma unroll
        for (int t = 0; t < 3; ++t)
#pragma unroll
            for (int j = 0; j < 8; ++j) { wg[t][j] = cw[(size_t)t * 2 * DFF + c0 + j]; wu[t][j] = cw[(size_t)t * 2 * DFF + DFF + c0 + j]; }
#pragma unroll
        for (int j = 0; j < 8; ++j) { bg[j] = cb[c0 + j]; bu[j] = cb[DFF + c0 + j]; }
        float g0[8], g1[8], g2[8], u0[8], u1[8], u2[8];
        if (s0 > 0) { ld8(H + (size_t)(m0 - 1) * 2 * DFF + c0, g0); ld8(H + (size_t)(m0 - 1) * 2 * DFF + DFF + c0, u0); }
        else {
#pragma unroll
            for (int j = 0; j < 8; ++j) { g0[j] = 0.f; u0[j] = 0.f; } }
        ld8(H + (size_t)m0 * 2 * DFF + c0, g1); ld8(H + (size_t)m0 * 2 * DFF + DFF + c0, u1);
        for (int r = 0; r < RB; ++r) { const int m = m0 + r;
            if (s0 + r + 1 < SEQ) { ld8(H + (size_t)(m + 1) * 2 * DFF + c0, g2); ld8(H + (size_t)(m + 1) * 2 * DFF + DFF + c0, u2); }
            else {
#pragma unroll
                for (int j = 0; j < 8; ++j) { g2[j] = 0.f; u2[j] = 0.f; } }
            float o[8];
#pragma unroll
            for (int j = 0; j < 8; ++j) { const float gg = bg[j] + g0[j] * wg[0][j] + g1[j] * wg[1][j] + g2[j] * wg[2][j]; const float uu = bu[j] + u0[j] * wu[0][j] + u1[j] * wu[1][j] + u2[j] * wu[2][j]; o[j] = gelu_tanh(gg) * uu; }
            *(u32x4*)(ACT + (size_t)m * DFF + c0) = (u32x4){pk2(o[0], o[1]), pk2(o[2], o[3]), pk2(o[4], o[5]), pk2(o[6], o[7])};
#pragma unroll
            for (int j = 0; j < 8; ++j) { g0[j] = g1[j]; g1[j] = g2[j]; u0[j] = u1[j]; u1[j] = u2[j]; }
        }
    }
}

constexpr size_t G_RL = WS_G + 320 * MiB;
static_assert(G_RL + 32 * MiB <= 480 * MiB, "ws");
__device__ __forceinline__ void ret_local(const Params& p, unsigned char* lds, int item) {
    unsigned char* ws = p.ws;
    int tid_ = threadIdx.x; asm volatile("" : "+v"(tid_));
    const int tid = tid_, lane = tid & 63, w = tid >> 6, l15 = lane & 15, quad = lane >> 4;
    const int eq = item & 3, idx = (item >> 2) % 6, bh = (item >> 2) / 6, bl = bh >> 2, h = bh & 3;
    const int dirb = idx >= 3, m = dirb ? idx - 2 : idx;
    const float lg2 = log2f(1.f - exp2f(-5.f - (float)h));
    bf16_t* KT = (bf16_t*)lds;
    bf16_t* VTx = (bf16_t*)(lds + 20480);
    const bf16_t* Kg = (const bf16_t*)(ws + G_K) + ((size_t)(bl * SEQ + m * 512)) * DM + h * 256;
    const bf16_t* VT = (const bf16_t*)(ws + G_VT) + ((size_t)(h * 512 + eq * 128)) * TG + bl * SEQ + m * 512;
    const int kj = tid & 31, kc8 = (tid >> 5) * 8;
    const int ve = tid >> 2, vj8 = (tid & 3) * 8;
    f32x4 af[2][8];
#pragma unroll
    for (int i = 0; i < 2; ++i)
#pragma unroll
        for (int j = 0; j < 8; ++j) af[i][j] = (f32x4){0.f, 0.f, 0.f, 0.f};
    u32x4 kr0[2], kr1[2], kr2[2], kr3[2], vr0, vr1, vr2, vr3;
#define RL_LOAD(s, KR, VR) do { const int s_ = (s) < 16 ? (s) : 15; \
        _Pragma("unroll") for (int i = 0; i < 2; ++i) KR[i] = *(const u32x4*)(Kg + (size_t)(32 * s_ + kj) * DM + kc8 + 128 * i); \
        VR = *(const u32x4*)(VT + (size_t)ve * TG + 32 * s_ + vj8); } while (0)
    RL_LOAD(0, kr0, vr0); RL_LOAD(1, kr1, vr1); RL_LOAD(2, kr2, vr2);
    const int et0 = 2 * (w & 3), dt0 = 8 * (w >> 2);
    __syncthreads();
#define RL_STEP(s, KR, VR, KN, VN) do { \
        _Pragma("unroll") for (int i = 0; i < 2; ++i) { const int j = kj, c0 = kc8 + 128 * i; const unsigned wv[4] = {KR[i].x, KR[i].y, KR[i].z, KR[i].w}; \
            _Pragma("unroll") for (int q = 0; q < 4; ++q) { KT[(c0 + 2 * q) * 40 + j] = (bf16_t)(wv[q] & 0xffffu); KT[(c0 + 2 * q + 1) * 40 + j] = (bf16_t)(wv[q] >> 16); } } \
        { const unsigned wv[4] = {VR.x, VR.y, VR.z, VR.w}; unsigned ov[4]; \
          _Pragma("unroll") for (int q = 0; q < 4; ++q) { const int jj = 32 * (s) + vj8 + 2 * q; const float v0 = bflo(wv[q]), v1 = bfhi(wv[q]); \
              const float e0 = dirb ? (float)jj : (float)(511 - jj), e1 = dirb ? (float)(jj + 1) : (float)(510 - jj); \
              ov[q] = cvtpk(v0 * __builtin_amdgcn_exp2f(lg2 * e0), v1 * __builtin_amdgcn_exp2f(lg2 * e1)); } \
          *(u32x4*)(VTx + ve * 40 + vj8) = (u32x4){ov[0], ov[1], ov[2], ov[3]}; } \
        __syncthreads(); \
        RL_LOAD((s) + 3, KN, VN); \
        bf16x8 a0[2]; \
        _Pragma("unroll") for (int i = 0; i < 2; ++i) a0[i] = *(const bf16x8*)(VTx + (16 * (et0 + i) + l15) * 40 + quad * 8); \
        _Pragma("unroll") for (int j = 0; j < 8; ++j) { const bf16x8 b = *(const bf16x8*)(KT + (16 * (dt0 + j) + l15) * 40 + quad * 8); \
            _Pragma("unroll") for (int i = 0; i < 2; ++i) af[i][j] = mfma16(b, a0[i], af[i][j]); }       \
        __syncthreads(); } while (0)
    for (int s = 0; s < 16; s += 4) { RL_STEP(s, kr0, vr0, kr3, vr3); RL_STEP(s + 1, kr1, vr1, kr0, vr0); RL_STEP(s + 2, kr2, vr2, kr1, vr1); RL_STEP(s + 3, kr3, vr3, kr2, vr2); }
#undef RL_LOAD
#undef RL_STEP
    bf16_t* L = (bf16_t*)(ws + G_RL) + ((size_t)((bh * 4 + m) * 2 + dirb) * 512 + eq * 128) * 256;
#pragma unroll
    for (int i = 0; i < 2; ++i)
#pragma unroll
        for (int j = 0; j < 8; ++j)
            *(u32x2*)(L + (size_t)(16 * (et0 + i) + l15) * 256 + 16 * (dt0 + j) + 4 * quad) = (u32x2){cvtpk(af[i][j][0], af[i][j][1]), cvtpk(af[i][j][2], af[i][j][3])};
}

__device__ __forceinline__ void ret_item(const Params& p, unsigned char* lds, int item) {
    unsigned char* ws = p.ws;
    int tid_ = threadIdx.x; asm volatile("" : "+v"(tid_));
    const int tid = tid_, lane = tid & 63, w = tid >> 6, l15 = lane & 15, quad = lane >> 4;
    const int bh = item >> 5, bl = bh >> 2, h = bh & 3, qt = item & 31, cq = qt >> 3, kt0 = 8 * cq;
    const float lg2 = log2f(1.f - exp2f(-5.f - (float)h));
    bf16_t* Ks = (bf16_t*)lds;
    bf16_t* Ps = (bf16_t*)(lds + 67584);
    float* red = (float*)(lds + 86016);
    float* rstd = (float*)(lds + 88064);
    const bf16_t* Q = (const bf16_t*)(ws + G_Q) + ((size_t)(bl * SEQ + qt * 64)) * DM + h * 256;
    const bf16_t* Kg = (const bf16_t*)(ws + G_K) + ((size_t)(bl * SEQ)) * DM + h * 256;
    const bf16_t* VTw = (const bf16_t*)(ws + G_VT) + ((size_t)(h * 512 + 64 * w + l15)) * TG + bl * SEQ + quad * 16;
    const bf16_t* Lw = (const bf16_t*)(ws + G_RL) + ((size_t)(bh * 4) * 2 * 512 + 64 * w + l15) * 256 + quad * 16;
    const int ti = w >> 1, tj0 = (w & 1) * 2;
    bf16_t* Qs = (bf16_t*)(lds + 88320);
    const int kr = tid >> 5, kc = (tid & 31) * 8;
    const int prow = tid >> 3, pc8 = (tid & 7) * 8;
    const int pos = (qt & 7) * 64 + prow;
    u32x4 kreg[4], VA[8], VB[8], VC[8];
#define RET_LOADV(g, V) do { if ((g) < 8) { const bf16_t* s_ = VTw + (kt0 + (g)) * 64; \
            _Pragma("unroll") for (int j = 0; j < 4; ++j) _Pragma("unroll") for (int kk = 0; kk < 2; ++kk) V[j * 2 + kk] = *(const u32x4*)(s_ + (size_t)(16 * j) * TG + kk * 8); } \
        else if ((g) < 20) { const int st_ = (g) - 8, mi_ = st_ >> 2, m_ = mi_ + (mi_ >= cq ? 1 : 0), ds_ = st_ & 3; \
            const bf16_t* s_ = Lw + ((size_t)(m_ * 2 + (m_ < cq ? 0 : 1)) * 512) * 256 + ds_ * 64; \
            _Pragma("unroll") for (int j = 0; j < 4; ++j) _Pragma("unroll") for (int kk = 0; kk < 2; ++kk) V[j * 2 + kk] = *(const u32x4*)(s_ + (size_t)(16 * j) * 256 + kk * 8); } } while (0)
#define RET_PV(Pw, V) do { _Pragma("unroll") for (int kk = 0; kk < 2; ++kk) { bf16x8 a[4]; \
            _Pragma("unroll") for (int i = 0; i < 4; ++i) a[i] = *(const bf16x8*)((Pw) + (16 * i + l15) * 72 + quad * 16 + kk * 8); \
            _Pragma("unroll") for (int i = 0; i < 4; ++i) _Pragma("unroll") for (int j = 0; j < 4; ++j) o[i][j] = mfma16(__builtin_bit_cast(bf16x8, V[j * 2 + kk]), a[i], o[i][j]); } } while (0)
#define RET_TILE(g, VCU, VN) do { const int kt = kt0 + (g); const bf16_t* Kc = Ks + ((g) & 1) * (64 * 264); bf16_t* Pw = Ps + ((g) & 1) * (64 * 72); \
        f32x4 s0 = {0.f, 0.f, 0.f, 0.f}, s1 = {0.f, 0.f, 0.f, 0.f}; \
        _Pragma("unroll") for (int ks = 0; ks < 8; ++ks) { \
            const bf16x8 b0 = *(const bf16x8*)(Kc + (16 * tj0 + l15) * 264 + ks * 32 + quad * 8); \
            const bf16x8 b1 = *(const bf16x8*)(Kc + (16 * (tj0 + 1) + l15) * 264 + ks * 32 + quad * 8); \
            const bf16x8 qa = *(const bf16x8*)(Qs + (16 * ti + l15) * 264 + ks * 32 + quad * 8); \
            s0 = mfma16(qa, b0, s0); s1 = mfma16(qa, b1, s1); } \
        _Pragma("unroll") for (int r = 0; r < 4; ++r) { const int row = 16 * ti + 4 * quad + r, qpos = qt * 64 + row; \
            const int c0 = 16 * tj0 + l15, c1 = c0 + 16; \
            const float d0 = fabsf((float)(qpos - (kt * 64 + c0))), d1 = fabsf((float)(qpos - (kt * 64 + c1))); \
            Pw[row * 72 + c0] = (bf16_t)cvtpk(s0[r] * __builtin_amdgcn_exp2f(lg2 * d0), 0.f); \
            Pw[row * 72 + c1] = (bf16_t)cvtpk(s1[r] * __builtin_amdgcn_exp2f(lg2 * d1), 0.f); } \
        if ((g) + 1 < 8) { bf16_t* Kn = Ks + (((g) + 1) & 1) * (64 * 264); \
            _Pragma("unroll") for (int i = 0; i < 4; ++i) *(u32x4*)(Kn + (kr + 16 * i) * 264 + kc) = kreg[i]; } \
        __syncthreads(); \
        RET_LOADV((g) + 2, VN); \
        if ((g) + 2 < 8) { _Pragma("unroll") for (int i = 0; i < 4; ++i) kreg[i] = *(const u32x4*)(Kg + (size_t)((kt + 2) * 64 + kr + 16 * i) * DM + kc); } \
        RET_PV(Pw, VCU); } while (0)
#define RET_STATE(g, VCU, VN) do { bf16_t* Pw = Ps + ((g) & 1) * (64 * 72); \
        { const int mi = ((g) - 8) >> 2, m = mi + (mi >= cq ? 1 : 0); \
          const float ex = (m < cq) ? (float)(pos + 1 + (cq - 1 - m) * 512) : (float)(512 - pos + (m - cq - 1) * 512); \
          const float rs = __builtin_amdgcn_exp2f(lg2 * ex); const u32x4 qreg = *(const u32x4*)(Qs + prow * 264 + (((g) - 8) & 3) * 64 + pc8); \
          *(u32x4*)(Pw + prow * 72 + pc8) = (u32x4){cvtpk(bflo(qreg.x) * rs, bfhi(qreg.x) * rs), cvtpk(bflo(qreg.y) * rs, bfhi(qreg.y) * rs), cvtpk(bflo(qreg.z) * rs, bfhi(qreg.z) * rs), cvtpk(bflo(qreg.w) * rs, bfhi(qreg.w) * rs)}; } \
        __syncthreads(); \
        RET_LOADV((g) + 2, VN); \
        RET_PV(Pw, VCU); } while (0)
    __syncthreads();
#pragma unroll
    for (int i = 0; i < 4; ++i) { *(u32x4*)(Ks + (kr + 16 * i) * 264 + kc) = *(const u32x4*)(Kg + (size_t)(kt0 * 64 + kr + 16 * i) * DM + kc);
        *(u32x4*)(Qs + (kr + 16 * i) * 264 + kc) = *(const u32x4*)(Q + (size_t)(kr + 16 * i) * DM + kc); }
    RET_LOADV(0, VA); RET_LOADV(1, VB);
#pragma unroll
    for (int i = 0; i < 4; ++i) kreg[i] = *(const u32x4*)(Kg + (size_t)((kt0 + 1) * 64 + kr + 16 * i) * DM + kc);
    f32x4 o[4][4];
#pragma unroll
    for (int i = 0; i < 4; ++i)
#pragma unroll
        for (int j = 0; j < 4; ++j) o[i][j] = (f32x4){0.f, 0.f, 0.f, 0.f};
    __syncthreads();
#define RET_STEP(g, VCUR, VNXT) do { if ((g) < 8) RET_TILE(g, VCUR, VNXT); else if ((g) < 20) RET_STATE(g, VCUR, VNXT); } while (0)
    for (int g = 0; g < 21; g += 3) { RET_STEP(g, VA, VC); RET_STEP(g + 1, VB, VA); RET_STEP(g + 2, VC, VB); }
#undef RET_STEP
#undef RET_LOADV
#undef RET_PV
#undef RET_TILE
#undef RET_STATE
#pragma unroll
    for (int i = 0; i < 4; ++i) { float s = 0.f;
#pragma unroll
        for (int j = 0; j < 4; ++j)
#pragma unroll
            for (int r = 0; r < 4; ++r) s += o[i][j][r] * o[i][j][r];
        s += shx(s, 16, lane); s += shx(s, 32, lane);
        if (quad == 0) red[w * 64 + 16 * i + l15] = s; }
    __syncthreads();
    if (tid < 64) { float s = 0.f;
#pragma unroll
        for (int ww = 0; ww < 8; ++ww) s += red[ww * 64 + tid];
        rstd[tid] = rsqrtf(s * (1.f / 512.f) + EPS); }
    __syncthreads();
    bf16_t* RO = (bf16_t*)(ws + G_SGR) + ((size_t)(bl * SEQ + qt * 64)) * 2048 + h * 512 + 64 * w + 4 * quad;
    u32x2 gv[4][4];
#pragma unroll
    for (int i = 0; i < 4; ++i)
#pragma unroll
        for (int j = 0; j < 4; ++j) gv[i][j] = *(const u32x2*)(RO + (size_t)(16 * i + l15) * 2048 + 16 * j);
#pragma unroll
    for (int i = 0; i < 4; ++i) { const float rs = rstd[16 * i + l15];
#pragma unroll
        for (int j = 0; j < 4; ++j) { const f32x4 v = o[i][j] * rs;
            *(u32x2*)(RO + (size_t)(16 * i + l15) * 2048 + 16 * j) = (u32x2){cvtpk(v[0] * bflo(gv[i][j].x), v[1] * bfhi(gv[i][j].x)), cvtpk(v[2] * bflo(gv[i][j].y), v[3] * bfhi(gv[i][j].y))}; } }
}

struct HgRaw { unsigned q[8], l[8]; u32x4 v0, v1; };
__device__ __forceinline__ void hgrn_load(HgRaw& R, const bf16_t* HQ, const bf16_t* LF, const bf16_t* HI, int c, int dir, int d2, int tg, int vt, int veg) {
#pragma unroll
    for (int i = 0; i < 8; ++i) { const int tau = 32 * c + 8 * tg + i, s = dir ? (SEQ - 1 - tau) : tau; R.q[i] = *(const unsigned*)(HQ + (size_t)s * DM + 2 * d2); R.l[i] = *(const unsigned*)(LF + (size_t)s * DM + 2 * d2); }
    { const int tau = 32 * c + vt, s = dir ? (SEQ - 1 - tau) : tau; R.v0 = *(const u32x4*)(HI + (size_t)s * DM + veg * 16); R.v1 = *(const u32x4*)(HI + (size_t)s * DM + veg * 16 + 8); }
}
__device__ __forceinline__ void hgrn_prep(const HgRaw& R, bf16_t* Qe, bf16_t* Ke, bf16_t* KdT, float* decs, bf16_t* VTs, int d2, int tg, int vt, int veg, int lane) {
    float b0[8], b1[8], l0[8], l1[8]; float run0 = 0.f, run1 = 0.f;
#pragma unroll
    for (int i = 0; i < 8; ++i) { l0[i] = bflo(R.l[i]); l1[i] = bfhi(R.l[i]); run0 += l0[i]; run1 += l1[i]; b0[i] = run0; b1[i] = run1; }
    float pre0, pre1, bl0, bl1;
    { const float r1 = shx(run0, 1, lane), s2 = run0 + r1, s2x = shx(s2, 2, lane); bl0 = s2 + s2x; pre0 = ((tg & 1) ? r1 : 0.f) + ((tg & 2) ? s2x : 0.f); }
    { const float r1 = shx(run1, 1, lane), s2 = run1 + r1, s2x = shx(s2, 2, lane); bl1 = s2 + s2x; pre1 = ((tg & 1) ? r1 : 0.f) + ((tg & 2) ? s2x : 0.f); }
    const float c30 = __builtin_amdgcn_exp2f(bl0), c31 = __builtin_amdgcn_exp2f(bl1);
    float kd0[8], kd1[8];
#pragma unroll
    for (int i = 0; i < 8; ++i) { const int t = 8 * tg + i;
        const float bb0 = b0[i] + pre0, bb1 = b1[i] + pre1;
        const float k0 = 1.f - __builtin_amdgcn_exp2f(l0[i]), k1 = 1.f - __builtin_amdgcn_exp2f(l1[i]);
        const float ke0 = k0 * __builtin_amdgcn_exp2f(fminf(-bb0, 115.f)), ke1 = k1 * __builtin_amdgcn_exp2f(fminf(-bb1, 115.f));
        *(unsigned*)(Qe + t * 136 + 2 * d2) = cvtpk(bflo(R.q[i]) * __builtin_amdgcn_exp2f(bb0), bfhi(R.q[i]) * __builtin_amdgcn_exp2f(bb1));
        *(unsigned*)(Ke + t * 136 + 2 * d2) = cvtpk(ke0, ke1);
        kd0[i] = ke0 * c30; kd1[i] = ke1 * c31;
        if (__builtin_expect(!(bl0 > -86.f && bl1 > -86.f), 0)) { kd0[i] = k0 * __builtin_amdgcn_exp2f(bl0 - bb0); kd1[i] = k1 * __builtin_amdgcn_exp2f(bl1 - bb1); } }
    *(u32x4*)(KdT + (2 * d2) * 40 + 8 * tg) = (u32x4){cvtpk(kd0[0], kd0[1]), cvtpk(kd0[2], kd0[3]), cvtpk(kd0[4], kd0[5]), cvtpk(kd0[6], kd0[7])};
    *(u32x4*)(KdT + (2 * d2 + 1) * 40 + 8 * tg) = (u32x4){cvtpk(kd1[0], kd1[1]), cvtpk(kd1[2], kd1[3]), cvtpk(kd1[4], kd1[5]), cvtpk(kd1[6], kd1[7])};
    if (tg == 0) { decs[2 * d2] = c30; decs[2 * d2 + 1] = c31; }
    { const unsigned wv[8] = {R.v0.x, R.v0.y, R.v0.z, R.v0.w, R.v1.x, R.v1.y, R.v1.z, R.v1.w};
#pragma unroll
      for (int q = 0; q < 8; ++q) { VTs[(16 * veg + 2 * q) * 40 + vt] = (bf16_t)(wv[q] & 0xffffu); VTs[(16 * veg + 2 * q + 1) * 40 + vt] = (bf16_t)(wv[q] >> 16); } }
}
__device__ __forceinline__ void hgrn_item(const Params& p, unsigned char* lds, int item) {
    unsigned char* ws = p.ws;
    int tid_ = threadIdx.x; asm volatile("" : "+v"(tid_));
    const int tid = tid_, lane = tid & 63, w = tid >> 6, l15 = lane & 15, quad = lane >> 4;
    const int dir = item & 1, h = (item >> 1) & 7, bl = item >> 4;
    bf16_t* Qe2 = (bf16_t*)lds;
    bf16_t* Ke2 = (bf16_t*)(lds + 17408);
    bf16_t* KdT2 = (bf16_t*)(lds + 34816);
    bf16_t* VTs2 = (bf16_t*)(lds + 55296);
    float* decs2 = (float*)(lds + 75776);
    bf16_t* Ps = (bf16_t*)(lds + 76800);
    bf16_t* StT = (bf16_t*)(lds + 79360);
    const bf16_t* HQ = (const bf16_t*)(ws + G_HQ) + (size_t)bl * SEQ * DM + h * 128;
    const bf16_t* LF = (const bf16_t*)(ws + (dir ? G_LFB : G_LFF)) + (size_t)bl * SEQ * DM + h * 128;
    const bf16_t* HI = (const bf16_t*)(ws + G_HI) + (size_t)bl * SEQ * DM + h * 128;
    bf16_t* HO = (bf16_t*)(ws + (dir ? G_HOB : G_HOF)) + (size_t)bl * SEQ * DM + h * 128;
    __syncthreads();
    for (int i = tid; i < 128 * 136 / 2; i += NTHREADS) ((unsigned*)StT)[i] = 0u;
    if (w < 4) {
        const int d2 = tid >> 2, tg = tid & 3, vt = tid & 31, veg = tid >> 5;
        HgRaw RA, RB;
        hgrn_load(RA, HQ, LF, HI, 0, dir, d2, tg, vt, veg);
        hgrn_load(RB, HQ, LF, HI, 1, dir, d2, tg, vt, veg);
        hgrn_prep(RA, Qe2, Ke2, KdT2, decs2, VTs2, d2, tg, vt, veg, lane);
        __syncthreads();
#define HG_PROD(c, RP, RL) do { \
            if ((c) + 2 < 64) hgrn_load(RL, HQ, LF, HI, (c) + 2, dir, d2, tg, vt, veg); \
            if ((c) + 1 < 64) { const int pb = ((c) + 1) & 1; \
                hgrn_prep(RP, Qe2 + pb * (32 * 136), Ke2 + pb * (32 * 136), KdT2 + pb * (128 * 40), decs2 + pb * 128, VTs2 + pb * (128 * 40), d2, tg, vt, veg, lane); } \
            __syncthreads(); __syncthreads(); } while (0)
        for (int c = 0; c < 64; c += 2) { HG_PROD(c, RB, RA); HG_PROD(c + 1, RA, RB); }
#undef HG_PROD
    } else {
        const int cw = w - 4;
        const int oti = cw >> 1, otj = cw & 1;
        f32x4 st[2][8];
#pragma unroll
        for (int dj = 0; dj < 2; ++dj)
#pragma unroll
            for (int j = 0; j < 8; ++j) st[dj][j] = (f32x4){0.f, 0.f, 0.f, 0.f};
        __syncthreads();
        for (int c = 0; c < 64; ++c) {
            const int pb = c & 1;
            const bf16_t* Qe = Qe2 + pb * (32 * 136); const bf16_t* Ke = Ke2 + pb * (32 * 136); const bf16_t* KdT = KdT2 + pb * (128 * 40);
            const bf16_t* VTs = VTs2 + pb * (128 * 40); const float* decs = decs2 + pb * 128;
            f32x4 ao[2][2];
#pragma unroll
            for (int ej = 0; ej < 2; ++ej)
#pragma unroll
                for (int ti = 0; ti < 2; ++ti) ao[ej][ti] = (f32x4){0.f, 0.f, 0.f, 0.f};
#pragma unroll
            for (int ks = 0; ks < 4; ++ks) { bf16x8 sf[2], qf2[2];
#pragma unroll
                for (int ej = 0; ej < 2; ++ej) sf[ej] = *(const bf16x8*)(StT + (16 * (2 * cw + ej) + l15) * 136 + ks * 32 + quad * 8);
#pragma unroll
                for (int ti = 0; ti < 2; ++ti) qf2[ti] = *(const bf16x8*)(Qe + (16 * ti + l15) * 136 + ks * 32 + quad * 8);
#pragma unroll
                for (int ej = 0; ej < 2; ++ej)
#pragma unroll
                    for (int ti = 0; ti < 2; ++ti) ao[ej][ti] = mfma16(sf[ej], qf2[ti], ao[ej][ti]); }
            { f32x4 acc = {0.f, 0.f, 0.f, 0.f};
#pragma unroll
              for (int ks = 0; ks < 4; ++ks) { const bf16x8 a = *(const bf16x8*)(Qe + (16 * oti + l15) * 136 + ks * 32 + quad * 8); const bf16x8 bb = *(const bf16x8*)(Ke + (16 * otj + l15) * 136 + ks * 32 + quad * 8); acc = mfma16(bb, a, acc); }
              const int t = 16 * oti + l15, s0 = 16 * otj + 4 * quad;
              *(u32x2*)(Ps + t * 40 + s0) = (u32x2){cvtpk(s0 <= t ? acc[0] : 0.f, s0 + 1 <= t ? acc[1] : 0.f), cvtpk(s0 + 2 <= t ? acc[2] : 0.f, s0 + 3 <= t ? acc[3] : 0.f)}; }
            { bf16x8 kf[2]; f32x4 dc[2];
#pragma unroll
              for (int dj = 0; dj < 2; ++dj) { kf[dj] = *(const bf16x8*)(KdT + (16 * (2 * cw + dj) + l15) * 40 + quad * 8); dc[dj] = *(const f32x4*)(decs + 16 * (2 * cw + dj) + 4 * quad); }
#pragma unroll
              for (int j = 0; j < 8; ++j) { const bf16x8 vf = *(const bf16x8*)(VTs + (16 * j + l15) * 40 + quad * 8);
#pragma unroll
                  for (int dj = 0; dj < 2; ++dj) st[dj][j] = mfma16(kf[dj], vf, st[dj][j] * dc[dj]); } }
            __syncthreads();
            { bf16x8 pf[2];
#pragma unroll
              for (int ti = 0; ti < 2; ++ti) pf[ti] = *(const bf16x8*)(Ps + (16 * ti + l15) * 40 + quad * 8);
#pragma unroll
              for (int ej = 0; ej < 2; ++ej) { const bf16x8 vf = *(const bf16x8*)(VTs + (16 * (2 * cw + ej) + l15) * 40 + quad * 8);
#pragma unroll
                  for (int ti = 0; ti < 2; ++ti) { ao[ej][ti] = mfma16(vf, pf[ti], ao[ej][ti]);
                      const int tau = 32 * c + 16 * ti + l15, s = dir ? (SEQ - 1 - tau) : tau;
                      *(u32x2*)(HO + (size_t)s * DM + 16 * (2 * cw + ej) + 4 * quad) = (u32x2){cvtpk(ao[ej][ti][0], ao[ej][ti][1]), cvtpk(ao[ej][ti][2], ao[ej][ti][3])}; } } }
#pragma unroll
            for (int dj = 0; dj < 2; ++dj)
#pragma unroll
                for (int j = 0; j < 8; ++j)
                    *(u32x2*)(StT + (16 * j + l15) * 136 + 16 * (2 * cw + dj) + 4 * quad) = (u32x2){cvtpk(st[dj][j][0], st[dj][j][1]), cvtpk(st[dj][j][2], st[dj][j][3])};
            __syncthreads();
        }
    }
}

__device__ __forceinline__ void seq_combine(const bf16_t* OZ, const bf16_t* PQT, bf16_t* YF) {
    constexpr int LD = NB * 1024;
    const int tid = otid(), gt = obid() * NTHREADS + tid, NT = ogrid() * NTHREADS;
    for (int it = gt; it < 1024 * LD / 8; it += NT) { const int sp = it / (LD / 8), n0 = (it % (LD / 8)) * 8, bl = n0 >> 10, gc = n0 & 1023;
        float av[8], bv[8]; ld8(OZ + (size_t)sp * LD + n0, av); ld8(OZ + (size_t)(1024 + sp) * LD + n0, bv);
        const f32x4 a0 = {av[0], av[1], av[2], av[3]}, a1 = {av[4], av[5], av[6], av[7]}, b0 = {bv[0], bv[1], bv[2], bv[3]}, b1 = {bv[4], bv[5], bv[6], bv[7]};
        *(u32x4*)(YF + ((size_t)(bl * SEQ + sp)) * DM + gc) = (u32x4){pk2(a0[0] + b0[0], a0[1] + b0[1]), pk2(a0[2] + b0[2], a0[3] + b0[3]), pk2(a1[0] + b1[0], a1[1] + b1[1]), pk2(a1[2] + b1[2], a1[3] + b1[3])};
        if (sp > 0) *(u32x4*)(YF + ((size_t)(bl * SEQ + SEQ - sp)) * DM + gc) = (u32x4){pk2(a0[0] - b0[0], a0[1] - b0[1]), pk2(a0[2] - b0[2], a0[3] - b0[3]), pk2(a1[0] - b1[0], a1[1] - b1[1]), pk2(a1[2] - b1[2], a1[3] - b1[3])}; }
    const int lane = tid & 63, gw = obid() * 8 + (tid >> 6), NGW = ogrid() * 8;
    for (int n = gw; n < LD; n += NGW) { const bf16_t* pr = PQT + (size_t)n * 4096 + lane * 32; float s = 0.f;
#pragma unroll
        for (int q = 0; q < 4; ++q) { float v[8]; ld8(pr + 8 * q, v); s += (v[0] - v[1]) + (v[2] - v[3]) + (v[4] - v[5]) + (v[6] - v[7]); }
        s = wave_sum(s, lane);
        if (lane == 0) YF[((size_t)((n >> 10) * SEQ + 1024)) * DM + (n & 1023)] = (bf16_t)f2bf(s * 0.02209708691207961f); }
}

__device__ __forceinline__ void mix_combine(const bf16_t* F1, const bf16_t* F2, bf16_t* MIX, int rank, int nblk) {
    const int gt = rank * NTHREADS + otid(), NT = nblk * NTHREADS;
    for (int it = gt; it < TG * DM / 8; it += NT) { const size_t o = (size_t)it * 8; float a[8], b[8]; ld8(F1 + o, a); ld8(F2 + o, b);
        *(u32x4*)(MIX + o) = (u32x4){pk2(a[0] + b[0], a[1] + b[1]), pk2(a[2] + b[2], a[3] + b[3]), pk2(a[4] + b[4], a[5] + b[5]), pk2(a[6] + b[6], a[7] + b[7])}; }
}

__device__ __forceinline__ void hgrn_combine(const Params& p, int l) {
    unsigned char* ws = p.ws;
    const int tid = otid(), lane = tid & 63, gw = obid() * 8 + (tid >> 6), NGW = ogrid() * 8;
    const bf16_t* HOF = (const bf16_t*)(ws + G_HOF); const bf16_t* HOB = (const bf16_t*)(ws + G_HOB); bf16_t* SG = (bf16_t*)(ws + G_SGH);
    const float* nw = p.hgrn_norm_w + (size_t)l * 128;
    float nwv[2][8];
#pragma unroll
    for (int i = 0; i < 2; ++i)
#pragma unroll
        for (int j = 0; j < 8; ++j) nwv[i][j] = nw[(((lane + 64 * i) * 8) & 127) + j];
    for (int m0 = gw; m0 < TG; m0 += 2 * NGW) {
        u32x4 av[2][2], bv[2][2], gv[2][2];
#pragma unroll
        for (int r = 0; r < 2; ++r) { const int m = m0 + r * NGW;
#pragma unroll
            for (int i = 0; i < 2; ++i) { const size_t o = (size_t)m * DM + (lane + 64 * i) * 8;
                if (m < TG) { av[r][i] = *(const u32x4*)(HOF + o); bv[r][i] = *(const u32x4*)(HOB + o); gv[r][i] = *(const u32x4*)(SG + o); } } }
#pragma unroll
        for (int r = 0; r < 2; ++r) { const int m = m0 + r * NGW;
            if (m < TG) {
#pragma unroll
                for (int i = 0; i < 2; ++i) { const size_t o = (size_t)m * DM + (lane + 64 * i) * 8;
                    const unsigned aw[4] = {av[r][i].x, av[r][i].y, av[r][i].z, av[r][i].w}, bw[4] = {bv[r][i].x, bv[r][i].y, bv[r][i].z, bv[r][i].w}, gw4[4] = {gv[r][i].x, gv[r][i].y, gv[r][i].z, gv[r][i].w};
                    float a[8]; float ss = 0.f;
#pragma unroll
                    for (int q = 0; q < 4; ++q) { a[2 * q] = bflo(aw[q]) + bflo(bw[q]); a[2 * q + 1] = bfhi(aw[q]) + bfhi(bw[q]); ss += a[2 * q] * a[2 * q] + a[2 * q + 1] * a[2 * q + 1]; }
                    ss += shx(ss, 1, lane); ss += shx(ss, 2, lane); ss += shx(ss, 4, lane); ss += shx(ss, 8, lane);
                    const float rr = rsqrtf(ss * (1.f / 128.f) + EPS); unsigned ow[4];
#pragma unroll
                    for (int q = 0; q < 4; ++q) ow[q] = pk2(a[2 * q] * rr * nwv[i][2 * q] * bflo(gw4[q]), a[2 * q + 1] * rr * nwv[i][2 * q + 1] * bfhi(gw4[q]));
                    *(u32x4*)(SG + o) = (u32x4){ow[0], ow[1], ow[2], ow[3]}; } } }
    }
}

#define XB_TMO      128
#define XB_XCNT(j)  (256  + 64 * (j))
#define XB_XSUB(j)  (1280 + 64 * (j))
#define XB_XGEN(j)  (2304 + 64 * (j))
#define XB_TOP      3328
#define XB_TOPGEN   3392
#define XCD_BAR_WORDS 3456
#define XB_SPIN_CAP (1u << 22)
__device__ __forceinline__ unsigned xb_ld(unsigned* p)              { return __hip_atomic_load(p, __ATOMIC_RELAXED, __HIP_MEMORY_SCOPE_AGENT); }
__device__ __forceinline__ unsigned xb_add(unsigned* p, unsigned v) { return __hip_atomic_fetch_add(p, v, __ATOMIC_RELAXED, __HIP_MEMORY_SCOPE_AGENT); }
__device__ __forceinline__ unsigned xb_xcc_id() { return (unsigned)__builtin_amdgcn_s_getreg((3 << 11) | 20) & 0xFu; }
#define XB_SPIN(cond, bar) do { unsigned _sp = 0; while (cond) { __builtin_amdgcn_s_sleep(1); \
    if ((++_sp & 255u) == 0u) { if (xb_ld(&(bar)[XB_TMO])) break; if (_sp > XB_SPIN_CAP) { atomicAdd(&(bar)[XB_TMO], 1u); break; } } } } while (0)
__device__ __forceinline__ void xcd_barrier_complete(unsigned* bar, unsigned x, unsigned G, unsigned& nloc, unsigned& nx) {
    unsigned sum, cnt, mine, sp = 0u;
    for (;;) {
        sum = 0u; cnt = 0u; mine = 0u;
#pragma unroll
        for (unsigned j = 0; j < 16; ++j) { const unsigned c = xb_ld(&bar[XB_XCNT(j)]); sum += c; cnt += (c > 0u) ? 1u : 0u; mine = (j == x) ? c : mine; }
        if (sum == G) break;
        __builtin_amdgcn_s_sleep(1);
        if ((++sp & 255u) == 0u) { if (xb_ld(&bar[XB_TMO])) break; if (sp > XB_SPIN_CAP) { atomicAdd(&bar[XB_TMO], 1u); break; } }
    }
    nloc = mine > 0u ? mine : 1u; nx = cnt > 0u ? cnt : 1u;
}
__device__ __forceinline__ void xcd_barrier(unsigned* bar, volatile LAS unsigned* st, unsigned nparts) {
    asm volatile("s_waitcnt vmcnt(0)" ::: "memory");
    __syncthreads();
    if (threadIdx.x == 0) {
        const unsigned x = xb_xcc_id();
        __builtin_amdgcn_s_waitcnt(0);
        unsigned nloc = st[0], nx = st[1];
        if (nloc == 0u) { xcd_barrier_complete(bar, x, nparts, nloc, nx); st[0] = nloc; st[1] = nx; }
        const unsigned old = xb_add(&bar[XB_XSUB(x)], 1u);
        const unsigned gen = old / nloc;
        if (old + 1u == (gen + 1u) * nloc) {
            __builtin_amdgcn_fence(__ATOMIC_RELEASE, "agent");
            asm volatile("s_waitcnt vmcnt(0)" ::: "memory");
            const unsigned og = xb_add(&bar[XB_TOP], 1u);
            const unsigned tg = og / nx;
            if (og + 1u == (tg + 1u) * nx) xb_add(&bar[XB_TOPGEN], 1u);
            else XB_SPIN(xb_ld(&bar[XB_TOPGEN]) == tg, bar);
            __builtin_amdgcn_fence(__ATOMIC_ACQUIRE, "agent");
            xb_add(&bar[XB_XGEN(x)], 1u);
            asm volatile("s_waitcnt vmcnt(0)" ::: "memory");
        } else {
            XB_SPIN(xb_ld(&bar[XB_XGEN(x)]) == gen, bar);
            __builtin_amdgcn_fence(__ATOMIC_ACQUIRE, "agent");
            asm volatile("s_waitcnt vmcnt(0)" ::: "memory");
        }
    }
    __syncthreads();
}

typedef const Params __attribute__((address_space(4)))* KParams;
__global__ void __launch_bounds__(NTHREADS, 2) fwd_kernel(Params pk) {
    extern __shared__ __attribute__((aligned(16))) unsigned char lds_raw[];
    LAS unsigned char* lds = (LAS unsigned char*)lds_raw;
    cg::grid_group grid = cg::this_grid();
    volatile LAS unsigned* bst = (volatile LAS unsigned*)(lds + LDS_BYTES - 16);
    unsigned* gbar = (unsigned*)(pk.ws + WS_BAR);
    volatile LAS unsigned* bst2 = (volatile LAS unsigned*)(lds + LDS_BYTES - 32);
    constexpr int NHG = NB * 8 * 2;
    const bool coop = (pk.ph_hi - pk.ph_lo > 1);
    if (coop) {
        if (threadIdx.x == 0) { bst[0] = 0u; bst[1] = 0u; bst2[0] = 0u; bst2[1] = 0u; (void)xb_add(&gbar[XB_XCNT(xb_xcc_id())], 1u);
            if ((int)blockIdx.x >= NHG) (void)xb_add(&gbar[4096 + XB_XCNT(xb_xcc_id())], 1u); }
        __syncthreads();
    }
    const int lo = pk.ph_lo, hi = pk.ph_hi;
    int ph = 0;
#define PH_BEGIN if (ph >= lo && ph < hi) { KParams kp = (KParams)__builtin_amdgcn_kernarg_segment_ptr(); asm volatile("" : "+s"(kp)); Params p; __builtin_memcpy(&p, (const void __attribute__((address_space(4)))*)kp, sizeof(Params)); \
        unsigned char* ws = p.ws; const int G = ogrid(), cb = obid(); const float* xsrc = (l == 0) ? p.x : p.out; const float* nw = p.norm_w + (size_t)l * 4 * DM;
#define PH_END   if (ph + 1 < hi) { if (lo < 0) grid.sync(); else xcd_barrier((unsigned*)(ws + WS_BAR), bst, gridDim.x); } } ++ph;

    for (int l = 0; l < DEPTH; ++l) {
        if (l == 0) {
        PH_BEGIN
            prep_tables(p); rms_rows(p.x, nw, (bf16_t*)(ws + WS_MIXIN), TA);
            prep_weights(p, 0, lds);
        PH_END
        }
        for (int g = 0; g < NGRP; ++g) {
            const int tok0 = g * TG;
            PH_BEGIN
                const bf16_t* XN = (const bf16_t*)(ws + WS_MIXIN) + (size_t)tok0 * DM;
                if (g > 0 && cb >= (G >> 1)) mix_combine((const bf16_t*)(ws + G_F1), (const bf16_t*)(ws + G_F2), (bf16_t*)(ws + WS_MIXIN) + (size_t)(tok0 - TG) * DM, cb - (G >> 1), G - (G >> 1));
                __syncthreads();
                { pg8::Gemm gm{XN, (const bf16_t*)(ws + WS_WIN), DM, DM, DM}; pg8::SchedInProj S; S.init(G, cb);
                  pg8::EpiInProj E{ws, (const float*)(ws + WS_ROPE), (const float*)(ws + WS_LB), tok0};
                  pg8::gemm_phase<pg8::EpiInProj, pg8::SchedInProj>(lds, gm, S, E); }
                __syncthreads();
                { pg8::Gemm gm{(const bf16_t*)(ws + WS_WIN) + (size_t)2048 * DM, XN, DM, DM, DM}; pg8::SchedPlain S; S.init(2048, TG, DM, DM, G, cb);
                  pg8::EpiBf16<TG> E{(bf16_t*)(ws + G_VT)};
                  pg8::gemm_phase<pg8::EpiBf16<TG>, pg8::SchedPlain>(lds, gm, S, E); }
            PH_END
            PH_BEGIN
                const bool split = coop && G > 2 * NHG;
                int chG = G, chC = cb, chBase = 0, chLim = 4 * 2 * (TG / 256); bool chDo = true;
                const bool xaware = split && G == 256 && NB == 4;
                if (split && cb < NHG) { hgrn_item(p, lds_raw, cb);
                    if (xaware) { chG = NHG; chC = cb; chBase = 0; chLim = 2 * NHG; }
                    else chDo = false; }
                else {
                    const int Gs = split ? G - NHG : G, cs = split ? cb - NHG : cb;
                    if (!split) for (int it = cb; it < NB * 8 * 2; it += G) hgrn_item(p, lds_raw, it);
                    for (int it = cs; it < NB * 4 * 6 * 4; it += Gs) ret_local(p, lds_raw, it);
                    if (split) xcd_barrier((unsigned*)(ws + WS_BAR) + 4096, bst2, (unsigned)Gs);
                    else if (coop) xcd_barrier((unsigned*)(ws + WS_BAR), bst, gridDim.x);
                    constexpr int NRI = NB * 4 * 32;
                    if (xaware) {
                        const int x = cb & 7, j = cs >> 3;
                        for (int idx = j; idx < 64; idx += 24) ret_item(p, lds_raw, (2 * x) * 32 + idx);
                        chDo = j >= 16; chG = 64; chC = (j - 16) * 8 + x; chBase = 2 * NHG; chLim = 4 * NHG;
                    } else {
                        for (int it = cs; it < NRI; it += Gs) ret_item(p, lds_raw, it);
                        const int nfull = split ? NRI % Gs : 0;
                        chDo = cs >= nfull; chG = Gs - nfull; chC = cs - nfull;
                    }
                }
                __syncthreads();
                if (chDo) { pg8::Gemm gm{(const bf16_t*)(ws + WS_CDFT), (const bf16_t*)(ws + G_FU), 256, DM, 256}; pg8::SchedChan S; S.init(chG, chC, chBase, chLim);
                  pg8::EpiChan E{(bf16_t*)(ws + G_PQT)};
                  pg8::gemm_phase<pg8::EpiChan, pg8::SchedChan>(lds, gm, S, E); }
            PH_END
            PH_BEGIN
                hgrn_combine(p, l);
                __syncthreads();
                const int half = G >> 1;
                if (cb < half) { pg8::Gemm gm{(const bf16_t*)(ws + WS_DSEQ), (const bf16_t*)(ws + G_PQT), 4096, 4096, 2048}; pg8::SchedSeqH S; S.init(half, cb);
                  pg8::EpiSeqH E{(bf16_t*)(ws + G_SQ)};
                  pg8::gemm_phase<pg8::EpiSeqH, pg8::SchedSeqH>(lds, gm, S, E); }
                else { pg8::Gemm gm{(const bf16_t*)(ws + G_SGR), (const bf16_t*)(ws + WS_WRET), 2048, 2048, 2048}; pg8::SchedPlain S; S.init(TG, DM, 2048, 2048, G - half, cb - half);
                  pg8::EpiMix<0> E{(bf16_t*)(ws + G_F1), (const bf16_t*)(ws + G_GATES)};
                  pg8::gemm_phase<pg8::EpiMix<0>, pg8::SchedPlain>(lds, gm, S, E); }
            PH_END
            PH_BEGIN
                seq_combine((const bf16_t*)(ws + G_SQ), (const bf16_t*)(ws + G_PQT), (bf16_t*)(ws + G_YF));
            PH_END
            PH_BEGIN
                __syncthreads();
                const int half = G >> 1;
                if (cb < half) { pg8::Gemm gm{(const bf16_t*)(ws + G_SGH), (const bf16_t*)(ws + WS_WHG), DM, DM, DM}; pg8::SchedPlain S; S.init(TG, DM, DM, DM, half, cb);
                  pg8::EpiMix<1> E{(bf16_t*)(ws + G_F1), (const bf16_t*)(ws + G_GATES) + 1024};
                  pg8::gemm_phase<pg8::EpiMix<1>, pg8::SchedPlain>(lds, gm, S, E); }
                else { pg8::Gemm gm{(const bf16_t*)(ws + G_YF), (const bf16_t*)(ws + WS_WFN), DM, DM, DM}; pg8::SchedPlain S; S.init(TG, DM, DM, DM, G - half, cb - half);
                  pg8::EpiMix<0> E{(bf16_t*)(ws + G_F2), (const bf16_t*)(ws + G_GATES) + 2048};
                  pg8::gemm_phase<pg8::EpiMix<0>, pg8::SchedPlain>(lds, gm, S, E); }
            PH_END
            if (g == NGRP - 1) {
            PH_BEGIN
                mix_combine((const bf16_t*)(ws + G_F1), (const bf16_t*)(ws + G_F2), (bf16_t*)(ws + WS_MIXIN) + (size_t)tok0 * DM, cb, G);
            PH_END
            }
        }
        PH_BEGIN
            __syncthreads();
            { pg8::Gemm gm{(const bf16_t*)(ws + WS_MIXIN), (const bf16_t*)(ws + WS_WOUT), DM, DM, DM}; pg8::SchedPlain S; S.init(TA, DM, DM, DM, G, cb);
              pg8::EpiBf16<DM> E{(bf16_t*)(ws + A_MIXO)};
              pg8::gemm_phase<pg8::EpiBf16<DM>, pg8::SchedPlain>(lds, gm, S, E); }
        PH_END
        PH_BEGIN
            resid_rows((const bf16_t*)(ws + A_MIXO), xsrc, p.out, nw + DM, nw + 2 * DM, (bf16_t*)(ws + A_HN));
        PH_END
        PH_BEGIN
            __syncthreads();
            { pg8::Gemm gm{(const bf16_t*)(ws + A_HN), (const bf16_t*)(ws + WS_WUP), DM, DM, DM}; pg8::SchedPlain S; S.init(TA, 2 * DFF, DM, DM, G, cb);
              pg8::EpiBf16<2 * DFF> E{(bf16_t*)(ws + A_H)};
              pg8::gemm_phase<pg8::EpiBf16<2 * DFF>, pg8::SchedPlain>(lds, gm, S, E); }
        PH_END
        PH_BEGIN
            conv_phase((const bf16_t*)(ws + A_H), p.conv_w + (size_t)l * 3 * 2 * DFF, p.conv_b + (size_t)l * 2 * DFF, (bf16_t*)(ws + A_ACT));
        PH_END
        PH_BEGIN
            __syncthreads();
            { pg8::Gemm gm{(const bf16_t*)(ws + A_ACT), (const bf16_t*)(ws + WS_WDN), DFF, DFF, DFF}; pg8::SchedPlain S; S.init(TA, DM, DFF, DFF, G, cb);
              pg8::EpiBf16<DM> E{(bf16_t*)(ws + A_FFO)};
              pg8::gemm_phase<pg8::EpiBf16<DM>, pg8::SchedPlain>(lds, gm, S, E); }
        PH_END
        PH_BEGIN
            if (l + 1 < DEPTH) { resid_rows((const bf16_t*)(ws + A_FFO), p.out, p.out, nw + 3 * DM, nw + 4 * DM, (bf16_t*)(ws + WS_MIXIN));
                                 prep_weights(p, l + 1, lds); }
            else resid_rows((const bf16_t*)(ws + A_FFO), p.out, p.out, nw + 3 * DM, nullptr, nullptr);
        PH_END
    }
#undef PH_BEGIN
#undef PH_END
}
constexpr int NPHASES = 1 + DEPTH * (NGRP * 5 + 1 + 6);

extern "C" void kernel_launch(void* const* d_in, const int* in_sizes, int n_in, void* d_out, int out_size, void* d_ws, size_t ws_size, hipStream_t stream) {
    static int grid = 0;
    if (grid == 0) {
        int dev = 0, cus = 0, per_cu = 0;
        hipGetDevice(&dev);
        hipDeviceGetAttribute(&cus, hipDeviceAttributeMultiprocessorCount, dev);
        if (hipFuncSetAttribute((const void*)fwd_kernel, hipFuncAttributeMaxDynamicSharedMemorySize, LDS_BYTES) != hipSuccess) fprintf(stderr, "hipFuncSetAttribute failed\n");
        if (hipOccupancyMaxActiveBlocksPerMultiprocessor(&per_cu, (const void*)fwd_kernel, NTHREADS, LDS_BYTES) != hipSuccess || per_cu < 1) { fprintf(stderr, "occupancy query: %d\n", per_cu); per_cu = 1; }
        (void)hipGetLastError();
        grid = cus * 1;
        if (ws_size < 480 * MiB) fprintf(stderr, "kernel_launch: workspace %zu too small\n", ws_size);
    }
    Params p{};
    p.x = (const float*)d_in[0]; p.pos = (const int*)d_in[1]; p.norm_w = (const float*)d_in[2]; p.w_in = (const float*)d_in[3]; p.lb_logits = (const float*)d_in[4];
    p.hgrn_norm_w = (const float*)d_in[5]; p.w_ret_o = (const float*)d_in[6]; p.w_hgrn_o = (const float*)d_in[7]; p.w_fnet = (const float*)d_in[8]; p.w_out = (const float*)d_in[9];
    p.w_up = (const float*)d_in[10]; p.conv_w = (const float*)d_in[11]; p.conv_b = (const float*)d_in[12]; p.w_down = (const float*)d_in[13];
    p.out = (float*)d_out; p.ws = (unsigned char*)d_ws;
    (void)hipMemsetAsync((unsigned char*)d_ws + WS_BAR, 0, 32768, stream);
#if MK_MULTI
    for (int ph = 0; ph < NPHASES; ++ph) { p.ph_lo = ph; p.ph_hi = ph + 1; hipLaunchKernelGGL(fwd_kernel, dim3(grid), dim3(NTHREADS), LDS_BYTES, stream, p); }
#else
    p.ph_lo = 0; p.ph_hi = NPHASES;
    void* args[] = {&p};
    hipError_t e = hipLaunchCooperativeKernel((const void*)fwd_kernel, dim3(grid), dim3(NTHREADS), args, LDS_BYTES, stream);
    if (e != hipSuccess) fprintf(stderr, "cooperative launch failed: %s (grid %d)\n", hipGetErrorString(e), grid);
#endif
}
```

```cpp
#include <hip/hip_runtime.h>
#include <hip/hip_cooperative_groups.h>
#include <cstdio>
#include <cstdint>
namespace cg = cooperative_groups;

#ifndef MK_MULTI
#define MK_MULTI 0
#endif

#define LAS __attribute__((address_space(3)))
typedef unsigned short bf16_t;
typedef short bf16x8 __attribute__((ext_vector_type(8)));
typedef float f32x4 __attribute__((ext_vector_type(4)));
typedef float f32x2 __attribute__((ext_vector_type(2)));
typedef unsigned u32x4 __attribute__((ext_vector_type(4)));
typedef unsigned u32x2 __attribute__((ext_vector_type(2)));

constexpr int BATCH = 8, SEQ = 2048, DM = 1024, DEPTH = 2, DIN = 15360, DFF = 2816;
constexpr int NB = 4;
constexpr int NGRP = BATCH / NB;
constexpr int TG = NB * SEQ;
constexpr int TA = BATCH * SEQ;
constexpr float EPS = 1e-6f;
constexpr int NTHREADS = 512;
constexpr int LDS_BYTES = 156 * 1024;

constexpr size_t MiB = 1u << 20;
constexpr size_t WS_WIN = 0;
constexpr size_t WS_WRET = WS_WIN + (size_t)DIN * DM * 2;
constexpr size_t WS_WHG = WS_WRET + (size_t)DM * 2048 * 2;
constexpr size_t WS_WFN = WS_WHG + (size_t)DM * DM * 2;
constexpr size_t WS_WOUT = WS_WFN + (size_t)DM * DM * 2;
constexpr size_t WS_WUP = WS_WOUT + (size_t)DM * DM * 2;
constexpr size_t WS_WDN = WS_WUP + (size_t)2 * DFF * DM * 2;
constexpr size_t WS_WEND = WS_WDN + (size_t)DM * DFF * 2;
static_assert(WS_WEND <= 58 * MiB, "weights");
constexpr size_t WS_DSEQ = 58 * MiB;
constexpr size_t WS_CDFT = 74 * MiB;
constexpr size_t WS_LB = WS_CDFT + 512 * 1024;
constexpr size_t WS_BAR = WS_CDFT + 640 * 1024;
constexpr size_t WS_ROPE = 75 * MiB;
constexpr size_t WS_MIXIN = 91 * MiB;
constexpr size_t WS_G = 123 * MiB;
constexpr size_t G_HOF = WS_G + 0 * MiB;
constexpr size_t G_Q = WS_G + 16 * MiB;
constexpr size_t G_K = WS_G + 32 * MiB;
constexpr size_t G_VT = WS_G + 48 * MiB;
constexpr size_t G_SGR = WS_G + 80 * MiB;
constexpr size_t G_HQ = WS_G + 112 * MiB;
constexpr size_t G_LFF = WS_G + 128 * MiB;
constexpr size_t G_LFB = WS_G + 144 * MiB;
constexpr size_t G_HI = WS_G + 160 * MiB;
constexpr size_t G_SGH = WS_G + 176 * MiB;
constexpr size_t G_FU = WS_G + 192 * MiB;
constexpr size_t G_GATES = WS_G + 208 * MiB;
constexpr size_t G_PQT = WS_G + 256 * MiB;
constexpr size_t G_SQ = WS_G + 16 * MiB;
constexpr size_t G_F1 = WS_G + 320 * MiB;
constexpr size_t G_F2 = WS_G + 336 * MiB;
constexpr size_t G_YF = WS_G + 288 * MiB;
constexpr size_t G_HOB = WS_G + 304 * MiB;
constexpr size_t G_END = WS_G + 320 * MiB;
constexpr size_t A_HN = WS_G + 0 * MiB;
constexpr size_t A_MIXO = WS_G + 32 * MiB;
constexpr size_t A_H = WS_G + 96 * MiB;
constexpr size_t A_FFO = A_H;
constexpr size_t A_ACT = WS_MIXIN;
constexpr size_t A_END = A_H + (size_t)TA * 2 * DFF * 2;
static_assert(G_END <= 480 * MiB && A_END <= 480 * MiB, "ws");
static_assert(A_ACT + (size_t)TA * DFF * 2 <= A_H, "act overlay");

__device__ __forceinline__ unsigned f2bf(float f) { unsigned u = __builtin_bit_cast(unsigned, f); return (u + 0x7fffu + ((u >> 16) & 1u)) >> 16; }
__device__ __forceinline__ unsigned pk2(float lo, float hi) { return f2bf(lo) | (f2bf(hi) << 16); }
__device__ __forceinline__ float bf2f(unsigned short h) { return __builtin_bit_cast(float, (unsigned)h << 16); }
__device__ __forceinline__ float bflo(unsigned w) { return __builtin_bit_cast(float, w << 16); }
__device__ __forceinline__ float bfhi(unsigned w) { return __builtin_bit_cast(float, w & 0xffff0000u); }
__device__ __forceinline__ float shx(float v, int o, int lane) { return __builtin_bit_cast(float, __builtin_amdgcn_ds_bpermute((lane ^ o) << 2, __builtin_bit_cast(int, v))); }
__device__ __forceinline__ float wave_sum(float v, int lane) {
#pragma unroll
    for (int o = 1; o < 64; o <<= 1) v += shx(v, o, lane);
    return v;
}
__device__ __forceinline__ int otid() { int t = threadIdx.x; asm volatile("" : "+v"(t)); return t; }
__device__ __forceinline__ int obid() { int t = blockIdx.x; asm volatile("" : "+s"(t)); return t; }
__device__ __forceinline__ int ogrid() { int t = gridDim.x; asm volatile("" : "+s"(t)); return t; }
typedef __bf16 bf16x2_t __attribute__((ext_vector_type(2)));
__device__ __forceinline__ unsigned cvtpk(float lo, float hi) { const f32x2 v = {lo, hi}; const bf16x2_t b = __builtin_convertvector(v, bf16x2_t); return __builtin_bit_cast(unsigned, b); }
__device__ __forceinline__ float silu_f(float x) { return x * __builtin_amdgcn_rcpf(1.f + __builtin_amdgcn_exp2f(-1.4426950408889634f * x)); }
__device__ __forceinline__ float sigm_f(float x) { return __builtin_amdgcn_rcpf(1.f + __builtin_amdgcn_exp2f(-1.4426950408889634f * x)); }
__device__ __forceinline__ f32x4 mfma16(bf16x8 a, bf16x8 b, f32x4 c) { return __builtin_amdgcn_mfma_f32_16x16x32_bf16(a, b, c, 0, 0, 0); }

namespace pg8 {
constexpr int BM = 256, BK = 64, HALF = 128, HTB = HALF * BK * 2, STAGE_BYTES = 8 * HTB, NXCD = 8, WGM = 8;
__host__ __device__ __forceinline__ int lds_byte(int r, int c) { const int st = (r >> 4) * 2 + (c >> 5), rr = r & 15, cc = c & 31, ob = rr * 64 + cc * 2; return st * 1024 + (ob ^ (((ob >> 9) & 1) << 5)); }
__host__ __device__ __forceinline__ void stage_rc(int b, int& R, int& C) { const int st = b / 1024, sb = b % 1024, swz = sb ^ (((sb >> 9) & 1) << 5); R = (st >> 1) * 16 + swz / 64; C = (st & 1) * 32 + (swz % 64) / 2; }
__host__ __device__ __forceinline__ int perm32(int rho) { const int n = rho >> 4, i = rho & 15; return 8 * (i >> 2) + 4 * n + (i & 3); }

struct Unit { int pm, pn, z; size_t offA, offB; };
struct Gemm { const bf16_t* A; const bf16_t* Bt; int lda, ldb, K; };

struct StaticOrder {
    int nM, nN, nwg, G, c;
    __device__ __forceinline__ void init(int nM_, int nN_, int G_, int c_) { nM = nM_; nN = nN_; nwg = nM * nN; G = G_; c = c_; }
    __device__ __forceinline__ bool next(int i, int& pm, int& pn) const {
        const long L = (long)i * G + c; if (L >= nwg) return false;
        int wgid = (int)L; { const int q = nwg / NXCD, r = nwg % NXCD, xcd = wgid % NXCD, off = wgid / NXCD; wgid = (xcd < r ? xcd * (q + 1) : r * (q + 1) + (xcd - r) * q) + off; }
        const int nig = WGM * nN, gid = wgid / nig, fm = gid * WGM, gsz = (nM - fm) < WGM ? (nM - fm) : WGM;
        pm = fm + ((wgid % nig) % gsz); pn = (wgid % nig) / gsz; return true;
    }
};
struct SchedPlain {
    StaticOrder o; size_t tA, tB;
    __device__ __forceinline__ void init(int M, int N, int lda, int ldb, int G, int c) { o.init(M / BM, N / BM, G, c); tA = (size_t)BM * lda * 2; tB = (size_t)BM * ldb * 2; }
    __device__ __forceinline__ bool next(int i, Unit& u) const { int pm, pn; if (!o.next(i, pm, pn)) return false; u.pm = pm; u.pn = pn; u.z = 0; u.offA = pm * tA; u.offB = pn * tB; return true; }
};
struct SchedInProj {
    StaticOrder o; size_t tA, tB;
    __device__ __forceinline__ void init(int G, int c) { o.init(TG / BM, 52, G, c); tA = (size_t)BM * DM * 2; tB = (size_t)BM * DM * 2; }
    __device__ __forceinline__ bool next(int i, Unit& u) const { int pm, pn; if (!o.next(i, pm, pn)) return false; if (pn >= 8) pn += 8; u.pm = pm; u.pn = pn; u.z = 0; u.offA = pm * tA; u.offB = pn * tB; return true; }
};
struct SchedChan {
    int G, c, base, lim;
    __device__ __forceinline__ void init(int G_, int c_, int base_ = 0, int lim_ = 4 * 2 * (TG / BM)) { G = G_; c = c_; base = base_; lim = lim_; }
    __device__ __forceinline__ bool next(int i, Unit& u) const {
        const int L = base + i * G + c; constexpr int NT = TG / BM; if (L >= lim) return false;
        const int g = L / (2 * NT), r = L % (2 * NT); u.z = g; u.pm = r / NT; u.pn = r % NT;
        u.offA = (size_t)u.pm * BM * 256 * 2; u.offB = ((size_t)u.pn * BM * DM + g * 256) * 2; return true;
    }
};

struct SchedSeqH {
    int G, c;
    __device__ __forceinline__ void init(int G_, int c_) { G = G_; c = c_; }
    __device__ __forceinline__ bool next(int i, Unit& u) const {
        const int L = i * G + c; constexpr int NN = NB * 1024 / BM; if (L >= 2 * 4 * NN) return false;
        const int z = L / (4 * NN), r = L % (4 * NN); u.z = z; u.pm = r / NN; u.pn = r % NN;
        u.offA = ((size_t)u.pm * BM * 4096 + z * 2048) * 2; u.offB = ((size_t)u.pn * BM * 4096 + z * 2048) * 2; return true;
    }
};
__device__ __forceinline__ unsigned cvt_pk_bf16(float lo, float hi) { return cvtpk(lo, hi); }

template <class Epi, class Sched, bool ALIGN_EPI = true, bool SP2 = true>
__device__ __forceinline__ void gemm_phase(LAS unsigned char* lds, const Gemm g, const Sched& S, const Epi& E) {
    int tid_ = threadIdx.x; asm volatile("" : "+v"(tid_));
    const int tid = tid_, wid = __builtin_amdgcn_readfirstlane(tid >> 6), lane = tid & 63, wr = wid >> 2, wc = wid & 3, fr = lane & 15, fq = lane >> 4;
    const int K = g.K, nt = K / BK;
    unsigned voffA[2], voffB[2];
#pragma unroll
    for (int i = 0; i < 2; ++i) { int R, C; stage_rc(tid * 16 + i * 8192, R, C); const int Rb = Epi::PERM ? ((R & ~31) + perm32(R & 31)) : R;
        voffA[i] = (unsigned)(R * g.lda + C) * 2u; voffB[i] = (unsigned)(Rb * g.ldb + C) * 2u; }
    const size_t kstep = (size_t)(BK * 2);
    const size_t hstepA = (size_t)HALF * g.lda * 2, hstepB = (size_t)HALF * g.ldb * 2;
    const unsigned ldsw = (unsigned)wid * 1024u;
    const int aoff = lds_byte(wr * 64 + fr, fq * 8), boff = lds_byte(wc * 32 + fr, fq * 8);
#define PG8_SA(b, h) (((b) * 2 + (h)) * HTB)
#define PG8_SB(b, h) ((4 + (b) * 2 + (h)) * HTB)
#define PG8_STAGE(bufoff, gbase, voff) do { const char* _gb = (const char*)(gbase); asm volatile("" : "+s"(_gb));     \
        _Pragma("unroll") for (int _i = 0; _i < 2; ++_i) \
        __builtin_amdgcn_global_load_lds((const unsigned*)(_gb + (voff)[_i]), (LAS unsigned*)(lds + (bufoff) + ldsw + _i * 8192), 16, 0, 0); } while (0)
#define PG8_LDA(dst, b, h) do { _Pragma("unroll") for (int m = 0; m < 4; ++m) _Pragma("unroll") for (int k = 0; k < 2; ++k) dst[m][k] = *(const LAS bf16x8*)(lds + PG8_SA(b, h) + aoff + m * 2048 + k * 1024); } while (0)
#define PG8_LDB(dst, b, h) do { _Pragma("unroll") for (int n = 0; n < 2; ++n) _Pragma("unroll") for (int k = 0; k < 2; ++k) dst[n][k] = *(const LAS bf16x8*)(lds + PG8_SB(b, h) + boff + n * 2048 + k * 1024); } while (0)
#define PG8_MMA(ai, bj, At, Bt) do { __builtin_amdgcn_s_setprio(1); _Pragma("unroll") for (int m = 0; m < 4; ++m) _Pragma("unroll") for (int n = 0; n < 2; ++n) _Pragma("unroll") for (int k = 0; k < 2; ++k) \
        acc[ai][bj][m][n] = __builtin_amdgcn_mfma_f32_16x16x32_bf16(Bt[n][k], At[m][k], acc[ai][bj][m][n], 0, 0, 0); __builtin_amdgcn_s_setprio(0); } while (0)
#define PG8_WAIT_V(n) asm volatile("s_waitcnt vmcnt(" #n ")" ::: "memory")
#define PG8_WAIT_L(n) asm volatile("s_waitcnt lgkmcnt(" #n ")" ::: "memory")
#define PG8_BAR __builtin_amdgcn_s_barrier()
#define PG8_SCHED __builtin_amdgcn_sched_barrier(0)
    Unit cur, nxt; int ui = 0;
    if (!S.next(0, cur)) return;
    f32x4 acc[2][2][4][2];
#pragma unroll
    for (int a = 0; a < 2; ++a)
#pragma unroll
        for (int b = 0; b < 2; ++b)
#pragma unroll
            for (int m = 0; m < 4; ++m)
#pragma unroll
                for (int n = 0; n < 2; ++n) acc[a][b][m][n] = (f32x4){0.f, 0.f, 0.f, 0.f};
    bf16x8 At[4][2], B0[2][2], B1[2][2];
    const char* cA = (const char*)g.A + cur.offA; const char* cB = (const char*)g.Bt + cur.offB;
    if constexpr (SP2) {
        PG8_STAGE(PG8_SB(0, 0), cB, voffB); PG8_STAGE(PG8_SB(0, 1), cB + hstepB, voffB); PG8_STAGE(PG8_SA(0, 0), cA, voffA); PG8_STAGE(PG8_SA(0, 1), cA + hstepA, voffA);
        if (wr == 1) PG8_BAR;
        PG8_WAIT_V(2); PG8_BAR;
        PG8_STAGE(PG8_SB(1, 0), cB + kstep, voffB); PG8_STAGE(PG8_SA(1, 0), cA + kstep, voffA); PG8_STAGE(PG8_SB(1, 1), cB + hstepB + kstep, voffB);
        PG8_WAIT_V(6); PG8_BAR;
    } else {
        PG8_STAGE(PG8_SB(0, 0), cB, voffB); PG8_STAGE(PG8_SA(0, 0), cA, voffA); PG8_STAGE(PG8_SB(0, 1), cB + hstepB, voffB); PG8_STAGE(PG8_SA(0, 1), cA + hstepA, voffA);
        if (wr == 1) PG8_BAR;
        PG8_WAIT_V(4); PG8_BAR;
        PG8_STAGE(PG8_SB(1, 0), cB + kstep, voffB); PG8_STAGE(PG8_SA(1, 0), cA + kstep, voffA); PG8_STAGE(PG8_SB(1, 1), cB + hstepB + kstep, voffB);
        PG8_WAIT_V(6); PG8_BAR;
    }
    for (;;) {
        const bool has_next = S.next(ui + 1, nxt);
        const char* nA = has_next ? (const char*)g.A + nxt.offA : cA; const char* nB = has_next ? (const char*)g.Bt + nxt.offB : cB;
        for (int t = 0; t < nt; t += 2) {
            const bool last = (t == nt - 2);
            const char* a1 = cA + (size_t)(t + 1) * kstep;
            const char* a2 = last ? nA : cA + (size_t)(t + 2) * kstep; const char* b2 = last ? nB : cB + (size_t)(t + 2) * kstep;
            const char* a3 = a2 + kstep; const char* b3 = b2 + kstep;
            if constexpr (SP2) {
            PG8_LDB(B0, 0, 0); PG8_LDB(B1, 0, 1); PG8_SCHED; PG8_LDA(At, 0, 0); PG8_STAGE(PG8_SA(1, 1), a1 + hstepA, voffA);
            PG8_WAIT_V(8); PG8_WAIT_L(0); PG8_BAR; PG8_MMA(0, 0, At, B0); PG8_MMA(0, 1, At, B1); PG8_BAR; PG8_SCHED;
            PG8_LDA(At, 0, 1); PG8_STAGE(PG8_SB(0, 0), b2, voffB); PG8_STAGE(PG8_SB(0, 1), b2 + hstepB, voffB); PG8_STAGE(PG8_SA(0, 0), a2, voffA);
            PG8_WAIT_V(8); PG8_WAIT_L(0); PG8_BAR; PG8_MMA(1, 0, At, B0); PG8_MMA(1, 1, At, B1); PG8_BAR; PG8_SCHED;
            PG8_LDB(B0, 1, 0); PG8_LDB(B1, 1, 1); PG8_SCHED; PG8_LDA(At, 1, 0); PG8_STAGE(PG8_SA(0, 1), a2 + hstepA, voffA);
            PG8_WAIT_V(8); PG8_WAIT_L(0); PG8_BAR; PG8_MMA(0, 0, At, B0); PG8_MMA(0, 1, At, B1); PG8_BAR; PG8_SCHED;
            PG8_LDA(At, 1, 1); PG8_STAGE(PG8_SB(1, 0), b3, voffB); PG8_STAGE(PG8_SB(1, 1), b3 + hstepB, voffB); PG8_STAGE(PG8_SA(1, 0), a3, voffA);
            PG8_WAIT_V(8); PG8_WAIT_L(0); PG8_BAR; PG8_MMA(1, 0, At, B0); PG8_MMA(1, 1, At, B1); PG8_BAR; PG8_SCHED;
            } else {
            PG8_LDB(B0, 0, 0); PG8_SCHED; PG8_LDA(At, 0, 0); PG8_STAGE(PG8_SA(1, 1), a1 + hstepA, voffA);
            PG8_WAIT_L(8); PG8_BAR; PG8_WAIT_L(0); PG8_MMA(0, 0, At, B0); PG8_BAR; PG8_SCHED;
            PG8_LDB(B1, 0, 1); PG8_STAGE(PG8_SB(0, 0), b2, voffB);
            PG8_BAR; PG8_WAIT_L(0); PG8_MMA(0, 1, At, B1); PG8_BAR;
            PG8_LDA(At, 0, 1); PG8_STAGE(PG8_SA(0, 0), a2, voffA);
            PG8_BAR; PG8_WAIT_L(0); PG8_MMA(1, 0, At, B0); PG8_BAR; PG8_SCHED;
            PG8_STAGE(PG8_SB(0, 1), b2 + hstepB, voffB);
            PG8_WAIT_V(6); PG8_BAR; PG8_MMA(1, 1, At, B1); PG8_BAR;
            PG8_LDB(B0, 1, 0); PG8_SCHED; PG8_LDA(At, 1, 0); PG8_STAGE(PG8_SA(0, 1), a2 + hstepA, voffA);
            PG8_WAIT_L(8); PG8_BAR; PG8_WAIT_L(0); PG8_MMA(0, 0, At, B0); PG8_BAR; PG8_SCHED;
            PG8_LDB(B1, 1, 1); PG8_STAGE(PG8_SB(1, 0), b3, voffB);
            PG8_BAR; PG8_WAIT_L(0); PG8_MMA(0, 1, At, B1); PG8_BAR;
            PG8_LDA(At, 1, 1); PG8_STAGE(PG8_SA(1, 0), a3, voffA);
            PG8_BAR; PG8_WAIT_L(0); PG8_MMA(1, 0, At, B0); PG8_BAR; PG8_SCHED;
            PG8_STAGE(PG8_SB(1, 1), b3 + hstepB, voffB);
            PG8_WAIT_V(6); PG8_BAR; PG8_MMA(1, 1, At, B1); PG8_BAR;
            }
        }
        if constexpr (ALIGN_EPI) { if (wr == 0) PG8_BAR; }
        { int t2 = tid; asm volatile("" : "+v"(t2));
          const int w2 = t2 >> 6, l2 = t2 & 63; E(acc, cur, w2 >> 2, w2 & 3, l2 & 15, l2 >> 4); }
        if (!has_next) break;
#pragma unroll
        for (int a = 0; a < 2; ++a)
#pragma unroll
            for (int b = 0; b < 2; ++b)
#pragma unroll
                for (int m = 0; m < 4; ++m)
#pragma unroll
                    for (int n = 0; n < 2; ++n) acc[a][b][m][n] = (f32x4){0.f, 0.f, 0.f, 0.f};
        cur = nxt; cA = nA; cB = nB; ++ui;
        if constexpr (ALIGN_EPI) { if (wr == 1) PG8_BAR; }
    }
    PG8_WAIT_V(0);
    if constexpr (!ALIGN_EPI) { if (wr == 0) PG8_BAR; }
    PG8_BAR;
#undef PG8_SA
#undef PG8_SB
#undef PG8_STAGE
#undef PG8_LDA
#undef PG8_LDB
#undef PG8_MMA
#undef PG8_WAIT_V
#undef PG8_WAIT_L
#undef PG8_BAR
#undef PG8_SCHED
}

typedef f32x4 Acc[2][2][4][2];
#define EPI_ROW_FENCE __builtin_amdgcn_sched_barrier(0)
__device__ __forceinline__ u32x4 pack8(const f32x4 v0, const f32x4 v1) { u32x4 w; w.x = cvt_pk_bf16(v0[0], v0[1]); w.y = cvt_pk_bf16(v0[2], v0[3]); w.z = cvt_pk_bf16(v1[0], v1[1]); w.w = cvt_pk_bf16(v1[2], v1[3]); return w; }

template <int LDC> __device__ __forceinline__ void store_tile_bf16(const Acc& acc, bf16_t* base) {
#pragma unroll
    for (int ai = 0; ai < 2; ++ai)
#pragma unroll
        for (int m = 0; m < 4; ++m) { bf16_t* rowp = base + (size_t)(ai * HALF + m * 16) * LDC;
#pragma unroll
            for (int bj = 0; bj < 2; ++bj) *(u32x4*)(rowp + bj * HALF) = pack8(acc[ai][bj][m][0], acc[ai][bj][m][1]);
            EPI_ROW_FENCE; }
}
template <int LDC> struct EpiBf16 {
    static constexpr bool PERM = true;
    bf16_t* O;
    __device__ __forceinline__ void operator()(const Acc& acc, const Unit& u, int wr, int wc, int fr, int fq) const {
        store_tile_bf16<LDC>(acc, O + (size_t)(u.pm * BM + wr * 64 + fr) * LDC + u.pn * BM + wc * 32 + 8 * fq);
    }
};
struct EpiF32 {
    static constexpr bool PERM = false;
    float* O;
    __device__ __forceinline__ void operator()(const Acc& acc, const Unit& u, int wr, int wc, int fr, int fq) const {
        float* base = O + (size_t)(u.pm * BM + wr * 64 + fr) * DM + u.pn * BM + wc * 32 + 4 * fq;
#pragma unroll
        for (int ai = 0; ai < 2; ++ai)
#pragma unroll
            for (int m = 0; m < 4; ++m) { float* rowp = base + (size_t)(ai * HALF + m * 16) * DM;
#pragma unroll
                for (int bj = 0; bj < 2; ++bj)
#pragma unroll
                    for (int n = 0; n < 2; ++n) *(f32x4*)(rowp + bj * HALF + 16 * n) = acc[ai][bj][m][n];
                EPI_ROW_FENCE; }
    }
};
struct EpiSeqH {
    static constexpr bool PERM = true;
    bf16_t* O;
    __device__ __forceinline__ void operator()(const Acc& acc, const Unit& u, int wr, int wc, int fr, int fq) const {
        constexpr int LD = NB * 1024;
        store_tile_bf16<LD>(acc, O + ((size_t)u.z * 1024 + u.pm * BM + wr * 64 + fr) * LD + u.pn * BM + wc * 32 + 8 * fq);
    }
};
template <int MODE> struct EpiMix {
    static constexpr bool PERM = false;
    bf16_t* F; const bf16_t* gates;
    __device__ __forceinline__ void operator()(const Acc& acc, const Unit& u, int wr, int wc, int fr, int fq) const {
        const size_t row0 = u.pm * BM + wr * 64 + fr; const int col0 = u.pn * BM + wc * 32 + 4 * fq;
        bf16_t* fb = F + row0 * DM + col0; const bf16_t* gb = gates + row0 * 3072 + col0;
#pragma unroll
        for (int ai = 0; ai < 2; ++ai) {
            u32x2 gw[4][4], ow[4][4];
#pragma unroll
            for (int m = 0; m < 4; ++m)
#pragma unroll
                for (int q = 0; q < 4; ++q) { const int ro = ai * HALF + m * 16, co = (q >> 1) * HALF + 16 * (q & 1);
                    gw[m][q] = *(const u32x2*)(gb + (size_t)ro * 3072 + co);
                    if (MODE >= 1) ow[m][q] = *(const u32x2*)(fb + (size_t)ro * DM + co); }
#pragma unroll
            for (int m = 0; m < 4; ++m)
#pragma unroll
                for (int q = 0; q < 4; ++q) { const int ro = ai * HALF + m * 16, co = (q >> 1) * HALF + 16 * (q & 1);
                    f32x4 v = acc[ai][q >> 1][m][q & 1]; v[0] *= bflo(gw[m][q].x); v[1] *= bfhi(gw[m][q].x); v[2] *= bflo(gw[m][q].y); v[3] *= bfhi(gw[m][q].y);
                    if (MODE >= 1) { v[0] += bflo(ow[m][q].x); v[1] += bfhi(ow[m][q].x); v[2] += bflo(ow[m][q].y); v[3] += bfhi(ow[m][q].y); }
                    u32x2 w; w.x = cvt_pk_bf16(v[0], v[1]); w.y = cvt_pk_bf16(v[2], v[3]); *(u32x2*)(fb + (size_t)ro * DM + co) = w; }
            EPI_ROW_FENCE; }
    }
};
struct EpiChan {
    static constexpr bool PERM = true;
    bf16_t* PQT;
    __device__ __forceinline__ void operator()(const Acc& acc, const Unit& u, int wr, int wc, int fr, int fq) const {
        const int tok0 = u.pn * BM, bl = tok0 >> 11, s0 = (tok0 & (SEQ - 1)) + wc * 32 + 8 * fq;
        store_tile_bf16<4096>(acc, PQT + ((size_t)(bl * 1024 + u.z * 256 + wr * 64 + fr)) * 4096 + u.pm * 2048 + s0);
    }
};
struct EpiSeq {
    static constexpr bool PERM = true;
    bf16_t* YF;
    __device__ __forceinline__ void operator()(const Acc& acc, const Unit& u, int wr, int wc, int fr, int fq) const {
        const int bl = u.pn >> 2, gc0 = (u.pn & 3) * 256 + wc * 32 + 8 * fq;
        store_tile_bf16<DM>(acc, YF + ((size_t)(bl * SEQ + u.pm * BM + wr * 64 + fr)) * DM + gc0);
    }
};
template <int KIND, int LDC> __device__ __forceinline__ void store_act(const Acc& acc, bf16_t* base, const float* lbp) {
    f32x4 lbv4[2][2];
#pragma unroll
    for (int bj = 0; bj < 2; ++bj)
#pragma unroll
        for (int n = 0; n < 2; ++n) lbv4[bj][n] = (KIND == 4) ? *(const f32x4*)(lbp + bj * HALF + 4 * n) : (f32x4){0.f, 0.f, 0.f, 0.f};
#pragma unroll
    for (int ai = 0; ai < 2; ++ai)
#pragma unroll
        for (int m = 0; m < 4; ++m) { bf16_t* rowp = base + (size_t)(ai * HALF + m * 16) * LDC;
#pragma unroll
            for (int bj = 0; bj < 2; ++bj) { f32x4 v[2] = {acc[ai][bj][m][0], acc[ai][bj][m][1]};
#pragma unroll
                for (int n = 0; n < 2; ++n) { const f32x4 lb = lbv4[bj][n];
#pragma unroll
                    for (int j = 0; j < 4; ++j) { float x = v[n][j];
                        if (KIND == 2) x = silu_f(x);
                        else if (KIND == 3) x = silu_f(x) * 0.08838834764831845f;
                        else if (KIND == 7) x = sigm_f(x);
                        else if (KIND == 4) { const float l = lb[j], e = __expf(-fabsf(x));
                            const float f = (x >= 0.f ? (1.f + l * e) : (e + l)) * __builtin_amdgcn_rcpf(1.f + e); x = fmaxf(__builtin_amdgcn_logf(f), -115.f); }
                        v[n][j] = x; } }
                *(u32x4*)(rowp + bj * HALF) = pack8(v[0], v[1]); }
            EPI_ROW_FENCE; }
}
struct EpiInProj {
    static constexpr bool PERM = true;
    unsigned char* ws; const float* rope; const float* lbv; int tok0;
    __device__ __forceinline__ void operator()(const Acc& acc, const Unit& u, int wr, int wc, int fr, int fq) const {
        const int pn = u.pn;
        const size_t row0 = u.pm * BM + wr * 64 + fr;
        const int cin = wc * 32 + 8 * fq;
        if (pn < 8) {
            const float sc = pn >= 4 ? 0.0625f : 1.0f;
            bf16_t* base = (bf16_t*)(ws + (pn >= 4 ? G_K : G_Q)) + row0 * DM + (pn & 3) * BM + cin;
            const float* rb = rope + ((size_t)(tok0 + row0) * 128 + cin) * 2;
#pragma unroll
            for (int ai = 0; ai < 2; ++ai) {
                f32x4 cs[4][4];
#pragma unroll
                for (int m = 0; m < 4; ++m) { const f32x4* rp = (const f32x4*)(rb + (size_t)(ai * HALF + m * 16) * 256);
#pragma unroll
                    for (int q = 0; q < 4; ++q) cs[m][q] = rp[q]; }
#pragma unroll
                for (int m = 0; m < 4; ++m) { const int ro = ai * HALF + m * 16;
                    f32x4 o1[2], o2[2];
#pragma unroll
                    for (int n = 0; n < 2; ++n) { const f32x4 cs0 = cs[m][2 * n], cs1 = cs[m][2 * n + 1];
                        const f32x4 x1 = acc[ai][0][m][n], x2 = acc[ai][1][m][n];
                        o1[n][0] = (x1[0] * cs0[0] - x2[0] * cs0[1]) * sc; o2[n][0] = (x1[0] * cs0[1] + x2[0] * cs0[0]) * sc;
                        o1[n][1] = (x1[1] * cs0[2] - x2[1] * cs0[3]) * sc; o2[n][1] = (x1[1] * cs0[3] + x2[1] * cs0[2]) * sc;
                        o1[n][2] = (x1[2] * cs1[0] - x2[2] * cs1[1]) * sc; o2[n][2] = (x1[2] * cs1[1] + x2[2] * cs1[0]) * sc;
                        o1[n][3] = (x1[3] * cs1[2] - x2[3] * cs1[3]) * sc; o2[n][3] = (x1[3] * cs1[3] + x2[3] * cs1[2]) * sc; }
                    bf16_t* rowp = base + (size_t)ro * DM;
                    *(u32x4*)rowp = pack8(o1[0], o1[1]);
                    *(u32x4*)(rowp + HALF) = pack8(o2[0], o2[1]); }
                EPI_ROW_FENCE; }
            return;
        }
        if (pn < 24) store_act<2, 2048>(acc, (bf16_t*)(ws + G_SGR) + row0 * 2048 + (pn - 16) * BM + cin, nullptr);
        else if (pn < 28) store_act<3, DM>(acc, (bf16_t*)(ws + G_HQ) + row0 * DM + (pn - 24) * BM + cin, nullptr);
        else if (pn < 32) store_act<4, DM>(acc, (bf16_t*)(ws + G_LFF) + row0 * DM + (pn - 28) * BM + cin, lbv + (pn - 28) * BM + cin);
        else if (pn < 36) store_act<4, DM>(acc, (bf16_t*)(ws + G_LFB) + row0 * DM + (pn - 32) * BM + cin, lbv + 1024 + (pn - 32) * BM + cin);
        else if (pn < 40) store_act<6, DM>(acc, (bf16_t*)(ws + G_HI) + row0 * DM + (pn - 36) * BM + cin, nullptr);
        else if (pn < 44) store_act<2, DM>(acc, (bf16_t*)(ws + G_SGH) + row0 * DM + (pn - 40) * BM + cin, nullptr);
        else if (pn < 48) store_act<6, DM>(acc, (bf16_t*)(ws + G_FU) + row0 * DM + (pn - 44) * BM + cin, nullptr);
        else store_act<7, 3072>(acc, (bf16_t*)(ws + G_GATES) + row0 * 3072 + (pn - 48) * BM + cin, nullptr);
    }
};
}

struct Params {
    const float* x; const int* pos; const float* norm_w; const float* w_in; const float* lb_logits; const float* hgrn_norm_w;
    const float* w_ret_o; const float* w_hgrn_o; const float* w_fnet; const float* w_out; const float* w_up; const float* conv_w; const float* conv_b; const float* w_down;
    float* out; unsigned char* ws; int ph_lo, ph_hi;
};

__device__ __forceinline__ void transpose_item(const float* W, int K, int N, bf16_t* WT, LAS float* scr, int item, int lane) {
    const int nblk = N / 32, kb = item / nblk, nb = item % nblk, k0 = 64 * kb, n0 = 32 * nb;
#pragma unroll 8
    for (int i = 0; i < 32; ++i) { const int kk = 2 * i + (lane >> 5); scr[kk * 33 + (lane & 31)] = W[(size_t)(k0 + kk) * N + n0 + (lane & 31)]; }
    asm volatile("s_waitcnt lgkmcnt(0)" ::: "memory");
    const int c = lane & 7;
#pragma unroll
    for (int j = 0; j < 4; ++j) { const int n = (lane >> 3) + 8 * j; const LAS float* s = scr + (8 * c) * 33 + n;
        u32x4 o; o.x = pk2(s[0 * 33], s[1 * 33]); o.y = pk2(s[2 * 33], s[3 * 33]); o.z = pk2(s[4 * 33], s[5 * 33]); o.w = pk2(s[6 * 33], s[7 * 33]);
        *(u32x4*)(WT + (size_t)(n0 + n) * K + k0 + 8 * c) = o; }
    asm volatile("s_waitcnt lgkmcnt(0)" ::: "memory");
}

__device__ __forceinline__ void prep_weights(const Params& p, int l, LAS unsigned char* lds) {
    const int tid = otid(), lane = tid & 63, wave = tid >> 6;
    LAS float* scr = (LAS float*)(lds + wave * 16384);
    const int gw = obid() * 8 + wave, NGW = ogrid() * 8;
    unsigned char* ws = p.ws;
    constexpr int I_IN = (DM / 64) * (DIN / 32), I_RET = (2048 / 64) * (DM / 32), I_SQ = (DM / 64) * (DM / 32), I_UP = (DM / 64) * (2 * DFF / 32), I_DN = (DFF / 64) * (DM / 32);
    constexpr int NITEMS = I_IN + I_RET + 3 * I_SQ + I_UP + I_DN;
    for (int it = gw; it < NITEMS; it += NGW) {
        int r = it;
        if (r < I_IN) { transpose_item(p.w_in + (size_t)l * DM * DIN, DM, DIN, (bf16_t*)(ws + WS_WIN), scr, r, lane); continue; } r -= I_IN;
        if (r < I_RET) { transpose_item(p.w_ret_o + (size_t)l * 2048 * DM, 2048, DM, (bf16_t*)(ws + WS_WRET), scr, r, lane); continue; } r -= I_RET;
        if (r < I_SQ) { transpose_item(p.w_hgrn_o + (size_t)l * DM * DM, DM, DM, (bf16_t*)(ws + WS_WHG), scr, r, lane); continue; } r -= I_SQ;
        if (r < I_SQ) { transpose_item(p.w_fnet + (size_t)l * DM * DM, DM, DM, (bf16_t*)(ws + WS_WFN), scr, r, lane); continue; } r -= I_SQ;
        if (r < I_SQ) { transpose_item(p.w_out + (size_t)l * DM * DM, DM, DM, (bf16_t*)(ws + WS_WOUT), scr, r, lane); continue; } r -= I_SQ;
        if (r < I_UP) { transpose_item(p.w_up + (size_t)l * DM * 2 * DFF, DM, 2 * DFF, (bf16_t*)(ws + WS_WUP), scr, r, lane); continue; } r -= I_UP;
        transpose_item(p.w_down + (size_t)l * DFF * DM, DFF, DM, (bf16_t*)(ws + WS_WDN), scr, r, lane);
    }
    const int gt = obid() * NTHREADS + tid;
    if (gt < 2 * DM) { const int dir = gt / DM, c = gt % DM;
        float lg[DEPTH], mx = -1e30f;
#pragma unroll
        for (int j = 0; j < DEPTH; ++j) { lg[j] = p.lb_logits[((size_t)dir * DEPTH + j) * DM + c]; mx = fmaxf(mx, lg[j]); }
        float den = 0.f, num = 0.f;
#pragma unroll
        for (int j = 0; j < DEPTH; ++j) { const float e = expf(lg[j] - mx); den += e; if (j >= 1 && j <= l) num += e; }
        ((float*)(ws + WS_LB))[gt] = fmaxf(num / den, 1e-30f); }
}

__device__ __forceinline__ void prep_tables(const Params& p) {
    const int gt = obid() * NTHREADS + otid(), NT = ogrid() * NTHREADS;
    unsigned char* ws = p.ws;
    bf16_t* dseq = (bf16_t*)(ws + WS_DSEQ);
    const float sc1 = 0.02209708691207961f;
    for (int it = gt; it < 2048 * 512; it += NT) { const int sp = it / 512, k0 = (it % 512) * 8;
        unsigned w[4];
#pragma unroll
        for (int h = 0; h < 4; ++h) { float v[2];
#pragma unroll
            for (int q = 0; q < 2; ++q) { const int kc = k0 + 2 * h + q, s = kc & 2047; const int ph = (s * sp) & 2047; const float a = (float)ph * (1.f / 1024.f);
                v[q] = (kc >> 11) ? -sinpif(a) * sc1 : cospif(a) * sc1; }
            w[h] = pk2(v[0], v[1]); }
        *(u32x4*)(dseq + (size_t)sp * 4096 + k0) = (u32x4){w[0], w[1], w[2], w[3]}; }
    bf16_t* cd = (bf16_t*)(ws + WS_CDFT);
    for (int it = gt; it < 512 * 256; it += NT) { const int r = it / 256, c = it % 256, cp = r & 255; const int ph = (c * cp) & 255; const float a = (float)ph * (1.f / 128.f);
        const float v = (r >> 8) ? sinpif(a) : cospif(a); cd[it] = (bf16_t)f2bf(v * 0.0625f); }
    f32x2* rope = (f32x2*)(ws + WS_ROPE);
    for (int it = gt; it < TA * 128; it += NT) { const int tok = it >> 7, i = it & 127;
        const float inv = powf(10000.f, -(float)i * (1.f / 128.f));
        const float ang = (float)p.pos[tok] * inv;
        double t = (double)ang * 0.31830988618379067; t -= 2.0 * rint(t * 0.5); const float tf = (float)t;
        rope[it] = (f32x2){cospif(tf), sinpif(tf)}; }
}

__device__ __forceinline__ void rms_rows(const float* xsrc, const float* w, bf16_t* XN, int nrows) {
    const int tid = otid(), lane = tid & 63, gw = obid() * 8 + (tid >> 6), NGW = ogrid() * 8;
    f32x4 wv[4];
#pragma unroll
    for (int j = 0; j < 4; ++j) wv[j] = ((const f32x4*)w)[lane + 64 * j];
    for (int m = gw; m < nrows; m += NGW) {
        const f32x4* xr = (const f32x4*)(xsrc + (size_t)m * DM); f32x4 v[4]; float ss = 0.f;
#pragma unroll
        for (int j = 0; j < 4; ++j) { v[j] = xr[lane + 64 * j]; ss += (v[j][0] * v[j][0] + v[j][1] * v[j][1]) + (v[j][2] * v[j][2] + v[j][3] * v[j][3]); }
        const float r = rsqrtf(wave_sum(ss, lane) * (1.f / DM) + EPS);
        u32x2* o = (u32x2*)(XN + (size_t)m * DM);
#pragma unroll
        for (int j = 0; j < 4; ++j) { const f32x4 y = v[j] * r * wv[j]; o[lane + 64 * j] = (u32x2){pk2(y[0], y[1]), pk2(y[2], y[3])}; }
    }
}
__device__ __forceinline__ void resid_rows(const bf16_t* V, const float* xsrc, float* out, const float* w1, const float* w2, bf16_t* HN) {
    const int tid = otid(), lane = tid & 63, gw = obid() * 8 + (tid >> 6), NGW = ogrid() * 8;
    f32x4 w1v[4], w2v[4];
#pragma unroll
    for (int j = 0; j < 4; ++j) { w1v[j] = ((const f32x4*)w1)[lane + 64 * j]; w2v[j] = HN ? ((const f32x4*)w2)[lane + 64 * j] : (f32x4){0.f, 0.f, 0.f, 0.f}; }
    for (int m = gw; m < TA; m += NGW) {
        const u32x2* vr = (const u32x2*)(V + (size_t)m * DM); const f32x4* xr = (const f32x4*)(xsrc + (size_t)m * DM); f32x4 v[4]; float ss = 0.f;
#pragma unroll
        for (int j = 0; j < 4; ++j) { const u32x2 vw = vr[lane + 64 * j]; v[j] = (f32x4){bflo(vw.x), bfhi(vw.x), bflo(vw.y), bfhi(vw.y)}; ss += (v[j][0] * v[j][0] + v[j][1] * v[j][1]) + (v[j][2] * v[j][2] + v[j][3] * v[j][3]); }
        const float r = rsqrtf(wave_sum(ss, lane) * (1.f / DM) + EPS); float s2 = 0.f;
#pragma unroll
        for (int j = 0; j < 4; ++j) { v[j] = xr[lane + 64 * j] + v[j] * r * w1v[j]; ((f32x4*)(out + (size_t)m * DM))[lane + 64 * j] = v[j];
            s2 += (v[j][0] * v[j][0] + v[j][1] * v[j][1]) + (v[j][2] * v[j][2] + v[j][3] * v[j][3]); }
        if (HN) { const float r2 = rsqrtf(wave_sum(s2, lane) * (1.f / DM) + EPS); u32x2* o = (u32x2*)(HN + (size_t)m * DM);
#pragma unroll
            for (int j = 0; j < 4; ++j) { const f32x4 y = v[j] * r2 * w2v[j]; o[lane + 64 * j] = (u32x2){pk2(y[0], y[1]), pk2(y[2], y[3])}; } }
    }
}

__device__ __forceinline__ float gelu_tanh(float x) { const float y = 0.7978845608028654f * (x + 0.044715f * x * x * x); const float t = 1.f - 2.f * __builtin_amdgcn_rcpf(1.f + __builtin_amdgcn_exp2f(2.8853900817779268f * y)); return 0.5f * x * (1.f + t); }
__device__ __forceinline__ void ld8(const bf16_t* p, float (&v)[8]) { const u32x4 w = *(const u32x4*)p; v[0] = bflo(w.x); v[1] = bfhi(w.x); v[2] = bflo(w.y); v[3] = bfhi(w.y); v[4] = bflo(w.z); v[5] = bfhi(w.z); v[6] = bflo(w.w); v[7] = bfhi(w.w); }
__device__ __forceinline__ void conv_phase(const bf16_t* H, const float* cw, const float* cb, bf16_t* ACT) {
    constexpr int RB = 16, NCH = DFF / 8;
    const int gt = obid() * NTHREADS + otid(), NT = ogrid() * NTHREADS;
    for (int it = gt; it < (TA / RB) * NCH; it += NT) {
        const int ch = it % NCH, rb = it / NCH, c0 = ch * 8, m0 = rb * RB, s0 = m0 % SEQ;
        float wg[3][8], wu[3][8], bg[8], bu[8];
#pragma unroll
        for (int t = 0; t < 3; ++t)
#pragma unroll
            for (int j = 0; j < 8; ++j) { wg[t][j] = cw[(size_t)t * 2 * DFF + c0 + j]; wu[t][j] = cw[(size_t)t * 2 * DFF + DFF + c0 + j]; }
#pragma unroll
        for (int j = 0; j < 8; ++j) { bg[j] = cb[c0 + j]; bu[j] = cb[DFF + c0 + j]; }
        float g0[8], g1[8], g2[8], u0[8], u1[8], u2[8];
        if (s0 > 0) { ld8(H + (size_t)(m0 - 1) * 2 * DFF + c0, g0); ld8(H + (size_t)(m0 - 1) * 2 * DFF + DFF + c0, u0); }
        else {
#pragma unroll
            for (int j = 0; j < 8; ++j) { g0[j] = 0.f; u0[j] = 0.f; } }
        ld8(H + (size_t)m0 * 2 * DFF + c0, g1); ld8(H + (size_t)m0 * 2 * DFF + DFF + c0, u1);
        for (int r = 0; r < RB; ++r) { const int m = m0 + r;
            if (s0 + r + 1 < SEQ) { ld8(H + (size_t)(m + 1) * 2 * DFF + c0, g2); ld8(H + (size_t)(m + 1) * 2 * DFF + DFF + c0, u2); }
            else {
#pragma unroll
                for (int j = 0; j < 8; ++j) { g2[j] = 0.f; u2[j] = 0.f; } }
            float o[8];
#pragma unroll
            for (int j = 0; j < 8; ++j) { const float gg = bg[j] + g0[j] * wg[0][j] + g1[j] * wg[1][j] + g2[j] * wg[2][j]; const float uu = bu[j] + u0[j] * wu[0][j] + u1[j] * wu[1][j] + u2[j] * wu[2][j]; o[j] = gelu_tanh(gg) * uu; }
            *(u32x4*)(ACT + (size_t)m * DFF + c0) = (u32x4){pk2(o[0], o[1]), pk2(o[2], o[3]), pk2(o[4], o[5]), pk2(o[6], o[7])};
#pragma unroll
            for (int j = 0; j < 8; ++j) { g0[j] = g1[j]; g1[j] = g2[j]; u0[j] = u1[j]; u1[j] = u2[j]; }
        }
    }
}

constexpr size_t G_RL = WS_G + 320 * MiB;
static_assert(G_RL + 32 * MiB <= 480 * MiB, "ws");
__device__ __forceinline__ void ret_local(const Params& p, unsigned char* lds, int item) {
    unsigned char* ws = p.ws;
    int tid_ = threadIdx.x; asm volatile("" : "+v"(tid_));
    const int tid = tid_, lane = tid & 63, w = tid >> 6, l15 = lane & 15, quad = lane >> 4;
    const int eq = item & 3, idx = (item >> 2) % 6, bh = (item >> 2) / 6, bl = bh >> 2, h = bh & 3;
    const int dirb = idx >= 3, m = dirb ? idx - 2 : idx;
    const float lg2 = log2f(1.f - exp2f(-5.f - (float)h));
    bf16_t* KT = (bf16_t*)lds;
    bf16_t* VTx = (bf16_t*)(lds + 20480);
    const bf16_t* Kg = (const bf16_t*)(ws + G_K) + ((size_t)(bl * SEQ + m * 512)) * DM + h * 256;
    const bf16_t* VT = (const bf16_t*)(ws + G_VT) + ((size_t)(h * 512 + eq * 128)) * TG + bl * SEQ + m * 512;
    const int kj = tid & 31, kc8 = (tid >> 5) * 8;
    const int ve = tid >> 2, vj8 = (tid & 3) * 8;
    f32x4 af[2][8];
#pragma unroll
    for (int i = 0; i < 2; ++i)
#pragma unroll
        for (int j = 0; j < 8; ++j) af[i][j] = (f32x4){0.f, 0.f, 0.f, 0.f};
    u32x4 kr0[2], kr1[2], kr2[2], kr3[2], vr0, vr1, vr2, vr3;
#define RL_LOAD(s, KR, VR) do { const int s_ = (s) < 16 ? (s) : 15; \
        _Pragma("unroll") for (int i = 0; i < 2; ++i) KR[i] = *(const u32x4*)(Kg + (size_t)(32 * s_ + kj) * DM + kc8 + 128 * i); \
        VR = *(const u32x4*)(VT + (size_t)ve * TG + 32 * s_ + vj8); } while (0)
    RL_LOAD(0, kr0, vr0); RL_LOAD(1, kr1, vr1); RL_LOAD(2, kr2, vr2);
    const int et0 = 2 * (w & 3), dt0 = 8 * (w >> 2);
    __syncthreads();
#define RL_STEP(s, KR, VR, KN, VN) do { \
        _Pragma("unroll") for (int i = 0; i < 2; ++i) { const int j = kj, c0 = kc8 + 128 * i; const unsigned wv[4] = {KR[i].x, KR[i].y, KR[i].z, KR[i].w}; \
            _Pragma("unroll") for (int q = 0; q < 4; ++q) { KT[(c0 + 2 * q) * 40 + j] = (bf16_t)(wv[q] & 0xffffu); KT[(c0 + 2 * q + 1) * 40 + j] = (bf16_t)(wv[q] >> 16); } } \
        { const unsigned wv[4] = {VR.x, VR.y, VR.z, VR.w}; unsigned ov[4]; \
          _Pragma("unroll") for (int q = 0; q < 4; ++q) { const int jj = 32 * (s) + vj8 + 2 * q; const float v0 = bflo(wv[q]), v1 = bfhi(wv[q]); \
              const float e0 = dirb ? (float)jj : (float)(511 - jj), e1 = dirb ? (float)(jj + 1) : (float)(510 - jj); \
              ov[q] = cvtpk(v0 * __builtin_amdgcn_exp2f(lg2 * e0), v1 * __builtin_amdgcn_exp2f(lg2 * e1)); } \
          *(u32x4*)(VTx + ve * 40 + vj8) = (u32x4){ov[0], ov[1], ov[2], ov[3]}; } \
        __syncthreads(); \
        RL_LOAD((s) + 3, KN, VN); \
        bf16x8 a0[2]; \
        _Pragma("unroll") for (int i = 0; i < 2; ++i) a0[i] = *(const bf16x8*)(VTx + (16 * (et0 + i) + l15) * 40 + quad * 8); \
        _Pragma("unroll") for (int j = 0; j < 8; ++j) { const bf16x8 b = *(const bf16x8*)(KT + (16 * (dt0 + j) + l15) * 40 + quad * 8); \
            _Pragma("unroll") for (int i = 0; i < 2; ++i) af[i][j] = mfma16(b, a0[i], af[i][j]); }       \
        __syncthreads(); } while (0)
    for (int s = 0; s < 16; s += 4) { RL_STEP(s, kr0, vr0, kr3, vr3); RL_STEP(s + 1, kr1, vr1, kr0, vr0); RL_STEP(s + 2, kr2, vr2, kr1, vr1); RL_STEP(s + 3, kr3, vr3, kr2, vr2); }
#undef RL_LOAD
#undef RL_STEP
    bf16_t* L = (bf16_t*)(ws + G_RL) + ((size_t)((bh * 4 + m) * 2 + dirb) * 512 + eq * 128) * 256;
#pragma unroll
    for (int i = 0; i < 2; ++i)
#pragma unroll
        for (int j = 0; j < 8; ++j)
            *(u32x2*)(L + (size_t)(16 * (et0 + i) + l15) * 256 + 16 * (dt0 + j) + 4 * quad) = (u32x2){cvtpk(af[i][j][0], af[i][j][1]), cvtpk(af[i][j][2], af[i][j][3])};
}

__device__ __forceinline__ void ret_item(const Params& p, unsigned char* lds, int item) {
    unsigned char* ws = p.ws;
    int tid_ = threadIdx.x; asm volatile("" : "+v"(tid_));
    const int tid = tid_, lane = tid & 63, w = tid >> 6, l15 = lane & 15, quad = lane >> 4;
    const int bh = item >> 5, bl = bh >> 2, h = bh & 3, qt = item & 31, cq = qt >> 3, kt0 = 8 * cq;
    const float lg2 = log2f(1.f - exp2f(-5.f - (float)h));
    bf16_t* Ks = (bf16_t*)lds;
    bf16_t* Ps = (bf16_t*)(lds + 67584);
    float* red = (float*)(lds + 86016);
    float* rstd = (float*)(lds + 88064);
    const bf16_t* Q = (const bf16_t*)(ws + G_Q) + ((size_t)(bl * SEQ + qt * 64)) * DM + h * 256;
    const bf16_t* Kg = (const bf16_t*)(ws + G_K) + ((size_t)(bl * SEQ)) * DM + h * 256;
    const bf16_t* VTw = (const bf16_t*)(ws + G_VT) + ((size_t)(h * 512 + 64 * w + l15)) * TG + bl * SEQ + quad * 16;
    const bf16_t* Lw = (const bf16_t*)(ws + G_RL) + ((size_t)(bh * 4) * 2 * 512 + 64 * w + l15) * 256 + quad * 16;
    const int ti = w >> 1, tj0 = (w & 1) * 2;
    bf16_t* Qs = (bf16_t*)(lds + 88320);
    const int kr = tid >> 5, kc = (tid & 31) * 8;
    const int prow = tid >> 3, pc8 = (tid & 7) * 8;
    const int pos = (qt & 7) * 64 + prow;
    u32x4 kreg[4], VA[8], VB[8], VC[8];
#define RET_LOADV(g, V) do { if ((g) < 8) { const bf16_t* s_ = VTw + (kt0 + (g)) * 64; \
            _Pragma("unroll") for (int j = 0; j < 4; ++j) _Pragma("unroll") for (int kk = 0; kk < 2; ++kk) V[j * 2 + kk] = *(const u32x4*)(s_ + (size_t)(16 * j) * TG + kk * 8); } \
        else if ((g) < 20) { const int st_ = (g) - 8, mi_ = st_ >> 2, m_ = mi_ + (mi_ >= cq ? 1 : 0), ds_ = st_ & 3; \
            const bf16_t* s_ = Lw + ((size_t)(m_ * 2 + (m_ < cq ? 0 : 1)) * 512) * 256 + ds_ * 64; \
            _Pragma("unroll") for (int j = 0; j < 4; ++j) _Pragma("unroll") for (int kk = 0; kk < 2; ++kk) V[j * 2 + kk] = *(const u32x4*)(s_ + (size_t)(16 * j) * 256 + kk * 8); } } while (0)
#define RET_PV(Pw, V) do { _Pragma("unroll") for (int kk = 0; kk < 2; ++kk) { bf16x8 a[4]; \
            _Pragma("unroll") for (int i = 0; i < 4; ++i) a[i] = *(const bf16x8*)((Pw) + (16 * i + l15) * 72 + quad * 16 + kk * 8); \
            _Pragma("unroll") for (int i = 0; i < 4; ++i) _Pragma("unroll") for (int j = 0; j < 4; ++j) o[i][j] = mfma16(__builtin_bit_cast(bf16x8, V[j * 2 + kk]), a[i], o[i][j]); } } while (0)
#define RET_TILE(g, VCU, VN) do { const int kt = kt0 + (g); const bf16_t* Kc = Ks + ((g) & 1) * (64 * 264); bf16_t* Pw = Ps + ((g) & 1) * (64 * 72); \
        f32x4 s0 = {0.f, 0.f, 0.f, 0.f}, s1 = {0.f, 0.f, 0.f, 0.f}; \
        _Pragma("unroll") for (int ks = 0; ks < 8; ++ks) { \
            const bf16x8 b0 = *(const bf16x8*)(Kc + (16 * tj0 + l15) * 264 + ks * 32 + quad * 8); \
            const bf16x8 b1 = *(const bf16x8*)(Kc + (16 * (tj0 + 1) + l15) * 264 + ks * 32 + quad * 8); \
            const bf16x8 qa = *(const bf16x8*)(Qs + (16 * ti + l15) * 264 + ks * 32 + quad * 8); \
            s0 = mfma16(qa, b0, s0); s1 = mfma16(qa, b1, s1); } \
        _Pragma("unroll") for (int r = 0; r < 4; ++r) { const int row = 16 * ti + 4 * quad + r, qpos = qt * 64 + row; \
            const int c0 = 16 * tj0 + l15, c1 = c0 + 16; \
            const float d0 = fabsf((float)(qpos - (kt * 64 + c0))), d1 = fabsf((float)(qpos - (kt * 64 + c1))); \
            Pw[row * 72 + c0] = (bf16_t)cvtpk(s0[r] * __builtin_amdgcn_exp2f(lg2 * d0), 0.f); \
            Pw[row * 72 + c1] = (bf16_t)cvtpk(s1[r] * __builtin_amdgcn_exp2f(lg2 * d1), 0.f); } \
        if ((g) + 1 < 8) { bf16_t* Kn = Ks + (((g) + 1) & 1) * (64 * 264); \
            _Pragma("unroll") for (int i = 0; i < 4; ++i) *(u32x4*)(Kn + (kr + 16 * i) * 264 + kc) = kreg[i]; } \
        __syncthreads(); \
        RET_LOADV((g) + 2, VN); \
        if ((g) + 2 < 8) { _Pragma("unroll") for (int i = 0; i < 4; ++i) kreg[i] = *(const u32x4*)(Kg + (size_t)((kt + 2) * 64 + kr + 16 * i) * DM + kc); } \
        RET_PV(Pw, VCU); } while (0)
#define RET_STATE(g, VCU, VN) do { bf16_t* Pw = Ps + ((g) & 1) * (64 * 72); \
        { const int mi = ((g) - 8) >> 2, m = mi + (mi >= cq ? 1 : 0); \
          const float ex = (m < cq) ? (float)(pos + 1 + (cq - 1 - m) * 512) : (float)(512 - pos + (m - cq - 1) * 512); \
          const float rs = __builtin_amdgcn_exp2f(lg2 * ex); const u32x4 qreg = *(const u32x4*)(Qs + prow * 264 + (((g) - 8) & 3) * 64 + pc8); \
          *(u32x4*)(Pw + prow * 72 + pc8) = (u32x4){cvtpk(bflo(qreg.x) * rs, bfhi(qreg.x) * rs), cvtpk(bflo(qreg.y) * rs, bfhi(qreg.y) * rs), cvtpk(bflo(qreg.z) * rs, bfhi(qreg.z) * rs), cvtpk(bflo(qreg.w) * rs, bfhi(qreg.w) * rs)}; } \
        __syncthreads(); \
        RET_LOADV((g) + 2, VN); \
        RET_PV(Pw, VCU); } while (0)
    __syncthreads();
#pragma unroll
    for (int i = 0; i < 4; ++i) { *(u32x4*)(Ks + (kr + 16 * i) * 264 + kc) = *(const u32x4*)(Kg + (size_t)(kt0 * 64 + kr + 16 * i) * DM + kc);
        *(u32x4*)(Qs + (kr + 16 * i) * 264 + kc) = *(const u32x4*)(Q + (size_t)(kr + 16 * i) * DM + kc); }
    RET_LOADV(0, VA); RET_LOADV(1, VB);
#pragma unroll
    for (int i = 0; i < 4; ++i) kreg[i] = *(const u32x4*)(Kg + (size_t)((kt0 + 1) * 64 + kr + 16 * i) * DM + kc);
    f32x4 o[4][4];
#pragma unroll
    for (int i = 0; i < 4; ++i)
#pragma unroll
        for (int j = 0; j < 4; ++j) o[i][j] = (f32x4){0.f, 0.f, 0.f, 0.f};
    __syncthreads();
#define RET_STEP(g, VCUR, VNXT) do { if ((g) < 8) RET_TILE(g, VCUR, VNXT); else if ((g) < 20) RET_STATE(g, VCUR, VNXT); } while (0)
    for (int g = 0; g < 21; g += 3) { RET_STEP(g, VA, VC); RET_STEP(g + 1, VB, VA); RET_STEP(g + 2, VC, VB); }
#undef RET_STEP
#undef RET_LOADV
#undef RET_PV
#undef RET_TILE
#undef RET_STATE
#pragma unroll
    for (int i = 0; i < 4; ++i) { float s = 0.f;
#pragma unroll
        for (int j = 0; j < 4; ++j)
#pragma unroll
            for (int r = 0; r < 4; ++r) s += o[i][j][r] * o[i][j][r];
        s += shx(s, 16, lane); s += shx(s, 32, lane);
        if (quad == 0) red[w * 64 + 16 * i + l15] = s; }
    __syncthreads();
    if (tid < 64) { float s = 0.f;
#pragma unroll
        for (int ww = 0; ww < 8; ++ww) s += red[ww * 64 + tid];
        rstd[tid] = rsqrtf(s * (1.f / 512.f) + EPS); }
    __syncthreads();
    bf16_t* RO = (bf16_t*)(ws + G_SGR) + ((size_t)(bl * SEQ + qt * 64)) * 2048 + h * 512 + 64 * w + 4 * quad;
    u32x2 gv[4][4];
#pragma unroll
    for (int i = 0; i < 4; ++i)
#pragma unroll
        for (int j = 0; j < 4; ++j) gv[i][j] = *(const u32x2*)(RO + (size_t)(16 * i + l15) * 2048 + 16 * j);
#pragma unroll
    for (int i = 0; i < 4; ++i) { const float rs = rstd[16 * i + l15];
#pragma unroll
        for (int j = 0; j < 4; ++j) { const f32x4 v = o[i][j] * rs;
            *(u32x2*)(RO + (size_t)(16 * i + l15) * 2048 + 16 * j) = (u32x2){cvtpk(v[0] * bflo(gv[i][j].x), v[1] * bfhi(gv[i][j].x)), cvtpk(v[2] * bflo(gv[i][j].y), v[3] * bfhi(gv[i][j].y))}; } }
}

struct HgRaw { unsigned q[8], l[8]; u32x4 v0, v1; };
__device__ __forceinline__ void hgrn_load(HgRaw& R, const bf16_t* HQ, const bf16_t* LF, const bf16_t* HI, int c, int dir, int d2, int tg, int vt, int veg) {
#pragma unroll
    for (int i = 0; i < 8; ++i) { const int tau = 32 * c + 8 * tg + i, s = dir ? (SEQ - 1 - tau) : tau; R.q[i] = *(const unsigned*)(HQ + (size_t)s * DM + 2 * d2); R.l[i] = *(const unsigned*)(LF + (size_t)s * DM + 2 * d2); }
    { const int tau = 32 * c + vt, s = dir ? (SEQ - 1 - tau) : tau; R.v0 = *(const u32x4*)(HI + (size_t)s * DM + veg * 16); R.v1 = *(const u32x4*)(HI + (size_t)s * DM + veg * 16 + 8); }
}
__device__ __forceinline__ void hgrn_prep(const HgRaw& R, bf16_t* Qe, bf16_t* Ke, bf16_t* KdT, float* decs, bf16_t* VTs, int d2, int tg, int vt, int veg, int lane) {
    float b0[8], b1[8], l0[8], l1[8]; float run0 = 0.f, run1 = 0.f;
#pragma unroll
    for (int i = 0; i < 8; ++i) { l0[i] = bflo(R.l[i]); l1[i] = bfhi(R.l[i]); run0 += l0[i]; run1 += l1[i]; b0[i] = run0; b1[i] = run1; }
    float pre0, pre1, bl0, bl1;
    { const float r1 = shx(run0, 1, lane), s2 = run0 + r1, s2x = shx(s2, 2, lane); bl0 = s2 + s2x; pre0 = ((tg & 1) ? r1 : 0.f) + ((tg & 2) ? s2x : 0.f); }
    { const float r1 = shx(run1, 1, lane), s2 = run1 + r1, s2x = shx(s2, 2, lane); bl1 = s2 + s2x; pre1 = ((tg & 1) ? r1 : 0.f) + ((tg & 2) ? s2x : 0.f); }
    const float c30 = __builtin_amdgcn_exp2f(bl0), c31 = __builtin_amdgcn_exp2f(bl1);
    float kd0[8], kd1[8];
#pragma unroll
    for (int i = 0; i < 8; ++i) { const int t = 8 * tg + i;
        const float bb0 = b0[i] + pre0, bb1 = b1[i] + pre1;
        const float k0 = 1.f - __builtin_amdgcn_exp2f(l0[i]), k1 = 1.f - __builtin_amdgcn_exp2f(l1[i]);
        const float ke0 = k0 * __builtin_amdgcn_exp2f(fminf(-bb0, 115.f)), ke1 = k1 * __builtin_amdgcn_exp2f(fminf(-bb1, 115.f));
        *(unsigned*)(Qe + t * 136 + 2 * d2) = cvtpk(bflo(R.q[i]) * __builtin_amdgcn_exp2f(bb0), bfhi(R.q[i]) * __builtin_amdgcn_exp2f(bb1));
        *(unsigned*)(Ke + t * 136 + 2 * d2) = cvtpk(ke0, ke1);
        kd0[i] = ke0 * c30; kd1[i] = ke1 * c31;
        if (__builtin_expect(!(bl0 > -86.f && bl1 > -86.f), 0)) { kd0[i] = k0 * __builtin_amdgcn_exp2f(bl0 - bb0); kd1[i] = k1 * __builtin_amdgcn_exp2f(bl1 - bb1); } }
    *(u32x4*)(KdT + (2 * d2) * 40 + 8 * tg) = (u32x4){cvtpk(kd0[0], kd0[1]), cvtpk(kd0[2], kd0[3]), cvtpk(kd0[4], kd0[5]), cvtpk(kd0[6], kd0[7])};
    *(u32x4*)(KdT + (2 * d2 + 1) * 40 + 8 * tg) = (u32x4){cvtpk(kd1[0], kd1[1]), cvtpk(kd1[2], kd1[3]), cvtpk(kd1[4], kd1[5]), cvtpk(kd1[6], kd1[7])};
    if (tg == 0) { decs[2 * d2] = c30; decs[2 * d2 + 1] = c31; }
    { const unsigned wv[8] = {R.v0.x, R.v0.y, R.v0.z, R.v0.w, R.v1.x, R.v1.y, R.v1.z, R.v1.w};
#pragma unroll
      for (int q = 0; q < 8; ++q) { VTs[(16 * veg + 2 * q) * 40 + vt] = (bf16_t)(wv[q] & 0xffffu); VTs[(16 * veg + 2 * q + 1) * 40 + vt] = (bf16_t)(wv[q] >> 16); } }
}
__device__ __forceinline__ void hgrn_item(const Params& p, unsigned char* lds, int item) {
    unsigned char* ws = p.ws;
    int tid_ = threadIdx.x; asm volatile("" : "+v"(tid_));
    const int tid = tid_, lane = tid & 63, w = tid >> 6, l15 = lane & 15, quad = lane >> 4;
    const int dir = item & 1, h = (item >> 1) & 7, bl = item >> 4;
    bf16_t* Qe2 = (bf16_t*)lds;
    bf16_t* Ke2 = (bf16_t*)(lds + 17408);
    bf16_t* KdT2 = (bf16_t*)(lds + 34816);
    bf16_t* VTs2 = (bf16_t*)(lds + 55296);
    float* decs2 = (float*)(lds + 75776);
    bf16_t* Ps = (bf16_t*)(lds + 76800);
    bf16_t* StT = (bf16_t*)(lds + 79360);
    const bf16_t* HQ = (const bf16_t*)(ws + G_HQ) + (size_t)bl * SEQ * DM + h * 128;
    const bf16_t* LF = (const bf16_t*)(ws + (dir ? G_LFB : G_LFF)) + (size_t)bl * SEQ * DM + h * 128;
    const bf16_t* HI = (const bf16_t*)(ws + G_HI) + (size_t)bl * SEQ * DM + h * 128;
    bf16_t* HO = (bf16_t*)(ws + (dir ? G_HOB : G_HOF)) + (size_t)bl * SEQ * DM + h * 128;
    __syncthreads();
    for (int i = tid; i < 128 * 136 / 2; i += NTHREADS) ((unsigned*)StT)[i] = 0u;
    if (w < 4) {
        const int d2 = tid >> 2, tg = tid & 3, vt = tid & 31, veg = tid >> 5;
        HgRaw RA, RB;
        hgrn_load(RA, HQ, LF, HI, 0, dir, d2, tg, vt, veg);
        hgrn_load(RB, HQ, LF, HI, 1, dir, d2, tg, vt, veg);
        hgrn_prep(RA, Qe2, Ke2, KdT2, decs2, VTs2, d2, tg, vt, veg, lane);
        __syncthreads();
#define HG_PROD(c, RP, RL) do { \
            if ((c) + 2 < 64) hgrn_load(RL, HQ, LF, HI, (c) + 2, dir, d2, tg, vt, veg); \
            if ((c) + 1 < 64) { const int pb = ((c) + 1) & 1; \
                hgrn_prep(RP, Qe2 + pb * (32 * 136), Ke2 + pb * (32 * 136), KdT2 + pb * (128 * 40), decs2 + pb * 128, VTs2 + pb * (128 * 40), d2, tg, vt, veg, lane); } \
            __syncthreads(); __syncthreads(); } while (0)
        for (int c = 0; c < 64; c += 2) { HG_PROD(c, RB, RA); HG_PROD(c + 1, RA, RB); }
#undef HG_PROD
    } else {
        const int cw = w - 4;
        const int oti = cw >> 1, otj = cw & 1;
        f32x4 st[2][8];
#pragma unroll
        for (int dj = 0; dj < 2; ++dj)
#pragma unroll
            for (int j = 0; j < 8; ++j) st[dj][j] = (f32x4){0.f, 0.f, 0.f, 0.f};
        __syncthreads();
        for (int c = 0; c < 64; ++c) {
            const int pb = c & 1;
            const bf16_t* Qe = Qe2 + pb * (32 * 136); const bf16_t* Ke = Ke2 + pb * (32 * 136); const bf16_t* KdT = KdT2 + pb * (128 * 40);
            const bf16_t* VTs = VTs2 + pb * (128 * 40); const float* decs = decs2 + pb * 128;
            f32x4 ao[2][2];
#pragma unroll
            for (int ej = 0; ej < 2; ++ej)
#pragma unroll
                for (int ti = 0; ti < 2; ++ti) ao[ej][ti] = (f32x4){0.f, 0.f, 0.f, 0.f};
#pragma unroll
            for (int ks = 0; ks < 4; ++ks) { bf16x8 sf[2], qf2[2];
#pragma unroll
                for (int ej = 0; ej < 2; ++ej) sf[ej] = *(const bf16x8*)(StT + (16 * (2 * cw + ej) + l15) * 136 + ks * 32 + quad * 8);
#pragma unroll
                for (int ti = 0; ti < 2; ++ti) qf2[ti] = *(const bf16x8*)(Qe + (16 * ti + l15) * 136 + ks * 32 + quad * 8);
#pragma unroll
                for (int ej = 0; ej < 2; ++ej)
#pragma unroll
                    for (int ti = 0; ti < 2; ++ti) ao[ej][ti] = mfma16(sf[ej], qf2[ti], ao[ej][ti]); }
            { f32x4 acc = {0.f, 0.f, 0.f, 0.f};
#pragma unroll
              for (int ks = 0; ks < 4; ++ks) { const bf16x8 a = *(const bf16x8*)(Qe + (16 * oti + l15) * 136 + ks * 32 + quad * 8); const bf16x8 bb = *(const bf16x8*)(Ke + (16 * otj + l15) * 136 + ks * 32 + quad * 8); acc = mfma16(bb, a, acc); }
              const int t = 16 * oti + l15, s0 = 16 * otj + 4 * quad;
              *(u32x2*)(Ps + t * 40 + s0) = (u32x2){cvtpk(s0 <= t ? acc[0] : 0.f, s0 + 1 <= t ? acc[1] : 0.f), cvtpk(s0 + 2 <= t ? acc[2] : 0.f, s0 + 3 <= t ? acc[3] : 0.f)}; }
            { bf16x8 kf[2]; f32x4 dc[2];
#pragma unroll
              for (int dj = 0; dj < 2; ++dj) { kf[dj] = *(const bf16x8*)(KdT + (16 * (2 * cw + dj) + l15) * 40 + quad * 8); dc[dj] = *(const f32x4*)(decs + 16 * (2 * cw + dj) + 4 * quad); }
#pragma unroll
              for (int j = 0; j < 8; ++j) { const bf16x8 vf = *(const bf16x8*)(VTs + (16 * j + l15) * 40 + quad * 8);
#pragma unroll
                  for (int dj = 0; dj < 2; ++dj) st[dj][j] = mfma16(kf[dj], vf, st[dj][j] * dc[dj]); } }
            __syncthreads();
            { bf16x8 pf[2];
#pragma unroll
              for (int ti = 0; ti < 2; ++ti) pf[ti] = *(const bf16x8*)(Ps + (16 * ti + l15) * 40 + quad * 8);
#pragma unroll
              for (int ej = 0; ej < 2; ++ej) { const bf16x8 vf = *(const bf16x8*)(VTs + (16 * (2 * cw + ej) + l15) * 40 + quad * 8);
#pragma unroll
                  for (int ti = 0; ti < 2; ++ti) { ao[ej][ti] = mfma16(vf, pf[ti], ao[ej][ti]);
                      const int tau = 32 * c + 16 * ti + l15, s = dir ? (SEQ - 1 - tau) : tau;
                      *(u32x2*)(HO + (size_t)s * DM + 16 * (2 * cw + ej) + 4 * quad) = (u32x2){cvtpk(ao[ej][ti][0], ao[ej][ti][1]), cvtpk(ao[ej][ti][2], ao[ej][ti][3])}; } } }
#pragma unroll
            for (int dj = 0; dj < 2; ++dj)
#pragma unroll
                for (int j = 0; j < 8; ++j)
                    *(u32x2*)(StT + (16 * j + l15) * 136 + 16 * (2 * cw + dj) + 4 * quad) = (u32x2){cvtpk(st[dj][j][0], st[dj][j][1]), cvtpk(st[dj][j][2], st[dj][j][3])};
            __syncthreads();
        }
    }
}

__device__ __forceinline__ void seq_combine(const bf16_t* OZ, const bf16_t* PQT, bf16_t* YF) {
    constexpr int LD = NB * 1024;
    const int tid = otid(), gt = obid() * NTHREADS + tid, NT = ogrid() * NTHREADS;
    for (int it = gt; it < 1024 * LD / 8; it += NT) { const int sp = it / (LD / 8), n0 = (it % (LD / 8)) * 8, bl = n0 >> 10, gc = n0 & 1023;
        float av[8], bv[8]; ld8(OZ + (size_t)sp * LD + n0, av); ld8(OZ + (size_t)(1024 + sp) * LD + n0, bv);
        const f32x4 a0 = {av[0], av[1], av[2], av[3]}, a1 = {av[4], av[5], av[6], av[7]}, b0 = {bv[0], bv[1], bv[2], bv[3]}, b1 = {bv[4], bv[5], bv[6], bv[7]};
        *(u32x4*)(YF + ((size_t)(bl * SEQ + sp)) * DM + gc) = (u32x4){pk2(a0[0] + b0[0], a0[1] + b0[1]), pk2(a0[2] + b0[2], a0[3] + b0[3]), pk2(a1[0] + b1[0], a1[1] + b1[1]), pk2(a1[2] + b1[2], a1[3] + b1[3])};
        if (sp > 0) *(u32x4*)(YF + ((size_t)(bl * SEQ + SEQ - sp)) * DM + gc) = (u32x4){pk2(a0[0] - b0[0], a0[1] - b0[1]), pk2(a0[2] - b0[2], a0[3] - b0[3]), pk2(a1[0] - b1[0], a1[1] - b1[1]), pk2(a1[2] - b1[2], a1[3] - b1[3])}; }
    const int lane = tid & 63, gw = obid() * 8 + (tid >> 6), NGW = ogrid() * 8;
    for (int n = gw; n < LD; n += NGW) { const bf16_t* pr = PQT + (size_t)n * 4096 + lane * 32; float s = 0.f;
#pragma unroll
        for (int q = 0; q < 4; ++q) { float v[8]; ld8(pr + 8 * q, v); s += (v[0] - v[1]) + (v[2] - v[3]) + (v[4] - v[5]) + (v[6] - v[7]); }
        s = wave_sum(s, lane);
        if (lane == 0) YF[((size_t)((n >> 10) * SEQ + 1024)) * DM + (n & 1023)] = (bf16_t)f2bf(s * 0.02209708691207961f); }
}

__device__ __forceinline__ void mix_combine(const bf16_t* F1, const bf16_t* F2, bf16_t* MIX, int rank, int nblk) {
    const int gt = rank * NTHREADS + otid(), NT = nblk * NTHREADS;
    constexpr int NIT = TG * DM / 8;
    for (int it = gt; it < NIT; it += 4 * NT) { u32x4 a[4], b[4];
#pragma unroll
        for (int u = 0; u < 4; ++u) { const int i2 = it + u * NT; if (i2 < NIT) { a[u] = *(const u32x4*)(F1 + (size_t)i2 * 8); b[u] = *(const u32x4*)(F2 + (size_t)i2 * 8); } }
#pragma unroll
        for (int u = 0; u < 4; ++u) { const int i2 = it + u * NT; if (i2 < NIT)
            *(u32x4*)(MIX + (size_t)i2 * 8) = (u32x4){pk2(bflo(a[u].x) + bflo(b[u].x), bfhi(a[u].x) + bfhi(b[u].x)), pk2(bflo(a[u].y) + bflo(b[u].y), bfhi(a[u].y) + bfhi(b[u].y)),
                                                      pk2(bflo(a[u].z) + bflo(b[u].z), bfhi(a[u].z) + bfhi(b[u].z)), pk2(bflo(a[u].w) + bflo(b[u].w), bfhi(a[u].w) + bfhi(b[u].w))}; }
    }
}

__device__ __forceinline__ void hgrn_combine(const Params& p, int l) {
    unsigned char* ws = p.ws;
    const int tid = otid(), lane = tid & 63, gw = obid() * 8 + (tid >> 6), NGW = ogrid() * 8;
    const bf16_t* HOF = (const bf16_t*)(ws + G_HOF); const bf16_t* HOB = (const bf16_t*)(ws + G_HOB); bf16_t* SG = (bf16_t*)(ws + G_SGH);
    const float* nw = p.hgrn_norm_w + (size_t)l * 128;
    float nwv[2][8];
#pragma unroll
    for (int i = 0; i < 2; ++i)
#pragma unroll
        for (int j = 0; j < 8; ++j) nwv[i][j] = nw[(((lane + 64 * i) * 8) & 127) + j];
    for (int m0 = gw; m0 < TG; m0 += 2 * NGW) {
        u32x4 av[2][2], bv[2][2], gv[2][2];
#pragma unroll
        for (int r = 0; r < 2; ++r) { const int m = m0 + r * NGW;
#pragma unroll
            for (int i = 0; i < 2; ++i) { const size_t o = (size_t)m * DM + (lane + 64 * i) * 8;
                if (m < TG) { av[r][i] = *(const u32x4*)(HOF + o); bv[r][i] = *(const u32x4*)(HOB + o); gv[r][i] = *(const u32x4*)(SG + o); } } }
#pragma unroll
        for (int r = 0; r < 2; ++r) { const int m = m0 + r * NGW;
            if (m < TG) {
#pragma unroll
                for (int i = 0; i < 2; ++i) { const size_t o = (size_t)m * DM + (lane + 64 * i) * 8;
                    const unsigned aw[4] = {av[r][i].x, av[r][i].y, av[r][i].z, av[r][i].w}, bw[4] = {bv[r][i].x, bv[r][i].y, bv[r][i].z, bv[r][i].w}, gw4[4] = {gv[r][i].x, gv[r][i].y, gv[r][i].z, gv[r][i].w};
                    float a[8]; float ss = 0.f;
#pragma unroll
                    for (int q = 0; q < 4; ++q) { a[2 * q] = bflo(aw[q]) + bflo(bw[q]); a[2 * q + 1] = bfhi(aw[q]) + bfhi(bw[q]); ss += a[2 * q] * a[2 * q] + a[2 * q + 1] * a[2 * q + 1]; }
                    ss += shx(ss, 1, lane); ss += shx(ss, 2, lane); ss += shx(ss, 4, lane); ss += shx(ss, 8, lane);
                    const float rr = rsqrtf(ss * (1.f / 128.f) + EPS); unsigned ow[4];
#pragma unroll
                    for (int q = 0; q < 4; ++q) ow[q] = pk2(a[2 * q] * rr * nwv[i][2 * q] * bflo(gw4[q]), a[2 * q + 1] * rr * nwv[i][2 * q + 1] * bfhi(gw4[q]));
                    *(u32x4*)(SG + o) = (u32x4){ow[0], ow[1], ow[2], ow[3]}; } } }
    }
}

#define XB_TMO      128
#define XB_XCNT(j)  (256  + 64 * (j))
#define XB_XSUB(j)  (1280 + 64 * (j))
#define XB_XGEN(j)  (2304 + 64 * (j))
#define XB_TOP      3328
#define XB_TOPGEN   3392
#define XCD_BAR_WORDS 3456
#define XB_SPIN_CAP (1u << 22)
__device__ __forceinline__ unsigned xb_ld(unsigned* p)              { return __hip_atomic_load(p, __ATOMIC_RELAXED, __HIP_MEMORY_SCOPE_AGENT); }
__device__ __forceinline__ unsigned xb_add(unsigned* p, unsigned v) { return __hip_atomic_fetch_add(p, v, __ATOMIC_RELAXED, __HIP_MEMORY_SCOPE_AGENT); }
__device__ __forceinline__ unsigned xb_xcc_id() { return (unsigned)__builtin_amdgcn_s_getreg((3 << 11) | 20) & 0xFu; }
#define XB_SPIN(cond, bar) do { unsigned _sp = 0; while (cond) { __builtin_amdgcn_s_sleep(1); \
    if ((++_sp & 255u) == 0u) { if (xb_ld(&(bar)[XB_TMO])) break; if (_sp > XB_SPIN_CAP) { atomicAdd(&(bar)[XB_TMO], 1u); break; } } } } while (0)
__device__ __forceinline__ void xcd_barrier_complete(unsigned* bar, unsigned x, unsigned G, unsigned& nloc, unsigned& nx) {
    unsigned sum, cnt, mine, sp = 0u;
    for (;;) {
        sum = 0u; cnt = 0u; mine = 0u;
#pragma unroll
        for (unsigned j = 0; j < 16; ++j) { const unsigned c = xb_ld(&bar[XB_XCNT(j)]); sum += c; cnt += (c > 0u) ? 1u : 0u; mine = (j == x) ? c : mine; }
        if (sum == G) break;
        __builtin_amdgcn_s_sleep(1);
        if ((++sp & 255u) == 0u) { if (xb_ld(&bar[XB_TMO])) break; if (sp > XB_SPIN_CAP) { atomicAdd(&bar[XB_TMO], 1u); break; } }
    }
    nloc = mine > 0u ? mine : 1u; nx = cnt > 0u ? cnt : 1u;
}
__device__ __forceinline__ void xcd_barrier(unsigned* bar, volatile LAS unsigned* st, unsigned nparts) {
    asm volatile("s_waitcnt vmcnt(0)" ::: "memory");
    __syncthreads();
    if (threadIdx.x == 0) {
        const unsigned x = xb_xcc_id();
        __builtin_amdgcn_s_waitcnt(0);
        unsigned nloc = st[0], nx = st[1];
        if (nloc == 0u) { xcd_barrier_complete(bar, x, nparts, nloc, nx); st[0] = nloc; st[1] = nx; }
        const unsigned old = xb_add(&bar[XB_XSUB(x)], 1u);
        const unsigned gen = old / nloc;
        if (old + 1u == (gen + 1u) * nloc) {
            __builtin_amdgcn_fence(__ATOMIC_RELEASE, "agent");
            asm volatile("s_waitcnt vmcnt(0)" ::: "memory");
            const unsigned og = xb_add(&bar[XB_TOP], 1u);
            const unsigned tg = og / nx;
            if (og + 1u == (tg + 1u) * nx) xb_add(&bar[XB_TOPGEN], 1u);
            else XB_SPIN(xb_ld(&bar[XB_TOPGEN]) == tg, bar);
            __builtin_amdgcn_fence(__ATOMIC_ACQUIRE, "agent");
            xb_add(&bar[XB_XGEN(x)], 1u);
            asm volatile("s_waitcnt vmcnt(0)" ::: "memory");
        } else {
            XB_SPIN(xb_ld(&bar[XB_XGEN(x)]) == gen, bar);
            __builtin_amdgcn_fence(__ATOMIC_ACQUIRE, "agent");
            asm volatile("s_waitcnt vmcnt(0)" ::: "memory");
        }
    }
    __syncthreads();
}

typedef const Params __attribute__((address_space(4)))* KParams;
__global__ void __launch_bounds__(NTHREADS, 2) fwd_kernel(Params pk) {
    extern __shared__ __attribute__((aligned(16))) unsigned char lds_raw[];
    LAS unsigned char* lds = (LAS unsigned char*)lds_raw;
    cg::grid_group grid = cg::this_grid();
    volatile LAS unsigned* bst = (volatile LAS unsigned*)(lds + LDS_BYTES - 16);
    unsigned* gbar = (unsigned*)(pk.ws + WS_BAR);
    volatile LAS unsigned* bst2 = (volatile LAS unsigned*)(lds + LDS_BYTES - 32);
    constexpr int NHG = NB * 8 * 2;
    const bool coop = (pk.ph_hi - pk.ph_lo > 1);
    if (coop) {
        if (threadIdx.x == 0) { bst[0] = 0u; bst[1] = 0u; bst2[0] = 0u; bst2[1] = 0u; (void)xb_add(&gbar[XB_XCNT(xb_xcc_id())], 1u);
            if ((int)blockIdx.x >= NHG) (void)xb_add(&gbar[4096 + XB_XCNT(xb_xcc_id())], 1u); }
        __syncthreads();
    }
    const int lo = pk.ph_lo, hi = pk.ph_hi;
    int ph = 0;
#define PH_BEGIN if (ph >= lo && ph < hi) { KParams kp = (KParams)__builtin_amdgcn_kernarg_segment_ptr(); asm volatile("" : "+s"(kp)); Params p; __builtin_memcpy(&p, (const void __attribute__((address_space(4)))*)kp, sizeof(Params)); \
        unsigned char* ws = p.ws; const int G = ogrid(), cb = obid(); const float* xsrc = (l == 0) ? p.x : p.out; const float* nw = p.norm_w + (size_t)l * 4 * DM;
#define PH_END   if (ph + 1 < hi) { if (lo < 0) grid.sync(); else xcd_barrier((unsigned*)(ws + WS_BAR), bst, gridDim.x); } } ++ph;

    for (int l = 0; l < DEPTH; ++l) {
        if (l == 0) {
        PH_BEGIN
            prep_tables(p); rms_rows(p.x, nw, (bf16_t*)(ws + WS_MIXIN), TA);
            prep_weights(p, 0, lds);
        PH_END
        }
        for (int g = 0; g < NGRP; ++g) {
            const int tok0 = g * TG;
            PH_BEGIN
                const bf16_t* XN = (const bf16_t*)(ws + WS_MIXIN) + (size_t)tok0 * DM;
                if (g > 0 && cb >= (G >> 1)) mix_combine((const bf16_t*)(ws + G_F1), (const bf16_t*)(ws + G_F2), (bf16_t*)(ws + WS_MIXIN) + (size_t)(tok0 - TG) * DM, cb - (G >> 1), G - (G >> 1));
                __syncthreads();
                { pg8::Gemm gm{XN, (const bf16_t*)(ws + WS_WIN), DM, DM, DM}; pg8::SchedInProj S; S.init(G, cb);
                  pg8::EpiInProj E{ws, (const float*)(ws + WS_ROPE), (const float*)(ws + WS_LB), tok0};
                  pg8::gemm_phase<pg8::EpiInProj, pg8::SchedInProj>(lds, gm, S, E); }
                __syncthreads();
                { pg8::Gemm gm{(const bf16_t*)(ws + WS_WIN) + (size_t)2048 * DM, XN, DM, DM, DM}; pg8::SchedPlain S; S.init(2048, TG, DM, DM, G, cb);
                  pg8::EpiBf16<TG> E{(bf16_t*)(ws + G_VT)};
                  pg8::gemm_phase<pg8::EpiBf16<TG>, pg8::SchedPlain>(lds, gm, S, E); }
            PH_END
            PH_BEGIN
                const bool split = coop && G > 2 * NHG;
                int chG = G, chC = cb, chBase = 0, chLim = 4 * 2 * (TG / 256); bool chDo = true;
                const bool xaware = split && G == 256 && NB == 4;
                if (split && cb < NHG) { hgrn_item(p, lds_raw, cb);
                    if (xaware) { chG = NHG; chC = cb; chBase = 0; chLim = 2 * NHG; }
                    else chDo = false; }
                else {
                    const int Gs = split ? G - NHG : G, cs = split ? cb - NHG : cb;
                    if (!split) for (int it = cb; it < NB * 8 * 2; it += G) hgrn_item(p, lds_raw, it);
                    for (int it = cs; it < NB * 4 * 6 * 4; it += Gs) ret_local(p, lds_raw, it);
                    if (split) xcd_barrier((unsigned*)(ws + WS_BAR) + 4096, bst2, (unsigned)Gs);
                    else if (coop) xcd_barrier((unsigned*)(ws + WS_BAR), bst, gridDim.x);
                    constexpr int NRI = NB * 4 * 32;
                    if (xaware) {
                        const int x = cb & 7, j = cs >> 3;
                        for (int idx = j; idx < 64; idx += 24) ret_item(p, lds_raw, (2 * x) * 32 + idx);
                        chDo = j >= 16; chG = 64; chC = (j - 16) * 8 + x; chBase = 2 * NHG; chLim = 4 * NHG;
                    } else {
                        for (int it = cs; it < NRI; it += Gs) ret_item(p, lds_raw, it);
                        const int nfull = split ? NRI % Gs : 0;
                        chDo = cs >= nfull; chG = Gs - nfull; chC = cs - nfull;
                    }
                }
                __syncthreads();
                if (chDo) { pg8::Gemm gm{(const bf16_t*)(ws + WS_CDFT), (const bf16_t*)(ws + G_FU), 256, DM, 256}; pg8::SchedChan S; S.init(chG, chC, chBase, chLim);
                  pg8::EpiChan E{(bf16_t*)(ws + G_PQT)};
                  pg8::gemm_phase<pg8::EpiChan, pg8::SchedChan>(lds, gm, S, E); }
            PH_END
            PH_BEGIN
                hgrn_combine(p, l);
                __syncthreads();
                const int half = G >> 1;
                if (cb < half) { pg8::Gemm gm{(const bf16_t*)(ws + WS_DSEQ), (const bf16_t*)(ws + G_PQT), 4096, 4096, 2048}; pg8::SchedSeqH S; S.init(half, cb);
                  pg8::EpiSeqH E{(bf16_t*)(ws + G_SQ)};
                  pg8::gemm_phase<pg8::EpiSeqH, pg8::SchedSeqH>(lds, gm, S, E); }
                else { pg8::Gemm gm{(const bf16_t*)(ws + G_SGR), (const bf16_t*)(ws + WS_WRET), 2048, 2048, 2048}; pg8::SchedPlain S; S.init(TG, DM, 2048, 2048, G - half, cb - half);
                  pg8::EpiMix<0> E{(bf16_t*)(ws + G_F1), (const bf16_t*)(ws + G_GATES)};
                  pg8::gemm_phase<pg8::EpiMix<0>, pg8::SchedPlain>(lds, gm, S, E); }
            PH_END
            PH_BEGIN
                seq_combine((const bf16_t*)(ws + G_SQ), (const bf16_t*)(ws + G_PQT), (bf16_t*)(ws + G_YF));
            PH_END
            PH_BEGIN
                __syncthreads();
                const int half = G >> 1;
                if (cb < half) { pg8::Gemm gm{(const bf16_t*)(ws + G_SGH), (const bf16_t*)(ws + WS_WHG), DM, DM, DM}; pg8::SchedPlain S; S.init(TG, DM, DM, DM, half, cb);
                  pg8::EpiMix<1> E{(bf16_t*)(ws + G_F1), (const bf16_t*)(ws + G_GATES) + 1024};
                  pg8::gemm_phase<pg8::EpiMix<1>, pg8::SchedPlain>(lds, gm, S, E); }
                else { pg8::Gemm gm{(const bf16_t*)(ws + G_YF), (const bf16_t*)(ws + WS_WFN), DM, DM, DM}; pg8::SchedPlain S; S.init(TG, DM, DM, DM, G - half, cb - half);
                  pg8::EpiMix<0> E{(bf16_t*)(ws + G_F2), (const bf16_t*)(ws + G_GATES) + 2048};
                  pg8::gemm_phase<pg8::EpiMix<0>, pg8::SchedPlain>(lds, gm, S, E); }
            PH_END
            if (g == NGRP - 1) {
            PH_BEGIN
                mix_combine((const bf16_t*)(ws + G_F1), (const bf16_t*)(ws + G_F2), (bf16_t*)(ws + WS_MIXIN) + (size_t)tok0 * DM, cb, G);
            PH_END
            }
        }
        PH_BEGIN
            __syncthreads();
            { pg8::Gemm gm{(const bf16_t*)(ws + WS_MIXIN), (const bf16_t*)(ws + WS_WOUT), DM, DM, DM}; pg8::SchedPlain S; S.init(TA, DM, DM, DM, G, cb);
              pg8::EpiBf16<DM> E{(bf16_t*)(ws + A_MIXO)};
              pg8::gemm_phase<pg8::EpiBf16<DM>, pg8::SchedPlain>(lds, gm, S, E); }
        PH_END
        PH_BEGIN
            resid_rows((const bf16_t*)(ws + A_MIXO), xsrc, p.out, nw + DM, nw + 2 * DM, (bf16_t*)(ws + A_HN));
        PH_END
        PH_BEGIN
            __syncthreads();
            { pg8::Gemm gm{(const bf16_t*)(ws + A_HN), (const bf16_t*)(ws + WS_WUP), DM, DM, DM}; pg8::SchedPlain S; S.init(TA, 2 * DFF, DM, DM, G, cb);
              pg8::EpiBf16<2 * DFF> E{(bf16_t*)(ws + A_H)};
              pg8::gemm_phase<pg8::EpiBf16<2 * DFF>, pg8::SchedPlain>(lds, gm, S, E); }
        PH_END
        PH_BEGIN
            conv_phase((const bf16_t*)(ws + A_H), p.conv_w + (size_t)l * 3 * 2 * DFF, p.conv_b + (size_t)l * 2 * DFF, (bf16_t*)(ws + A_ACT));
        PH_END
        PH_BEGIN
            __syncthreads();
            { pg8::Gemm gm{(const bf16_t*)(ws + A_ACT), (const bf16_t*)(ws + WS_WDN), DFF, DFF, DFF}; pg8::SchedPlain S; S.init(TA, DM, DFF, DFF, G, cb);
              pg8::EpiBf16<DM> E{(bf16_t*)(ws + A_FFO)};
              pg8::gemm_phase<pg8::EpiBf16<DM>, pg8::SchedPlain>(lds, gm, S, E); }
        PH_END
        PH_BEGIN
            if (l + 1 < DEPTH) { resid_rows((const bf16_t*)(ws + A_FFO), p.out, p.out, nw + 3 * DM, nw + 4 * DM, (bf16_t*)(ws + WS_MIXIN));
                                 prep_weights(p, l + 1, lds); }
            else resid_rows((const bf16_t*)(ws + A_FFO), p.out, p.out, nw + 3 * DM, nullptr, nullptr);
        PH_END
    }
#undef PH_BEGIN
#undef PH_END
}
constexpr int NPHASES = 1 + DEPTH * (NGRP * 5 + 1 + 6);

extern "C" void kernel_launch(void* const* d_in, const int* in_sizes, int n_in, void* d_out, int out_size, void* d_ws, size_t ws_size, hipStream_t stream) {
    static int grid = 0;
    if (grid == 0) {
        int dev = 0, cus = 0, per_cu = 0;
        hipGetDevice(&dev);
        hipDeviceGetAttribute(&cus, hipDeviceAttributeMultiprocessorCount, dev);
        if (hipFuncSetAttribute((const void*)fwd_kernel, hipFuncAttributeMaxDynamicSharedMemorySize, LDS_BYTES) != hipSuccess) fprintf(stderr, "hipFuncSetAttribute failed\n");
        if (hipOccupancyMaxActiveBlocksPerMultiprocessor(&per_cu, (const void*)fwd_kernel, NTHREADS, LDS_BYTES) != hipSuccess || per_cu < 1) { fprintf(stderr, "occupancy query: %d\n", per_cu); per_cu = 1; }
        (void)hipGetLastError();
        grid = cus * 1;
        if (ws_size < 480 * MiB) fprintf(stderr, "kernel_launch: workspace %zu too small\n", ws_size);
    }
    Params p{};
    p.x = (const float*)d_in[0]; p.pos = (const int*)d_in[1]; p.norm_w = (const float*)d_in[2]; p.w_in = (const float*)d_in[3]; p.lb_logits = (const float*)d_in[4];
    p.hgrn_norm_w = (const float*)d_in[5]; p.w_ret_o = (const float*)d_in[6]; p.w_hgrn_o = (const float*)d_in[7]; p.w_fnet = (const float*)d_in[8]; p.w_out = (const float*)d_in[9];
    p.w_up = (const float*)d_in[10]; p.conv_w = (const float*)d_in[11]; p.conv_b = (const float*)d_in[12]; p.w_down = (const float*)d_in[13];
    p.out = (float*)d_out; p.ws = (unsigned char*)d_ws;
    (void)hipMemsetAsync((unsigned char*)d_ws + WS_BAR, 0, 32768, stream);
#if MK_MULTI
    for (int ph = 0; ph < NPHASES; ++ph) { p.ph_lo = ph; p.ph_hi = ph + 1; hipLaunchKernelGGL(fwd_kernel, dim3(grid), dim3(NTHREADS), LDS_BYTES, stream, p); }
#else
    p.ph_lo = 0; p.ph_hi = NPHASES;
    void* args[] = {&p};
    hipError_t e = hipLaunchCooperativeKernel((const void*)fwd_kernel, dim3(grid), dim3(NTHREADS), args, LDS_BYTES, stream);
    if (e != hipSuccess) fprintf(stderr, "cooperative launch failed: %s (grid %d)\n", hipGetErrorString(e), grid);
#endif
}
```

```cpp
#include <hip/hip_runtime.h>
#include <hip/hip_cooperative_groups.h>
#include <cstdio>
#include <cstdint>
namespace cg = cooperative_groups;

#ifndef MK_MULTI
#define MK_MULTI 0
#endif

#define LAS __attribute__((address_space(3)))
typedef unsigned short bf16_t;
typedef short bf16x8 __attribute__((ext_vector_type(8)));
typedef float f32x4 __attribute__((ext_vector_type(4)));
typedef float f32x2 __attribute__((ext_vector_type(2)));
typedef unsigned u32x4 __attribute__((ext_vector_type(4)));
typedef unsigned u32x2 __attribute__((ext_vector_type(2)));

constexpr int BATCH = 8, SEQ = 2048, DM = 1024, DEPTH = 2, DIN = 15360, DFF = 2816;
constexpr int NB = 4;
constexpr int NGRP = BATCH / NB;
constexpr int TG = NB * SEQ;
constexpr int TA = BATCH * SEQ;
constexpr float EPS = 1e-6f;
constexpr int NTHREADS = 512;
constexpr int LDS_BYTES = 156 * 1024;

constexpr size_t MiB = 1u << 20;
constexpr size_t WS_WIN = 0;
constexpr size_t WS_WRET = WS_WIN + (size_t)DIN * DM * 2;
constexpr size_t WS_WHG = WS_WRET + (size_t)DM * 2048 * 2;
constexpr size_t WS_WFN = WS_WHG + (size_t)DM * DM * 2;
constexpr size_t WS_WOUT = WS_WFN + (size_t)DM * DM * 2;
constexpr size_t WS_WUP = WS_WOUT + (size_t)DM * DM * 2;
constexpr size_t WS_WDN = WS_WUP + (size_t)2 * DFF * DM * 2;
constexpr size_t WS_WEND = WS_WDN + (size_t)DM * DFF * 2;
static_assert(WS_WEND <= 58 * MiB, "weights");
constexpr size_t WS_DSEQ = 58 * MiB;
constexpr size_t WS_CDFT = 74 * MiB;
constexpr size_t WS_LB = WS_CDFT + 512 * 1024;
constexpr size_t WS_BAR = WS_CDFT + 640 * 1024;
constexpr size_t WS_ROPE = 75 * MiB;
constexpr size_t WS_MIXIN = 91 * MiB;
constexpr size_t WS_G = 123 * MiB;
constexpr size_t G_HOF = WS_G + 0 * MiB;
constexpr size_t G_Q = WS_G + 16 * MiB;
constexpr size_t G_K = WS_G + 32 * MiB;
constexpr size_t G_VT = WS_G + 48 * MiB;
constexpr size_t G_SGR = WS_G + 80 * MiB;
constexpr size_t G_HQ = WS_G + 112 * MiB;
constexpr size_t G_LFF = WS_G + 128 * MiB;
constexpr size_t G_LFB = WS_G + 144 * MiB;
constexpr size_t G_HI = WS_G + 160 * MiB;
constexpr size_t G_SGH = WS_G + 176 * MiB;
constexpr size_t G_FU = WS_G + 192 * MiB;
constexpr size_t G_GATES = WS_G + 208 * MiB;
constexpr size_t G_PQT = WS_G + 256 * MiB;
constexpr size_t G_SQ = WS_G + 16 * MiB;
constexpr size_t G_F1 = WS_G + 320 * MiB;
constexpr size_t G_F2 = WS_G + 336 * MiB;
constexpr size_t G_YF = WS_G + 288 * MiB;
constexpr size_t G_HOB = WS_G + 304 * MiB;
constexpr size_t G_END = WS_G + 320 * MiB;
constexpr size_t A_HN = WS_G + 0 * MiB;
constexpr size_t A_MIXO = WS_G + 32 * MiB;
constexpr size_t A_H = WS_G + 96 * MiB;
constexpr size_t A_FFO = A_H;
constexpr size_t A_ACT = WS_MIXIN;
constexpr size_t A_END = A_H + (size_t)TA * 2 * DFF * 2;
static_assert(G_END <= 480 * MiB && A_END <= 480 * MiB, "ws");
static_assert(A_ACT + (size_t)TA * DFF * 2 <= A_H, "act overlay");

__device__ __forceinline__ unsigned f2bf(float f) { unsigned u = __builtin_bit_cast(unsigned, f); return (u + 0x7fffu + ((u >> 16) & 1u)) >> 16; }
__device__ __forceinline__ unsigned pk2(float lo, float hi) { return f2bf(lo) | (f2bf(hi) << 16); }
__device__ __forceinline__ float bf2f(unsigned short h) { return __builtin_bit_cast(float, (unsigned)h << 16); }
__device__ __forceinline__ float bflo(unsigned w) { return __builtin_bit_cast(float, w << 16); }
__device__ __forceinline__ float bfhi(unsigned w) { return __builtin_bit_cast(float, w & 0xffff0000u); }
__device__ __forceinline__ float shx(float v, int o, int lane) { return __builtin_bit_cast(float, __builtin_amdgcn_ds_bpermute((lane ^ o) << 2, __builtin_bit_cast(int, v))); }
__device__ __forceinline__ float wave_sum(float v, int lane) {
#pragma unroll
    for (int o = 1; o < 64; o <<= 1) v += shx(v, o, lane);
    return v;
}
__device__ __forceinline__ int otid() { int t = threadIdx.x; asm volatile("" : "+v"(t)); return t; }
__device__ __forceinline__ int obid() { int t = blockIdx.x; asm volatile("" : "+s"(t)); return t; }
__device__ __forceinline__ int ogrid() { int t = gridDim.x; asm volatile("" : "+s"(t)); return t; }
typedef __bf16 bf16x2_t __attribute__((ext_vector_type(2)));
__device__ __forceinline__ unsigned cvtpk(float lo, float hi) { const f32x2 v = {lo, hi}; const bf16x2_t b = __builtin_convertvector(v, bf16x2_t); return __builtin_bit_cast(unsigned, b); }
__device__ __forceinline__ float silu_f(float x) { return x * __builtin_amdgcn_rcpf(1.f + __builtin_amdgcn_exp2f(-1.4426950408889634f * x)); }
__device__ __forceinline__ float sigm_f(float x) { return __builtin_amdgcn_rcpf(1.f + __builtin_amdgcn_exp2f(-1.4426950408889634f * x)); }
__device__ __forceinline__ f32x4 mfma16(bf16x8 a, bf16x8 b, f32x4 c) { return __builtin_amdgcn_mfma_f32_16x16x32_bf16(a, b, c, 0, 0, 0); }

namespace pg8 {
constexpr int BM = 256, BK = 64, HALF = 128, HTB = HALF * BK * 2, STAGE_BYTES = 8 * HTB, NXCD = 8, WGM = 8;
__host__ __device__ __forceinline__ int lds_byte(int r, int c) { const int st = (r >> 4) * 2 + (c >> 5), rr = r & 15, cc = c & 31, ob = rr * 64 + cc * 2; return st * 1024 + (ob ^ (((ob >> 9) & 1) << 5)); }
__host__ __device__ __forceinline__ void stage_rc(int b, int& R, int& C) { const int st = b / 1024, sb = b % 1024, swz = sb ^ (((sb >> 9) & 1) << 5); R = (st >> 1) * 16 + swz / 64; C = (st & 1) * 32 + (swz % 64) / 2; }
__host__ __device__ __forceinline__ int perm32(int rho) { const int n = rho >> 4, i = rho & 15; return 8 * (i >> 2) + 4 * n + (i & 3); }

struct Unit { int pm, pn, z; size_t offA, offB; };
struct Gemm { const bf16_t* A; const bf16_t* Bt; int lda, ldb, K; };

struct StaticOrder {
    int nM, nN, nwg, G, c;
    __device__ __forceinline__ void init(int nM_, int nN_, int G_, int c_) { nM = nM_; nN = nN_; nwg = nM * nN; G = G_; c = c_; }
    __device__ __forceinline__ bool next(int i, int& pm, int& pn) const {
        const long L = (long)i * G + c; if (L >= nwg) return false;
        int wgid = (int)L; { const int q = nwg / NXCD, r = nwg % NXCD, xcd = wgid % NXCD, off = wgid / NXCD; wgid = (xcd < r ? xcd * (q + 1) : r * (q + 1) + (xcd - r) * q) + off; }
        const int nig = WGM * nN, gid = wgid / nig, fm = gid * WGM, gsz = (nM - fm) < WGM ? (nM - fm) : WGM;
        pm = fm + ((wgid % nig) % gsz); pn = (wgid % nig) / gsz; return true;
    }
};
struct SchedPlain {
    StaticOrder o; size_t tA, tB;
    __device__ __forceinline__ void init(int M, int N, int lda, int ldb, int G, int c) { o.init(M / BM, N / BM, G, c); tA = (size_t)BM * lda * 2; tB = (size_t)BM * ldb * 2; }
    __device__ __forceinline__ bool next(int i, Unit& u) const { int pm, pn; if (!o.next(i, pm, pn)) return false; u.pm = pm; u.pn = pn; u.z = 0; u.offA = pm * tA; u.offB = pn * tB; return true; }
};
struct SchedInProj {
    StaticOrder o; size_t tA, tB;
    __device__ __forceinline__ void init(int G, int c) { o.init(TG / BM, 52, G, c); tA = (size_t)BM * DM * 2; tB = (size_t)BM * DM * 2; }
    __device__ __forceinline__ bool next(int i, Unit& u) const { int pm, pn; if (!o.next(i, pm, pn)) return false; if (pn >= 8) pn += 8; u.pm = pm; u.pn = pn; u.z = 0; u.offA = pm * tA; u.offB = pn * tB; return true; }
};
struct SchedChan {
    int G, c, base, lim;
    __device__ __forceinline__ void init(int G_, int c_, int base_ = 0, int lim_ = 4 * 2 * (TG / BM)) { G = G_; c = c_; base = base_; lim = lim_; }
    __device__ __forceinline__ bool next(int i, Unit& u) const {
        const int L = base + i * G + c; constexpr int NT = TG / BM; if (L >= lim) return false;
        const int g = L / (2 * NT), r = L % (2 * NT); u.z = g; u.pm = r / NT; u.pn = r % NT;
        u.offA = (size_t)u.pm * BM * 256 * 2; u.offB = ((size_t)u.pn * BM * DM + g * 256) * 2; return true;
    }
};

struct SchedSeqH {
    int G, c;
    __device__ __forceinline__ void init(int G_, int c_) { G = G_; c = c_; }
    __device__ __forceinline__ bool next(int i, Unit& u) const {
        const int L = i * G + c; constexpr int NN = NB * 1024 / BM; if (L >= 2 * 4 * NN) return false;
        const int z = L / (4 * NN), r = L % (4 * NN); u.z = z; u.pm = r / NN; u.pn = r % NN;
        u.offA = ((size_t)u.pm * BM * 4096 + z * 2048) * 2; u.offB = ((size_t)u.pn * BM * 4096 + z * 2048) * 2; return true;
    }
};
__device__ __forceinline__ unsigned cvt_pk_bf16(float lo, float hi) { return cvtpk(lo, hi); }

template <class Epi, class Sched, bool ALIGN_EPI = true, bool SP2 = true>
__device__ __forceinline__ void gemm_phase(LAS unsigned char* lds, const Gemm g, const Sched& S, const Epi& E) {
    int tid_ = threadIdx.x; asm volatile("" : "+v"(tid_));
    const int tid = tid_, wid = __builtin_amdgcn_readfirstlane(tid >> 6), lane = tid & 63, wr = wid >> 2, wc = wid & 3, fr = lane & 15, fq = lane >> 4;
    const int K = g.K, nt = K / BK;
    unsigned voffA[2], voffB[2];
#pragma unroll
    for (int i = 0; i < 2; ++i) { int R, C; stage_rc(tid * 16 + i * 8192, R, C); const int Rb = Epi::PERM ? ((R & ~31) + perm32(R & 31)) : R;
        voffA[i] = (unsigned)(R * g.lda + C) * 2u; voffB[i] = (unsigned)(Rb * g.ldb + C) * 2u; }
    const size_t kstep = (size_t)(BK * 2);
    const size_t hstepA = (size_t)HALF * g.lda * 2, hstepB = (size_t)HALF * g.ldb * 2;
    const unsigned ldsw = (unsigned)wid * 1024u;
    const int aoff = lds_byte(wr * 64 + fr, fq * 8), boff = lds_byte(wc * 32 + fr, fq * 8);
#define PG8_SA(b, h) (((b) * 2 + (h)) * HTB)
#define PG8_SB(b, h) ((4 + (b) * 2 + (h)) * HTB)
#define PG8_STAGE(bufoff, gbase, voff) do { const char* _gb = (const char*)(gbase); asm volatile("" : "+s"(_gb));     \
        _Pragma("unroll") for (int _i = 0; _i < 2; ++_i) \
        __builtin_amdgcn_global_load_lds((const unsigned*)(_gb + (voff)[_i]), (LAS unsigned*)(lds + (bufoff) + ldsw + _i * 8192), 16, 0, 0); } while (0)
#define PG8_LDA(dst, b, h) do { _Pragma("unroll") for (int m = 0; m < 4; ++m) _Pragma("unroll") for (int k = 0; k < 2; ++k) dst[m][k] = *(const LAS bf16x8*)(lds + PG8_SA(b, h) + aoff + m * 2048 + k * 1024); } while (0)
#define PG8_LDB(dst, b, h) do { _Pragma("unroll") for (int n = 0; n < 2; ++n) _Pragma("unroll") for (int k = 0; k < 2; ++k) dst[n][k] = *(const LAS bf16x8*)(lds + PG8_SB(b, h) + boff + n * 2048 + k * 1024); } while (0)
#define PG8_MMA(ai, bj, At, Bt) do { __builtin_amdgcn_s_setprio(1); _Pragma("unroll") for (int m = 0; m < 4; ++m) _Pragma("unroll") for (int n = 0; n < 2; ++n) _Pragma("unroll") for (int k = 0; k < 2; ++k) \
        acc[ai][bj][m][n] = __builtin_amdgcn_mfma_f32_16x16x32_bf16(Bt[n][k], At[m][k], acc[ai][bj][m][n], 0, 0, 0); __builtin_amdgcn_s_setprio(0); } while (0)
#define PG8_WAIT_V(n) asm volatile("s_waitcnt vmcnt(" #n ")" ::: "memory")
#define PG8_WAIT_L(n) asm volatile("s_waitcnt lgkmcnt(" #n ")" ::: "memory")
#define PG8_BAR __builtin_amdgcn_s_barrier()
#define PG8_SCHED __builtin_amdgcn_sched_barrier(0)
    Unit cur, nxt; int ui = 0;
    if (!S.next(0, cur)) return;
    f32x4 acc[2][2][4][2];
#pragma unroll
    for (int a = 0; a < 2; ++a)
#pragma unroll
        for (int b = 0; b < 2; ++b)
#pragma unroll
            for (int m = 0; m < 4; ++m)
#pragma unroll
                for (int n = 0; n < 2; ++n) acc[a][b][m][n] = (f32x4){0.f, 0.f, 0.f, 0.f};
    bf16x8 At[4][2], B0[2][2], B1[2][2];
    const char* cA = (const char*)g.A + cur.offA; const char* cB = (const char*)g.Bt + cur.offB;
    if constexpr (SP2) {
        PG8_STAGE(PG8_SB(0, 0), cB, voffB); PG8_STAGE(PG8_SB(0, 1), cB + hstepB, voffB); PG8_STAGE(PG8_SA(0, 0), cA, voffA); PG8_STAGE(PG8_SA(0, 1), cA + hstepA, voffA);
        if (wr == 1) PG8_BAR;
        PG8_WAIT_V(2); PG8_BAR;
        PG8_STAGE(PG8_SB(1, 0), cB + kstep, voffB); PG8_STAGE(PG8_SA(1, 0), cA + kstep, voffA); PG8_STAGE(PG8_SB(1, 1), cB + hstepB + kstep, voffB);
        PG8_WAIT_V(6); PG8_BAR;
    } else {
        PG8_STAGE(PG8_SB(0, 0), cB, voffB); PG8_STAGE(PG8_SA(0, 0), cA, voffA); PG8_STAGE(PG8_SB(0, 1), cB + hstepB, voffB); PG8_STAGE(PG8_SA(0, 1), cA + hstepA, voffA);
        if (wr == 1) PG8_BAR;
        PG8_WAIT_V(4); PG8_BAR;
        PG8_STAGE(PG8_SB(1, 0), cB + kstep, voffB); PG8_STAGE(PG8_SA(1, 0), cA + kstep, voffA); PG8_STAGE(PG8_SB(1, 1), cB + hstepB + kstep, voffB);
        PG8_WAIT_V(6); PG8_BAR;
    }
    for (;;) {
        const bool has_next = S.next(ui + 1, nxt);
        const char* nA = has_next ? (const char*)g.A + nxt.offA : cA; const char* nB = has_next ? (const char*)g.Bt + nxt.offB : cB;
        for (int t = 0; t < nt; t += 2) {
            const bool last = (t == nt - 2);
            const char* a1 = cA + (size_t)(t + 1) * kstep;
            const char* a2 = last ? nA : cA + (size_t)(t + 2) * kstep; const char* b2 = last ? nB : cB + (size_t)(t + 2) * kstep;
            const char* a3 = a2 + kstep; const char* b3 = b2 + kstep;
            if constexpr (SP2) {
            PG8_LDB(B0, 0, 0); PG8_LDB(B1, 0, 1); PG8_SCHED; PG8_LDA(At, 0, 0); PG8_STAGE(PG8_SA(1, 1), a1 + hstepA, voffA);
            PG8_WAIT_V(8); PG8_WAIT_L(0); PG8_BAR; PG8_MMA(0, 0, At, B0); PG8_MMA(0, 1, At, B1); PG8_BAR; PG8_SCHED;
            PG8_LDA(At, 0, 1); PG8_STAGE(PG8_SB(0, 0), b2, voffB); PG8_STAGE(PG8_SB(0, 1), b2 + hstepB, voffB); PG8_STAGE(PG8_SA(0, 0), a2, voffA);
            PG8_WAIT_V(8); PG8_WAIT_L(0); PG8_BAR; PG8_MMA(1, 0, At, B0); PG8_MMA(1, 1, At, B1); PG8_BAR; PG8_SCHED;
            PG8_LDB(B0, 1, 0); PG8_LDB(B1, 1, 1); PG8_SCHED; PG8_LDA(At, 1, 0); PG8_STAGE(PG8_SA(0, 1), a2 + hstepA, voffA);
            PG8_WAIT_V(8); PG8_WAIT_L(0); PG8_BAR; PG8_MMA(0, 0, At, B0); PG8_MMA(0, 1, At, B1); PG8_BAR; PG8_SCHED;
            PG8_LDA(At, 1, 1); PG8_STAGE(PG8_SB(1, 0), b3, voffB); PG8_STAGE(PG8_SB(1, 1), b3 + hstepB, voffB); PG8_STAGE(PG8_SA(1, 0), a3, voffA);
            PG8_WAIT_V(8); PG8_WAIT_L(0); PG8_BAR; PG8_MMA(1, 0, At, B0); PG8_MMA(1, 1, At, B1); PG8_BAR; PG8_SCHED;
            } else {
            PG8_LDB(B0, 0, 0); PG8_SCHED; PG8_LDA(At, 0, 0); PG8_STAGE(PG8_SA(1, 1), a1 + hstepA, voffA);
            PG8_WAIT_L(8); PG8_BAR; PG8_WAIT_L(0); PG8_MMA(0, 0, At, B0); PG8_BAR; PG8_SCHED;
            PG8_LDB(B1, 0, 1); PG8_STAGE(PG8_SB(0, 0), b2, voffB);
            PG8_BAR; PG8_WAIT_L(0); PG8_MMA(0, 1, At, B1); PG8_BAR;
            PG8_LDA(At, 0, 1); PG8_STAGE(PG8_SA(0, 0), a2, voffA);
            PG8_BAR; PG8_WAIT_L(0); PG8_MMA(1, 0, At, B0); PG8_BAR; PG8_SCHED;
            PG8_STAGE(PG8_SB(0, 1), b2 + hstepB, voffB);
            PG8_WAIT_V(6); PG8_BAR; PG8_MMA(1, 1, At, B1); PG8_BAR;
            PG8_LDB(B0, 1, 0); PG8_SCHED; PG8_LDA(At, 1, 0); PG8_STAGE(PG8_SA(0, 1), a2 + hstepA, voffA);
            PG8_WAIT_L(8); PG8_BAR; PG8_WAIT_L(0); PG8_MMA(0, 0, At, B0); PG8_BAR; PG8_SCHED;
            PG8_LDB(B1, 1, 1); PG8_STAGE(PG8_SB(1, 0), b3, voffB);
            PG8_BAR; PG8_WAIT_L(0); PG8_MMA(0, 1, At, B1); PG8_BAR;
            PG8_LDA(At, 1, 1); PG8_STAGE(PG8_SA(1, 0), a3, voffA);
            PG8_BAR; PG8_WAIT_L(0); PG8_MMA(1, 0, At, B0); PG8_BAR; PG8_SCHED;
            PG8_STAGE(PG8_SB(1, 1), b3 + hstepB, voffB);
            PG8_WAIT_V(6); PG8_BAR; PG8_MMA(1, 1, At, B1); PG8_BAR;
            }
        }
        if constexpr (ALIGN_EPI) { if (wr == 0) PG8_BAR; }
        { int t2 = tid; asm volatile("" : "+v"(t2));
          const int w2 = t2 >> 6, l2 = t2 & 63; E(acc, cur, w2 >> 2, w2 & 3, l2 & 15, l2 >> 4); }
        if (!has_next) break;
#pragma unroll
        for (int a = 0; a < 2; ++a)
#pragma unroll
            for (int b = 0; b < 2; ++b)
#pragma unroll
                for (int m = 0; m < 4; ++m)
#pragma unroll
                    for (int n = 0; n < 2; ++n) acc[a][b][m][n] = (f32x4){0.f, 0.f, 0.f, 0.f};
        cur = nxt; cA = nA; cB = nB; ++ui;
        if constexpr (ALIGN_EPI) { if (wr == 1) PG8_BAR; }
    }
    PG8_WAIT_V(0);
    if constexpr (!ALIGN_EPI) { if (wr == 0) PG8_BAR; }
    PG8_BAR;
#undef PG8_SA
#undef PG8_SB
#undef PG8_STAGE
#undef PG8_LDA
#undef PG8_LDB
#undef PG8_MMA
#undef PG8_WAIT_V
#undef PG8_WAIT_L
#undef PG8_BAR
#undef PG8_SCHED
}

typedef f32x4 Acc[2][2][4][2];
#define EPI_ROW_FENCE __builtin_amdgcn_sched_barrier(0)
__device__ __forceinline__ u32x4 pack8(const f32x4 v0, const f32x4 v1) { u32x4 w; w.x = cvt_pk_bf16(v0[0], v0[1]); w.y = cvt_pk_bf16(v0[2], v0[3]); w.z = cvt_pk_bf16(v1[0], v1[1]); w.w = cvt_pk_bf16(v1[2], v1[3]); return w; }

template <int LDC> __device__ __forceinline__ void store_tile_bf16(const Acc& acc, bf16_t* base) {
#pragma unroll
    for (int ai = 0; ai < 2; ++ai)
#pragma unroll
        for (int m = 0; m < 4; ++m) { bf16_t* rowp = base + (size_t)(ai * HALF + m * 16) * LDC;
#pragma unroll
            for (int bj = 0; bj < 2; ++bj) *(u32x4*)(rowp + bj * HALF) = pack8(acc[ai][bj][m][0], acc[ai][bj][m][1]);
            EPI_ROW_FENCE; }
}
template <int LDC> struct EpiBf16 {
    static constexpr bool PERM = true;
    bf16_t* O;
    __device__ __forceinline__ void operator()(const Acc& acc, const Unit& u, int wr, int wc, int fr, int fq) const {
        store_tile_bf16<LDC>(acc, O + (size_t)(u.pm * BM + wr * 64 + fr) * LDC + u.pn * BM + wc * 32 + 8 * fq);
    }
};
struct EpiF32 {
    static constexpr bool PERM = false;
    float* O;
    __device__ __forceinline__ void operator()(const Acc& acc, const Unit& u, int wr, int wc, int fr, int fq) const {
        float* base = O + (size_t)(u.pm * BM + wr * 64 + fr) * DM + u.pn * BM + wc * 32 + 4 * fq;
#pragma unroll
        for (int ai = 0; ai < 2; ++ai)
#pragma unroll
            for (int m = 0; m < 4; ++m) { float* rowp = base + (size_t)(ai * HALF + m * 16) * DM;
#pragma unroll
                for (int bj = 0; bj < 2; ++bj)
#pragma unroll
                    for (int n = 0; n < 2; ++n) *(f32x4*)(rowp + bj * HALF + 16 * n) = acc[ai][bj][m][n];
                EPI_ROW_FENCE; }
    }
};
struct EpiSeqH {
    static constexpr bool PERM = true;
    bf16_t* O;
    __device__ __forceinline__ void operator()(const Acc& acc, const Unit& u, int wr, int wc, int fr, int fq) const {
        constexpr int LD = NB * 1024;
        store_tile_bf16<LD>(acc, O + ((size_t)u.z * 1024 + u.pm * BM + wr * 64 + fr) * LD + u.pn * BM + wc * 32 + 8 * fq);
    }
};
template <int MODE> struct EpiMix {
    static constexpr bool PERM = false;
    bf16_t* F; const bf16_t* gates;
    __device__ __forceinline__ void operator()(const Acc& acc, const Unit& u, int wr, int wc, int fr, int fq) const {
        const size_t row0 = u.pm * BM + wr * 64 + fr; const int col0 = u.pn * BM + wc * 32 + 4 * fq;
        bf16_t* fb = F + row0 * DM + col0; const bf16_t* gb = gates + row0 * 3072 + col0;
#pragma unroll
        for (int ai = 0; ai < 2; ++ai) {
            u32x2 gw[4][4], ow[4][4];
#pragma unroll
            for (int m = 0; m < 4; ++m)
#pragma unroll
                for (int q = 0; q < 4; ++q) { const int ro = ai * HALF + m * 16, co = (q >> 1) * HALF + 16 * (q & 1);
                    gw[m][q] = *(const u32x2*)(gb + (size_t)ro * 3072 + co);
                    if (MODE >= 1) ow[m][q] = *(const u32x2*)(fb + (size_t)ro * DM + co); }
#pragma unroll
            for (int m = 0; m < 4; ++m)
#pragma unroll
                for (int q = 0; q < 4; ++q) { const int ro = ai * HALF + m * 16, co = (q >> 1) * HALF + 16 * (q & 1);
                    f32x4 v = acc[ai][q >> 1][m][q & 1]; v[0] *= bflo(gw[m][q].x); v[1] *= bfhi(gw[m][q].x); v[2] *= bflo(gw[m][q].y); v[3] *= bfhi(gw[m][q].y);
                    if (MODE >= 1) { v[0] += bflo(ow[m][q].x); v[1] += bfhi(ow[m][q].x); v[2] += bflo(ow[m][q].y); v[3] += bfhi(ow[m][q].y); }
                    u32x2 w; w.x = cvt_pk_bf16(v[0], v[1]); w.y = cvt_pk_bf16(v[2], v[3]); *(u32x2*)(fb + (size_t)ro * DM + co) = w; }
            EPI_ROW_FENCE; }
    }
};
struct EpiChan {
    static constexpr bool PERM = true;
    bf16_t* PQT;
    __device__ __forceinline__ void operator()(const Acc& acc, const Unit& u, int wr, int wc, int fr, int fq) const {
        const int tok0 = u.pn * BM, bl = tok0 >> 11, s0 = (tok0 & (SEQ - 1)) + wc * 32 + 8 * fq;
        store_tile_bf16<4096>(acc, PQT + ((size_t)(bl * 1024 + u.z * 256 + wr * 64 + fr)) * 4096 + u.pm * 2048 + s0);
    }
};
struct EpiSeq {
    static constexpr bool PERM = true;
    bf16_t* YF;
    __device__ __forceinline__ void operator()(const Acc& acc, const Unit& u, int wr, int wc, int fr, int fq) const {
        const int bl = u.pn >> 2, gc0 = (u.pn & 3) * 256 + wc * 32 + 8 * fq;
        store_tile_bf16<DM>(acc, YF + ((size_t)(bl * SEQ + u.pm * BM + wr * 64 + fr)) * DM + gc0);
    }
};
template <int KIND, int LDC> __device__ __forceinline__ void store_act(const Acc& acc, bf16_t* base, const float* lbp) {
    f32x4 lbv4[2][2];
#pragma unroll
    for (int bj = 0; bj < 2; ++bj)
#pragma unroll
        for (int n = 0; n < 2; ++n) lbv4[bj][n] = (KIND == 4) ? *(const f32x4*)(lbp + bj * HALF + 4 * n) : (f32x4){0.f, 0.f, 0.f, 0.f};
#pragma unroll
    for (int ai = 0; ai < 2; ++ai)
#pragma unroll
        for (int m = 0; m < 4; ++m) { bf16_t* rowp = base + (size_t)(ai * HALF + m * 16) * LDC;
#pragma unroll
            for (int bj = 0; bj < 2; ++bj) { f32x4 v[2] = {acc[ai][bj][m][0], acc[ai][bj][m][1]};
#pragma unroll
                for (int n = 0; n < 2; ++n) { const f32x4 lb = lbv4[bj][n];
#pragma unroll
                    for (int j = 0; j < 4; ++j) { float x = v[n][j];
                        if (KIND == 2) x = silu_f(x);
                        else if (KIND == 3) x = silu_f(x) * 0.08838834764831845f;
                        else if (KIND == 7) x = sigm_f(x);
                        else if (KIND == 4) { const float l = lb[j], e = __expf(-fabsf(x));
                            const float f = (x >= 0.f ? (1.f + l * e) : (e + l)) * __builtin_amdgcn_rcpf(1.f + e); x = fmaxf(__builtin_amdgcn_logf(f), -115.f); }
                        v[n][j] = x; } }
                *(u32x4*)(rowp + bj * HALF) = pack8(v[0], v[1]); }
            EPI_ROW_FENCE; }
}
struct EpiInProj {
    static constexpr bool PERM = true;
    unsigned char* ws; const float* rope; const float* lbv; int tok0;
    __device__ __forceinline__ void operator()(const Acc& acc, const Unit& u, int wr, int wc, int fr, int fq) const {
        const int pn = u.pn;
        const size_t row0 = u.pm * BM + wr * 64 + fr;
        const int cin = wc * 32 + 8 * fq;
        if (pn < 8) {
            const float sc = pn >= 4 ? 0.0625f : 1.0f;
            bf16_t* base = (bf16_t*)(ws + (pn >= 4 ? G_K : G_Q)) + row0 * DM + (pn & 3) * BM + cin;
            const float* rb = rope + ((size_t)(tok0 + row0) * 128 + cin) * 2;
#pragma unroll
            for (int ai = 0; ai < 2; ++ai) {
                f32x4 cs[4][4];
#pragma unroll
                for (int m = 0; m < 4; ++m) { const f32x4* rp = (const f32x4*)(rb + (size_t)(ai * HALF + m * 16) * 256);
#pragma unroll
                    for (int q = 0; q < 4; ++q) cs[m][q] = rp[q]; }
#pragma unroll
                for (int m = 0; m < 4; ++m) { const int ro = ai * HALF + m * 16;
                    f32x4 o1[2], o2[2];
#pragma unroll
                    for (int n = 0; n < 2; ++n) { const f32x4 cs0 = cs[m][2 * n], cs1 = cs[m][2 * n + 1];
                        const f32x4 x1 = acc[ai][0][m][n], x2 = acc[ai][1][m][n];
                        o1[n][0] = (x1[0] * cs0[0] - x2[0] * cs0[1]) * sc; o2[n][0] = (x1[0] * cs0[1] + x2[0] * cs0[0]) * sc;
                        o1[n][1] = (x1[1] * cs0[2] - x2[1] * cs0[3]) * sc; o2[n][1] = (x1[1] * cs0[3] + x2[1] * cs0[2]) * sc;
                        o1[n][2] = (x1[2] * cs1[0] - x2[2] * cs1[1]) * sc; o2[n][2] = (x1[2] * cs1[1] + x2[2] * cs1[0]) * sc;
                        o1[n][3] = (x1[3] * cs1[2] - x2[3] * cs1[3]) * sc; o2[n][3] = (x1[3] * cs1[3] + x2[3] * cs1[2]) * sc; }
                    bf16_t* rowp = base + (size_t)ro * DM;
                    *(u32x4*)rowp = pack8(o1[0], o1[1]);
                    *(u32x4*)(rowp + HALF) = pack8(o2[0], o2[1]); }
                EPI_ROW_FENCE; }
            return;
        }
        if (pn < 24) store_act<2, 2048>(acc, (bf16_t*)(ws + G_SGR) + row0 * 2048 + (pn - 16) * BM + cin, nullptr);
        else if (pn < 28) store_act<3, DM>(acc, (bf16_t*)(ws + G_HQ) + row0 * DM + (pn - 24) * BM + cin, nullptr);
        else if (pn < 32) store_act<4, DM>(acc, (bf16_t*)(ws + G_LFF) + row0 * DM + (pn - 28) * BM + cin, lbv + (pn - 28) * BM + cin);
        else if (pn < 36) store_act<4, DM>(acc, (bf16_t*)(ws + G_LFB) + row0 * DM + (pn - 32) * BM + cin, lbv + 1024 + (pn - 32) * BM + cin);
        else if (pn < 40) store_act<6, DM>(acc, (bf16_t*)(ws + G_HI) + row0 * DM + (pn - 36) * BM + cin, nullptr);
        else if (pn < 44) store_act<2, DM>(acc, (bf16_t*)(ws + G_SGH) + row0 * DM + (pn - 40) * BM + cin, nullptr);
        else if (pn < 48) store_act<6, DM>(acc, (bf16_t*)(ws + G_FU) + row0 * DM + (pn - 44) * BM + cin, nullptr);
        else store_act<7, 3072>(acc, (bf16_t*)(ws + G_GATES) + row0 * 3072 + (pn - 48) * BM + cin, nullptr);
    }
};
}

struct Params {
    const float* x; const int* pos; const float* norm_w; const float* w_in; const float* lb_logits; const float* hgrn_norm_w;
    const float* w_ret_o; const float* w_hgrn_o; const float* w_fnet; const float* w_out; const float* w_up; const float* conv_w; const float* conv_b; const float* w_down;
    float* out; unsigned char* ws; int ph_lo, ph_hi;
};

__device__ __forceinline__ void transpose_item(const float* W, int K, int N, bf16_t* WT, LAS float* scr, int item, int lane) {
    const int nblk = N / 32, kb = item / nblk, nb = item % nblk, k0 = 64 * kb, n0 = 32 * nb;
#pragma unroll 8
    for (int i = 0; i < 32; ++i) { const int kk = 2 * i + (lane >> 5); scr[kk * 33 + (lane & 31)] = W[(size_t)(k0 + kk) * N + n0 + (lane & 31)]; }
    asm volatile("s_waitcnt lgkmcnt(0)" ::: "memory");
    const int c = lane & 7;
#pragma unroll
    for (int j = 0; j < 4; ++j) { const int n = (lane >> 3) + 8 * j; const LAS float* s = scr + (8 * c) * 33 + n;
        u32x4 o; o.x = pk2(s[0 * 33], s[1 * 33]); o.y = pk2(s[2 * 33], s[3 * 33]); o.z = pk2(s[4 * 33], s[5 * 33]); o.w = pk2(s[6 * 33], s[7 * 33]);
        *(u32x4*)(WT + (size_t)(n0 + n) * K + k0 + 8 * c) = o; }
    asm volatile("s_waitcnt lgkmcnt(0)" ::: "memory");
}

__device__ __forceinline__ void prep_weights(const Params& p, int l, LAS unsigned char* lds) {
    const int tid = otid(), lane = tid & 63, wave = tid >> 6;
    LAS float* scr = (LAS float*)(lds + wave * 16384);
    const int gw = obid() * 8 + wave, NGW = ogrid() * 8;
    unsigned char* ws = p.ws;
    constexpr int I_IN = (DM / 64) * (DIN / 32), I_RET = (2048 / 64) * (DM / 32), I_SQ = (DM / 64) * (DM / 32), I_UP = (DM / 64) * (2 * DFF / 32), I_DN = (DFF / 64) * (DM / 32);
    constexpr int NITEMS = I_IN + I_RET + 3 * I_SQ + I_UP + I_DN;
    for (int it = gw; it < NITEMS; it += NGW) {
        int r = it;
        if (r < I_IN) { transpose_item(p.w_in + (size_t)l * DM * DIN, DM, DIN, (bf16_t*)(ws + WS_WIN), scr, r, lane); continue; } r -= I_IN;
        if (r < I_RET) { transpose_item(p.w_ret_o + (size_t)l * 2048 * DM, 2048, DM, (bf16_t*)(ws + WS_WRET), scr, r, lane); continue; } r -= I_RET;
        if (r < I_SQ) { transpose_item(p.w_hgrn_o + (size_t)l * DM * DM, DM, DM, (bf16_t*)(ws + WS_WHG), scr, r, lane); continue; } r -= I_SQ;
        if (r < I_SQ) { transpose_item(p.w_fnet + (size_t)l * DM * DM, DM, DM, (bf16_t*)(ws + WS_WFN), scr, r, lane); continue; } r -= I_SQ;
        if (r < I_SQ) { transpose_item(p.w_out + (size_t)l * DM * DM, DM, DM, (bf16_t*)(ws + WS_WOUT), scr, r, lane); continue; } r -= I_SQ;
        if (r < I_UP) { transpose_item(p.w_up + (size_t)l * DM * 2 * DFF, DM, 2 * DFF, (bf16_t*)(ws + WS_WUP), scr, r, lane); continue; } r -= I_UP;
        transpose_item(p.w_down + (size_t)l * DFF * DM, DFF, DM, (bf16_t*)(ws + WS_WDN), scr, r, lane);
    }
    const int gt = obid() * NTHREADS + tid;
    if (gt < 2 * DM) { const int dir = gt / DM, c = gt % DM;
        float lg[DEPTH], mx = -1e30f;
#pragma unroll
        for (int j = 0; j < DEPTH; ++j) { lg[j] = p.lb_logits[((size_t)dir * DEPTH + j) * DM + c]; mx = fmaxf(mx, lg[j]); }
        float den = 0.f, num = 0.f;
#pragma unroll
        for (int j = 0; j < DEPTH; ++j) { const float e = expf(lg[j] - mx); den += e; if (j >= 1 && j <= l) num += e; }
        ((float*)(ws + WS_LB))[gt] = fmaxf(num / den, 1e-30f); }
}

__device__ __forceinline__ void prep_tables(const Params& p) {
    const int gt = obid() * NTHREADS + otid(), NT = ogrid() * NTHREADS;
    unsigned char* ws = p.ws;
    bf16_t* dseq = (bf16_t*)(ws + WS_DSEQ);
    const float sc1 = 0.02209708691207961f;
    for (int it = gt; it < 2048 * 512; it += NT) { const int sp = it / 512, k0 = (it % 512) * 8;
        unsigned w[4];
#pragma unroll
        for (int h = 0; h < 4; ++h) { float v[2];
#pragma unroll
            for (int q = 0; q < 2; ++q) { const int kc = k0 + 2 * h + q, s = kc & 2047; const int ph = (s * sp) & 2047; const float a = (float)ph * (1.f / 1024.f);
                v[q] = (kc >> 11) ? -sinpif(a) * sc1 : cospif(a) * sc1; }
            w[h] = pk2(v[0], v[1]); }
        *(u32x4*)(dseq + (size_t)sp * 4096 + k0) = (u32x4){w[0], w[1], w[2], w[3]}; }
    bf16_t* cd = (bf16_t*)(ws + WS_CDFT);
    for (int it = gt; it < 512 * 256; it += NT) { const int r = it / 256, c = it % 256, cp = r & 255; const int ph = (c * cp) & 255; const float a = (float)ph * (1.f / 128.f);
        const float v = (r >> 8) ? sinpif(a) : cospif(a); cd[it] = (bf16_t)f2bf(v * 0.0625f); }
    f32x2* rope = (f32x2*)(ws + WS_ROPE);
    for (int it = gt; it < TA * 128; it += NT) { const int tok = it >> 7, i = it & 127;
        const float inv = powf(10000.f, -(float)i * (1.f / 128.f));
        const float ang = (float)p.pos[tok] * inv;
        double t = (double)ang * 0.31830988618379067; t -= 2.0 * rint(t * 0.5); const float tf = (float)t;
        rope[it] = (f32x2){cospif(tf), sinpif(tf)}; }
}

__device__ __forceinline__ void rms_rows(const float* xsrc, const float* w, bf16_t* XN, int nrows) {
    const int tid = otid(), lane = tid & 63, gw = obid() * 8 + (tid >> 6), NGW = ogrid() * 8;
    f32x4 wv[4];
#pragma unroll
    for (int j = 0; j < 4; ++j) wv[j] = ((const f32x4*)w)[lane + 64 * j];
    for (int m = gw; m < nrows; m += NGW) {
        const f32x4* xr = (const f32x4*)(xsrc + (size_t)m * DM); f32x4 v[4]; float ss = 0.f;
#pragma unroll
        for (int j = 0; j < 4; ++j) { v[j] = xr[lane + 64 * j]; ss += (v[j][0] * v[j][0] + v[j][1] * v[j][1]) + (v[j][2] * v[j][2] + v[j][3] * v[j][3]); }
        const float r = rsqrtf(wave_sum(ss, lane) * (1.f / DM) + EPS);
        u32x2* o = (u32x2*)(XN + (size_t)m * DM);
#pragma unroll
        for (int j = 0; j < 4; ++j) { const f32x4 y = v[j] * r * wv[j]; o[lane + 64 * j] = (u32x2){pk2(y[0], y[1]), pk2(y[2], y[3])}; }
    }
}
__device__ __forceinline__ void resid_rows(const bf16_t* V, const float* xsrc, float* out, const float* w1, const float* w2, bf16_t* HN) {
    const int tid = otid(), lane = tid & 63, gw = obid() * 8 + (tid >> 6), NGW = ogrid() * 8;
    f32x4 w1v[4], w2v[4];
#pragma unroll
    for (int j = 0; j < 4; ++j) { w1v[j] = ((const f32x4*)w1)[lane + 64 * j]; w2v[j] = HN ? ((const f32x4*)w2)[lane + 64 * j] : (f32x4){0.f, 0.f, 0.f, 0.f}; }
    for (int m = gw; m < TA; m += NGW) {
        const u32x2* vr = (const u32x2*)(V + (size_t)m * DM); const f32x4* xr = (const f32x4*)(xsrc + (size_t)m * DM); f32x4 v[4]; float ss = 0.f;
#pragma unroll
        for (int j = 0; j < 4; ++j) { const u32x2 vw = vr[lane + 64 * j]; v[j] = (f32x4){bflo(vw.x), bfhi(vw.x), bflo(vw.y), bfhi(vw.y)}; ss += (v[j][0] * v[j][0] + v[j][1] * v[j][1]) + (v[j][2] * v[j][2] + v[j][3] * v[j][3]); }
        const float r = rsqrtf(wave_sum(ss, lane) * (1.f / DM) + EPS); float s2 = 0.f;
#pragma unroll
        for (int j = 0; j < 4; ++j) { v[j] = xr[lane + 64 * j] + v[j] * r * w1v[j]; ((f32x4*)(out + (size_t)m * DM))[lane + 64 * j] = v[j];
            s2 += (v[j][0] * v[j][0] + v[j][1] * v[j][1]) + (v[j][2] * v[j][2] + v[j][3] * v[j][3]); }
        if (HN) { const float r2 = rsqrtf(wave_sum(s2, lane) * (1.f / DM) + EPS); u32x2* o = (u32x2*)(HN + (size_t)m * DM);
#pragma unroll
            for (int j = 0; j < 4; ++j) { const f32x4 y = v[j] * r2 * w2v[j]; o[lane + 64 * j] = (u32x2){pk2(y[0], y[1]), pk2(y[2], y[3])}; } }
    }
}

__device__ __forceinline__ float gelu_tanh(float x) { const float y = 0.7978845608028654f * (x + 0.044715f * x * x * x); const float t = 1.f - 2.f * __builtin_amdgcn_rcpf(1.f + __builtin_amdgcn_exp2f(2.8853900817779268f * y)); return 0.5f * x * (1.f + t); }
__device__ __forceinline__ void ld8(const bf16_t* p, float (&v)[8]) { const u32x4 w = *(const u32x4*)p; v[0] = bflo(w.x); v[1] = bfhi(w.x); v[2] = bflo(w.y); v[3] = bfhi(w.y); v[4] = bflo(w.z); v[5] = bfhi(w.z); v[6] = bflo(w.w); v[7] = bfhi(w.w); }
__device__ __forceinline__ void conv_phase(const bf16_t* H, const float* cw, const float* cb, bf16_t* ACT) {
    constexpr int RB = 16, NCH = DFF / 8;
    const int gt = obid() * NTHREADS + otid(), NT = ogrid() * NTHREADS;
    for (int it = gt; it < (TA / RB) * NCH; it += NT) {
        const int ch = it % NCH, rb = it / NCH, c0 = ch * 8, m0 = rb * RB, s0 = m0 % SEQ;
        float wg[3][8], wu[3][8], bg[8], bu[8];
#pragma unroll
        for (int t = 0; t < 3; ++t)
#pragma unroll
            for (int j = 0; j < 8; ++j) { wg[t][j] = cw[(size_t)t * 2 * DFF + c0 + j]; wu[t][j] = cw[(size_t)t * 2 * DFF + DFF + c0 + j]; }
#pragma unroll
        for (int j = 0; j < 8; ++j) { bg[j] = cb[c0 + j]; bu[j] = cb[DFF + c0 + j]; }
        float g0[8], g1[8], g2[8], u0[8], u1[8], u2[8];
        if (s0 > 0) { ld8(H + (size_t)(m0 - 1) * 2 * DFF + c0, g0); ld8(H + (size_t)(m0 - 1) * 2 * DFF + DFF + c0, u0); }
        else {
#pragma unroll
            for (int j = 0; j < 8; ++j) { g0[j] = 0.f; u0[j] = 0.f; } }
        ld8(H + (size_t)m0 * 2 * DFF + c0, g1); ld8(H + (size_t)m0 * 2 * DFF + DFF + c0, u1);
        for (int r = 0; r < RB; ++r) { const int m = m0 + r;
            if (s0 + r + 1 < SEQ) { ld8(H + (size_t)(m + 1) * 2 * DFF + c0, g2); ld8(H + (size_t)(m + 1) * 2 * DFF + DFF + c0, u2); }
            else {
#pragma unroll
                for (int j = 0; j < 8; ++j) { g2[j] = 0.f; u2[j] = 0.f; } }
            float o[8];
#pragma unroll
            for (int j = 0; j < 8; ++j) { const float gg = bg[j] + g0[j] * wg[0][j] + g1[j] * wg[1][j] + g2[j] * wg[2][j]; const float uu = bu[j] + u0[j] * wu[0][j] + u1[j] * wu[1][j] + u2[j] * wu[2][j]; o[j] = gelu_tanh(gg) * uu; }
            *(u32x4*)(ACT + (size_t)m * DFF + c0) = (u32x4){pk2(o[0], o[1]), pk2(o[2], o[3]), pk2(o[4], o[5]), pk2(o[6], o[7])};
#pragma unroll
            for (int j = 0; j < 8; ++j) { g0[j] = g1[j]; g1[j] = g2[j]; u0[j] = u1[j]; u1[j] = u2[j]; }
        }
    }
}

constexpr size_t G_RL = WS_G + 320 * MiB;
static_assert(G_RL + 32 * MiB <= 480 * MiB, "ws");
__device__ __forceinline__ void ret_local(const Params& p, unsigned char* lds, int item) {
    unsigned char* ws = p.ws;
    int tid_ = threadIdx.x; asm volatile("" : "+v"(tid_));
    const int tid = tid_, lane = tid & 63, w = tid >> 6, l15 = lane & 15, quad = lane >> 4;
    const int eq = item & 3, idx = (item >> 2) % 6, bh = (item >> 2) / 6, bl = bh >> 2, h = bh & 3;
    const int dirb = idx >= 3, m = dirb ? idx - 2 : idx;
    const float lg2 = log2f(1.f - exp2f(-5.f - (float)h));
    bf16_t* KT = (bf16_t*)lds;
    bf16_t* VTx = (bf16_t*)(lds + 20480);
    const bf16_t* Kg = (const bf16_t*)(ws + G_K) + ((size_t)(bl * SEQ + m * 512)) * DM + h * 256;
    const bf16_t* VT = (const bf16_t*)(ws + G_VT) + ((size_t)(h * 512 + eq * 128)) * TG + bl * SEQ + m * 512;
    const int kj = tid & 31, kc8 = (tid >> 5) * 8;
    const int ve = tid >> 2, vj8 = (tid & 3) * 8;
    f32x4 af[2][8];
#pragma unroll
    for (int i = 0; i < 2; ++i)
#pragma unroll
        for (int j = 0; j < 8; ++j) af[i][j] = (f32x4){0.f, 0.f, 0.f, 0.f};
    u32x4 kr0[2], kr1[2], kr2[2], kr3[2], vr0, vr1, vr2, vr3;
#define RL_LOAD(s, KR, VR) do { const int s_ = (s) < 16 ? (s) : 15; \
        _Pragma("unroll") for (int i = 0; i < 2; ++i) KR[i] = *(const u32x4*)(Kg + (size_t)(32 * s_ + kj) * DM + kc8 + 128 * i); \
        VR = *(const u32x4*)(VT + (size_t)ve * TG + 32 * s_ + vj8); } while (0)
    RL_LOAD(0, kr0, vr0); RL_LOAD(1, kr1, vr1); RL_LOAD(2, kr2, vr2);
    const int et0 = 2 * (w & 3), dt0 = 8 * (w >> 2);
    __syncthreads();
#define RL_STEP(s, KR, VR, KN, VN) do { \
        _Pragma("unroll") for (int i = 0; i < 2; ++i) { const int j = kj, c0 = kc8 + 128 * i; const unsigned wv[4] = {KR[i].x, KR[i].y, KR[i].z, KR[i].w}; \
            _Pragma("unroll") for (int q = 0; q < 4; ++q) { KT[(c0 + 2 * q) * 40 + j] = (bf16_t)(wv[q] & 0xffffu); KT[(c0 + 2 * q + 1) * 40 + j] = (bf16_t)(wv[q] >> 16); } } \
        { const unsigned wv[4] = {VR.x, VR.y, VR.z, VR.w}; unsigned ov[4]; \
          _Pragma("unroll") for (int q = 0; q < 4; ++q) { const int jj = 32 * (s) + vj8 + 2 * q; const float v0 = bflo(wv[q]), v1 = bfhi(wv[q]); \
              const float e0 = dirb ? (float)jj : (float)(511 - jj), e1 = dirb ? (float)(jj + 1) : (float)(510 - jj); \
              ov[q] = cvtpk(v0 * __builtin_amdgcn_exp2f(lg2 * e0), v1 * __builtin_amdgcn_exp2f(lg2 * e1)); } \
          *(u32x4*)(VTx + ve * 40 + vj8) = (u32x4){ov[0], ov[1], ov[2], ov[3]}; } \
        __syncthreads(); \
        RL_LOAD((s) + 3, KN, VN); \
        bf16x8 a0[2]; \
        _Pragma("unroll") for (int i = 0; i < 2; ++i) a0[i] = *(const bf16x8*)(VTx + (16 * (et0 + i) + l15) * 40 + quad * 8); \
        _Pragma("unroll") for (int j = 0; j < 8; ++j) { const bf16x8 b = *(const bf16x8*)(KT + (16 * (dt0 + j) + l15) * 40 + quad * 8); \
            _Pragma("unroll") for (int i = 0; i < 2; ++i) af[i][j] = mfma16(b, a0[i], af[i][j]); }       \
        __syncthreads(); } while (0)
    for (int s = 0; s < 16; s += 4) { RL_STEP(s, kr0, vr0, kr3, vr3); RL_STEP(s + 1, kr1, vr1, kr0, vr0); RL_STEP(s + 2, kr2, vr2, kr1, vr1); RL_STEP(s + 3, kr3, vr3, kr2, vr2); }
#undef RL_LOAD
#undef RL_STEP
    bf16_t* L = (bf16_t*)(ws + G_RL) + ((size_t)((bh * 4 + m) * 2 + dirb) * 512 + eq * 128) * 256;
#pragma unroll
    for (int i = 0; i < 2; ++i)
#pragma unroll
        for (int j = 0; j < 8; ++j)
            *(u32x2*)(L + (size_t)(16 * (et0 + i) + l15) * 256 + 16 * (dt0 + j) + 4 * quad) = (u32x2){cvtpk(af[i][j][0], af[i][j][1]), cvtpk(af[i][j][2], af[i][j][3])};
}

__device__ __forceinline__ void ret_item(const Params& p, unsigned char* lds, int item) {
    unsigned char* ws = p.ws;
    int tid_ = threadIdx.x; asm volatile("" : "+v"(tid_));
    const int tid = tid_, lane = tid & 63, w = tid >> 6, l15 = lane & 15, quad = lane >> 4;
    const int bh = item >> 5, bl = bh >> 2, h = bh & 3, qt = item & 31, cq = qt >> 3, kt0 = 8 * cq;
    const float lg2 = log2f(1.f - exp2f(-5.f - (float)h));
    bf16_t* Ks = (bf16_t*)lds;
    bf16_t* Ps = (bf16_t*)(lds + 67584);
    float* red = (float*)(lds + 86016);
    float* rstd = (float*)(lds + 88064);
    const bf16_t* Q = (const bf16_t*)(ws + G_Q) + ((size_t)(bl * SEQ + qt * 64)) * DM + h * 256;
    const bf16_t* Kg = (const bf16_t*)(ws + G_K) + ((size_t)(bl * SEQ)) * DM + h * 256;
    const bf16_t* VTw = (const bf16_t*)(ws + G_VT) + ((size_t)(h * 512 + 64 * w + l15)) * TG + bl * SEQ + quad * 16;
    const bf16_t* Lw = (const bf16_t*)(ws + G_RL) + ((size_t)(bh * 4) * 2 * 512 + 64 * w + l15) * 256 + quad * 16;
    const int ti = w >> 1, tj0 = (w & 1) * 2;
    bf16_t* Qs = (bf16_t*)(lds + 88320);
    const int kr = tid >> 5, kc = (tid & 31) * 8;
    const int prow = tid >> 3, pc8 = (tid & 7) * 8;
    const int pos = (qt & 7) * 64 + prow;
    u32x4 kreg[4], VA[8], VB[8], VC[8];
#define RET_LOADV(g, V) do { if ((g) < 8) { const bf16_t* s_ = VTw + (kt0 + (g)) * 64; \
            _Pragma("unroll") for (int j = 0; j < 4; ++j) _Pragma("unroll") for (int kk = 0; kk < 2; ++kk) V[j * 2 + kk] = *(const u32x4*)(s_ + (size_t)(16 * j) * TG + kk * 8); } \
        else if ((g) < 20) { const int st_ = (g) - 8, mi_ = st_ >> 2, m_ = mi_ + (mi_ >= cq ? 1 : 0), ds_ = st_ & 3; \
            const bf16_t* s_ = Lw + ((size_t)(m_ * 2 + (m_ < cq ? 0 : 1)) * 512) * 256 + ds_ * 64; \
            _Pragma("unroll") for (int j = 0; j < 4; ++j) _Pragma("unroll") for (int kk = 0; kk < 2; ++kk) V[j * 2 + kk] = *(const u32x4*)(s_ + (size_t)(16 * j) * 256 + kk * 8); } } while (0)
#define RET_PV(Pw, V) do { _Pragma("unroll") for (int kk = 0; kk < 2; ++kk) { bf16x8 a[4]; \
            _Pragma("unroll") for (int i = 0; i < 4; ++i) a[i] = *(const bf16x8*)((Pw) + (16 * i + l15) * 72 + quad * 16 + kk * 8); \
            _Pragma("unroll") for (int i = 0; i < 4; ++i) _Pragma("unroll") for (int j = 0; j < 4; ++j) o[i][j] = mfma16(__builtin_bit_cast(bf16x8, V[j * 2 + kk]), a[i], o[i][j]); } } while (0)
#define RET_TILE(g, VCU, VN) do { const int kt = kt0 + (g); const bf16_t* Kc = Ks + ((g) & 1) * (64 * 264); bf16_t* Pw = Ps + ((g) & 1) * (64 * 72); \
        f32x4 s0 = {0.f, 0.f, 0.f, 0.f}, s1 = {0.f, 0.f, 0.f, 0.f}; \
        _Pragma("unroll") for (int ks = 0; ks < 8; ++ks) { \
            const bf16x8 b0 = *(const bf16x8*)(Kc + (16 * tj0 + l15) * 264 + ks * 32 + quad * 8); \
            const bf16x8 b1 = *(const bf16x8*)(Kc + (16 * (tj0 + 1) + l15) * 264 + ks * 32 + quad * 8); \
            const bf16x8 qa = *(const bf16x8*)(Qs + (16 * ti + l15) * 264 + ks * 32 + quad * 8); \
            s0 = mfma16(qa, b0, s0); s1 = mfma16(qa, b1, s1); } \
        _Pragma("unroll") for (int r = 0; r < 4; ++r) { const int row = 16 * ti + 4 * quad + r, qpos = qt * 64 + row; \
            const int c0 = 16 * tj0 + l15, c1 = c0 + 16; \
            const float d0 = fabsf((float)(qpos - (kt * 64 + c0))), d1 = fabsf((float)(qpos - (kt * 64 + c1))); \
            Pw[row * 72 + c0] = (bf16_t)cvtpk(s0[r] * __builtin_amdgcn_exp2f(lg2 * d0), 0.f); \
            Pw[row * 72 + c1] = (bf16_t)cvtpk(s1[r] * __builtin_amdgcn_exp2f(lg2 * d1), 0.f); } \
        if ((g) + 1 < 8) { bf16_t* Kn = Ks + (((g) + 1) & 1) * (64 * 264); \
            _Pragma("unroll") for (int i = 0; i < 4; ++i) *(u32x4*)(Kn + (kr + 16 * i) * 264 + kc) = kreg[i]; } \
        __syncthreads(); \
        RET_LOADV((g) + 2, VN); \
        if ((g) + 2 < 8) { _Pragma("unroll") for (int i = 0; i < 4; ++i) kreg[i] = *(const u32x4*)(Kg + (size_t)((kt + 2) * 64 + kr + 16 * i) * DM + kc); } \
        RET_PV(Pw, VCU); } while (0)
#define RET_STATE(g, VCU, VN) do { bf16_t* Pw = Ps + ((g) & 1) * (64 * 72); \
        { const int mi = ((g) - 8) >> 2, m = mi + (mi >= cq ? 1 : 0); \
          const float ex = (m < cq) ? (float)(pos + 1 + (cq - 1 - m) * 512) : (float)(512 - pos + (m - cq - 1) * 512); \
          const float rs = __builtin_amdgcn_exp2f(lg2 * ex); const u32x4 qreg = *(const u32x4*)(Qs + prow * 264 + (((g) - 8) & 3) * 64 + pc8); \
          *(u32x4*)(Pw + prow * 72 + pc8) = (u32x4){cvtpk(bflo(qreg.x) * rs, bfhi(qreg.x) * rs), cvtpk(bflo(qreg.y) * rs, bfhi(qreg.y) * rs), cvtpk(bflo(qreg.z) * rs, bfhi(qreg.z) * rs), cvtpk(bflo(qreg.w) * rs, bfhi(qreg.w) * rs)}; } \
        __syncthreads(); \
        RET_LOADV((g) + 2, VN); \
        RET_PV(Pw, VCU); } while (0)
    __syncthreads();
#pragma unroll
    for (int i = 0; i < 4; ++i) { *(u32x4*)(Ks + (kr + 16 * i) * 264 + kc) = *(const u32x4*)(Kg + (size_t)(kt0 * 64 + kr + 16 * i) * DM + kc);
        *(u32x4*)(Qs + (kr + 16 * i) * 264 + kc) = *(const u32x4*)(Q + (size_t)(kr + 16 * i) * DM + kc); }
    RET_LOADV(0, VA); RET_LOADV(1, VB);
#pragma unroll
    for (int i = 0; i < 4; ++i) kreg[i] = *(const u32x4*)(Kg + (size_t)((kt0 + 1) * 64 + kr + 16 * i) * DM + kc);
    f32x4 o[4][4];
#pragma unroll
    for (int i = 0; i < 4; ++i)
#pragma unroll
        for (int j = 0; j < 4; ++j) o[i][j] = (f32x4){0.f, 0.f, 0.f, 0.f};
    __syncthreads();
#define RET_STEP(g, VCUR, VNXT) do { if ((g) < 8) RET_TILE(g, VCUR, VNXT); else if ((g) < 20) RET_STATE(g, VCUR, VNXT); } while (0)
    for (int g = 0; g < 21; g += 3) { RET_STEP(g, VA, VC); RET_STEP(g + 1, VB, VA); RET_STEP(g + 2, VC, VB); }
#undef RET_STEP
#undef RET_LOADV
#undef RET_PV
#undef RET_TILE
#undef RET_STATE
#pragma unroll
    for (int i = 0; i < 4; ++i) { float s = 0.f;
#pragma unroll
        for (int j = 0; j < 4; ++j)
#pragma unroll
            for (int r = 0; r < 4; ++r) s += o[i][j][r] * o[i][j][r];
        s += shx(s, 16, lane); s += shx(s, 32, lane);
        if (quad == 0) red[w * 64 + 16 * i + l15] = s; }
    __syncthreads();
    if (tid < 64) { float s = 0.f;
#pragma unroll
        for (int ww = 0; ww < 8; ++ww) s += red[ww * 64 + tid];
        rstd[tid] = rsqrtf(s * (1.f / 512.f) + EPS); }
    __syncthreads();
    bf16_t* RO = (bf16_t*)(ws + G_SGR) + ((size_t)(bl * SEQ + qt * 64)) * 2048 + h * 512 + 64 * w + 4 * quad;
    u32x2 gv[4][4];
#pragma unroll
    for (int i = 0; i < 4; ++i)
#pragma unroll
        for (int j = 0; j < 4; ++j) gv[i][j] = *(const u32x2*)(RO + (size_t)(16 * i + l15) * 2048 + 16 * j);
#pragma unroll
    for (int i = 0; i < 4; ++i) { const float rs = rstd[16 * i + l15];
#pragma unroll
        for (int j = 0; j < 4; ++j) { const f32x4 v = o[i][j] * rs;
            *(u32x2*)(RO + (size_t)(16 * i + l15) * 2048 + 16 * j) = (u32x2){cvtpk(v[0] * bflo(gv[i][j].x), v[1] * bfhi(gv[i][j].x)), cvtpk(v[2] * bflo(gv[i][j].y), v[3] * bfhi(gv[i][j].y))}; } }
}

struct HgRaw { unsigned q[8], l[8]; u32x4 v0, v1; };
__device__ __forceinline__ void hgrn_load(HgRaw& R, const bf16_t* HQ, const bf16_t* LF, const bf16_t* HI, int c, int dir, int d2, int tg, int vt, int veg) {
#pragma unroll
    for (int i = 0; i < 8; ++i) { const int tau = 32 * c + 8 * tg + i, s = dir ? (SEQ - 1 - tau) : tau; R.q[i] = *(const unsigned*)(HQ + (size_t)s * DM + 2 * d2); R.l[i] = *(const unsigned*)(LF + (size_t)s * DM + 2 * d2); }
    { const int tau = 32 * c + vt, s = dir ? (SEQ - 1 - tau) : tau; R.v0 = *(const u32x4*)(HI + (size_t)s * DM + veg * 16); R.v1 = *(const u32x4*)(HI + (size_t)s * DM + veg * 16 + 8); }
}
__device__ __forceinline__ void hgrn_prep(const HgRaw& R, bf16_t* Qe, bf16_t* Ke, bf16_t* KdT, float* decs, bf16_t* VTs, int d2, int tg, int vt, int veg, int lane) {
    float b0[8], b1[8], l0[8], l1[8]; float run0 = 0.f, run1 = 0.f;
#pragma unroll
    for (int i = 0; i < 8; ++i) { l0[i] = bflo(R.l[i]); l1[i] = bfhi(R.l[i]); run0 += l0[i]; run1 += l1[i]; b0[i] = run0; b1[i] = run1; }
    float pre0, pre1, bl0, bl1;
    { const float r1 = shx(run0, 1, lane), s2 = run0 + r1, s2x = shx(s2, 2, lane); bl0 = s2 + s2x; pre0 = ((tg & 1) ? r1 : 0.f) + ((tg & 2) ? s2x : 0.f); }
    { const float r1 = shx(run1, 1, lane), s2 = run1 + r1, s2x = shx(s2, 2, lane); bl1 = s2 + s2x; pre1 = ((tg & 1) ? r1 : 0.f) + ((tg & 2) ? s2x : 0.f); }
    const float c30 = __builtin_amdgcn_exp2f(bl0), c31 = __builtin_amdgcn_exp2f(bl1);
    float kd0[8], kd1[8];
#pragma unroll
    for (int i = 0; i < 8; ++i) { const int t = 8 * tg + i;
        const float bb0 = b0[i] + pre0, bb1 = b1[i] + pre1;
        const float k0 = 1.f - __builtin_amdgcn_exp2f(l0[i]), k1 = 1.f - __builtin_amdgcn_exp2f(l1[i]);
        const float ke0 = k0 * __builtin_amdgcn_exp2f(fminf(-bb0, 115.f)), ke1 = k1 * __builtin_amdgcn_exp2f(fminf(-bb1, 115.f));
        *(unsigned*)(Qe + t * 136 + 2 * d2) = cvtpk(bflo(R.q[i]) * __builtin_amdgcn_exp2f(bb0), bfhi(R.q[i]) * __builtin_amdgcn_exp2f(bb1));
        *(unsigned*)(Ke + t * 136 + 2 * d2) = cvtpk(ke0, ke1);
        kd0[i] = ke0 * c30; kd1[i] = ke1 * c31;
        if (__builtin_expect(!(bl0 > -86.f && bl1 > -86.f), 0)) { kd0[i] = k0 * __builtin_amdgcn_exp2f(bl0 - bb0); kd1[i] = k1 * __builtin_amdgcn_exp2f(bl1 - bb1); } }
    *(u32x4*)(KdT + (2 * d2) * 40 + 8 * tg) = (u32x4){cvtpk(kd0[0], kd0[1]), cvtpk(kd0[2], kd0[3]), cvtpk(kd0[4], kd0[5]), cvtpk(kd0[6], kd0[7])};
    *(u32x4*)(KdT + (2 * d2 + 1) * 40 + 8 * tg) = (u32x4){cvtpk(kd1[0], kd1[1]), cvtpk(kd1[2], kd1[3]), cvtpk(kd1[4], kd1[5]), cvtpk(kd1[6], kd1[7])};
    if (tg == 0) { decs[2 * d2] = c30; decs[2 * d2 + 1] = c31; }
    { const unsigned wv[8] = {R.v0.x, R.v0.y, R.v0.z, R.v0.w, R.v1.x, R.v1.y, R.v1.z, R.v1.w};
#pragma unroll
      for (int q = 0; q < 8; ++q) { VTs[(16 * veg + 2 * q) * 40 + vt] = (bf16_t)(wv[q] & 0xffffu); VTs[(16 * veg + 2 * q + 1) * 40 + vt] = (bf16_t)(wv[q] >> 16); } }
}
__device__ __forceinline__ void hgrn_item(const Params& p, unsigned char* lds, int item) {
    unsigned char* ws = p.ws;
    int tid_ = threadIdx.x; asm volatile("" : "+v"(tid_));
    const int tid = tid_, lane = tid & 63, w = tid >> 6, l15 = lane & 15, quad = lane >> 4;
    const int dir = item & 1, h = (item >> 1) & 7, bl = item >> 4;
    bf16_t* Qe2 = (bf16_t*)lds;
    bf16_t* Ke2 = (bf16_t*)(lds + 17408);
    bf16_t* KdT2 = (bf16_t*)(lds + 34816);
    bf16_t* VTs2 = (bf16_t*)(lds + 55296);
    float* decs2 = (float*)(lds + 75776);
    bf16_t* Ps = (bf16_t*)(lds + 76800);
    bf16_t* StT = (bf16_t*)(lds + 79360);
    const bf16_t* HQ = (const bf16_t*)(ws + G_HQ) + (size_t)bl * SEQ * DM + h * 128;
    const bf16_t* LF = (const bf16_t*)(ws + (dir ? G_LFB : G_LFF)) + (size_t)bl * SEQ * DM + h * 128;
    const bf16_t* HI = (const bf16_t*)(ws + G_HI) + (size_t)bl * SEQ * DM + h * 128;
    bf16_t* HO = (bf16_t*)(ws + (dir ? G_HOB : G_HOF)) + (size_t)bl * SEQ * DM + h * 128;
    __syncthreads();
    for (int i = tid; i < 128 * 136 / 2; i += NTHREADS) ((unsigned*)StT)[i] = 0u;
    if (w < 4) {
        const int d2 = tid >> 2, tg = tid & 3, vt = tid & 31, veg = tid >> 5;
        HgRaw RA, RB;
        hgrn_load(RA, HQ, LF, HI, 0, dir, d2, tg, vt, veg);
        hgrn_load(RB, HQ, LF, HI, 1, dir, d2, tg, vt, veg);
        hgrn_prep(RA, Qe2, Ke2, KdT2, decs2, VTs2, d2, tg, vt, veg, lane);
        __syncthreads();
#define HG_PROD(c, RP, RL) do { \
            if ((c) + 2 < 64) hgrn_load(RL, HQ, LF, HI, (c) + 2, dir, d2, tg, vt, veg); \
            if ((c) + 1 < 64) { const int pb = ((c) + 1) & 1; \
                hgrn_prep(RP, Qe2 + pb * (32 * 136), Ke2 + pb * (32 * 136), KdT2 + pb * (128 * 40), decs2 + pb * 128, VTs2 + pb * (128 * 40), d2, tg, vt, veg, lane); } \
            __syncthreads(); __syncthreads(); } while (0)
        for (int c = 0; c < 64; c += 2) { HG_PROD(c, RB, RA); HG_PROD(c + 1, RA, RB); }
#undef HG_PROD
    } else {
        const int cw = w - 4;
        const int oti = cw >> 1, otj = cw & 1;
        f32x4 st[2][8];
#pragma unroll
        for (int dj = 0; dj < 2; ++dj)
#pragma unroll
            for (int j = 0; j < 8; ++j) st[dj][j] = (f32x4){0.f, 0.f, 0.f, 0.f};
        __syncthreads();
        for (int c = 0; c < 64; ++c) {
            const int pb = c & 1;
            const bf16_t* Qe = Qe2 + pb * (32 * 136); const bf16_t* Ke = Ke2 + pb * (32 * 136); const bf16_t* KdT = KdT2 + pb * (128 * 40);
            const bf16_t* VTs = VTs2 + pb * (128 * 40); const float* decs = decs2 + pb * 128;
            f32x4 ao[2][2];
#pragma unroll
            for (int ej = 0; ej < 2; ++ej)
#pragma unroll
                for (int ti = 0; ti < 2; ++ti) ao[ej][ti] = (f32x4){0.f, 0.f, 0.f, 0.f};
#pragma unroll
            for (int ks = 0; ks < 4; ++ks) { bf16x8 sf[2], qf2[2];
#pragma unroll
                for (int ej = 0; ej < 2; ++ej) sf[ej] = *(const bf16x8*)(StT + (16 * (2 * cw + ej) + l15) * 136 + ks * 32 + quad * 8);
#pragma unroll
                for (int ti = 0; ti < 2; ++ti) qf2[ti] = *(const bf16x8*)(Qe + (16 * ti + l15) * 136 + ks * 32 + quad * 8);
#pragma unroll
                for (int ej = 0; ej < 2; ++ej)
#pragma unroll
                    for (int ti = 0; ti < 2; ++ti) ao[ej][ti] = mfma16(sf[ej], qf2[ti], ao[ej][ti]); }
            { f32x4 acc = {0.f, 0.f, 0.f, 0.f};
#pragma unroll
              for (int ks = 0; ks < 4; ++ks) { const bf16x8 a = *(const bf16x8*)(Qe + (16 * oti + l15) * 136 + ks * 32 + quad * 8); const bf16x8 bb = *(const bf16x8*)(Ke + (16 * otj + l15) * 136 + ks * 32 + quad * 8); acc = mfma16(bb, a, acc); }
              const int t = 16 * oti + l15, s0 = 16 * otj + 4 * quad;
              *(u32x2*)(Ps + t * 40 + s0) = (u32x2){cvtpk(s0 <= t ? acc[0] : 0.f, s0 + 1 <= t ? acc[1] : 0.f), cvtpk(s0 + 2 <= t ? acc[2] : 0.f, s0 + 3 <= t ? acc[3] : 0.f)}; }
            { bf16x8 kf[2]; f32x4 dc[2];
#pragma unroll
              for (int dj = 0; dj < 2; ++dj) { kf[dj] = *(const bf16x8*)(KdT + (16 * (2 * cw + dj) + l15) * 40 + quad * 8); dc[dj] = *(const f32x4*)(decs + 16 * (2 * cw + dj) + 4 * quad); }
#pragma unroll
              for (int j = 0; j < 8; ++j) { const bf16x8 vf = *(const bf16x8*)(VTs + (16 * j + l15) * 40 + quad * 8);
#pragma unroll
                  for (int dj = 0; dj < 2; ++dj) st[dj][j] = mfma16(kf[dj], vf, st[dj][j] * dc[dj]); } }
            __syncthreads();
            { bf16x8 pf[2];
#pragma unroll
              for (int ti = 0; ti < 2; ++ti) pf[ti] = *(const bf16x8*)(Ps + (16 * ti + l15) * 40 + quad * 8);
#pragma unroll
              for (int ej = 0; ej < 2; ++ej) { const bf16x8 vf = *(const bf16x8*)(VTs + (16 * (2 * cw + ej) + l15) * 40 + quad * 8);
#pragma unroll
                  for (int ti = 0; ti < 2; ++ti) { ao[ej][ti] = mfma16(vf, pf[ti], ao[ej][ti]);
                      const int tau = 32 * c + 16 * ti + l15, s = dir ? (SEQ - 1 - tau) : tau;
                      *(u32x2*)(HO + (size_t)s * DM + 16 * (2 * cw + ej) + 4 * quad) = (u32x2){cvtpk(ao[ej][ti][0], ao[ej][ti][1]), cvtpk(ao[ej][ti][2], ao[ej][ti][3])}; } } }
#pragma unroll
            for (int dj = 0; dj < 2; ++dj)
#pragma unroll
                for (int j = 0; j < 8; ++j)
                    *(u32x2*)(StT + (16 * j + l15) * 136 + 16 * (2 * cw + dj) + 4 * quad) = (u32x2){cvtpk(st[dj][j][0], st[dj][j][1]), cvtpk(st[dj][j][2], st[dj][j][3])};
            __syncthreads();
        }
    }
}

__device__ __forceinline__ void seq_combine(const bf16_t* OZ, const bf16_t* PQT, bf16_t* YF) {
    constexpr int LD = NB * 1024;
    const int tid = otid(), gt = obid() * NTHREADS + tid, NT = ogrid() * NTHREADS;
    constexpr int NIT = 1024 * LD / 8;
    for (int it = gt; it < NIT; it += 4 * NT) { u32x4 av[4], bv[4];
#pragma unroll
        for (int u = 0; u < 4; ++u) { const int i2 = it + u * NT; if (i2 < NIT) { const int sp = i2 / (LD / 8), n0 = (i2 % (LD / 8)) * 8;
            av[u] = *(const u32x4*)(OZ + (size_t)sp * LD + n0); bv[u] = *(const u32x4*)(OZ + (size_t)(1024 + sp) * LD + n0); } }
#pragma unroll
        for (int u = 0; u < 4; ++u) { const int i2 = it + u * NT; if (i2 < NIT) { const int sp = i2 / (LD / 8), n0 = (i2 % (LD / 8)) * 8, bl = n0 >> 10, gc = n0 & 1023;
            const unsigned aw[4] = {av[u].x, av[u].y, av[u].z, av[u].w}, bw[4] = {bv[u].x, bv[u].y, bv[u].z, bv[u].w}; unsigned su[4], di[4];
#pragma unroll
            for (int q = 0; q < 4; ++q) { const float a0 = bflo(aw[q]), a1 = bfhi(aw[q]), b0 = bflo(bw[q]), b1 = bfhi(bw[q]); su[q] = pk2(a0 + b0, a1 + b1); di[q] = pk2(a0 - b0, a1 - b1); }
            *(u32x4*)(YF + ((size_t)(bl * SEQ + sp)) * DM + gc) = (u32x4){su[0], su[1], su[2], su[3]};
            if (sp > 0) *(u32x4*)(YF + ((size_t)(bl * SEQ + SEQ - sp)) * DM + gc) = (u32x4){di[0], di[1], di[2], di[3]}; } }
    }
    const int lane = tid & 63, gw = obid() * 8 + (tid >> 6), NGW = ogrid() * 8;
    for (int n = gw; n < LD; n += NGW) { const bf16_t* pr = PQT + (size_t)n * 4096 + lane * 32; float s = 0.f;
#pragma unroll
        for (int q = 0; q < 4; ++q) { float v[8]; ld8(pr + 8 * q, v); s += (v[0] - v[1]) + (v[2] - v[3]) + (v[4] - v[5]) + (v[6] - v[7]); }
        s = wave_sum(s, lane);
        if (lane == 0) YF[((size_t)((n >> 10) * SEQ + 1024)) * DM + (n & 1023)] = (bf16_t)f2bf(s * 0.02209708691207961f); }
}

__device__ __forceinline__ void mix_combine(const bf16_t* F1, const bf16_t* F2, bf16_t* MIX, int rank, int nblk) {
    const int gt = rank * NTHREADS + otid(), NT = nblk * NTHREADS;
    constexpr int NIT = TG * DM / 8;
    for (int it = gt; it < NIT; it += 4 * NT) { u32x4 a[4], b[4];
#pragma unroll
        for (int u = 0; u < 4; ++u) { const int i2 = it + u * NT; if (i2 < NIT) { a[u] = *(const u32x4*)(F1 + (size_t)i2 * 8); b[u] = *(const u32x4*)(F2 + (size_t)i2 * 8); } }
#pragma unroll
        for (int u = 0; u < 4; ++u) { const int i2 = it + u * NT; if (i2 < NIT)
            *(u32x4*)(MIX + (size_t)i2 * 8) = (u32x4){pk2(bflo(a[u].x) + bflo(b[u].x), bfhi(a[u].x) + bfhi(b[u].x)), pk2(bflo(a[u].y) + bflo(b[u].y), bfhi(a[u].y) + bfhi(b[u].y)),
                                                      pk2(bflo(a[u].z) + bflo(b[u].z), bfhi(a[u].z) + bfhi(b[u].z)), pk2(bflo(a[u].w) + bflo(b[u].w), bfhi(a[u].w) + bfhi(b[u].w))}; }
    }
}

__device__ __forceinline__ void hgrn_combine(const Params& p, int l) {
    unsigned char* ws = p.ws;
    const int tid = otid(), lane = tid & 63, gw = obid() * 8 + (tid >> 6), NGW = ogrid() * 8;
    const bf16_t* HOF = (const bf16_t*)(ws + G_HOF); const bf16_t* HOB = (const bf16_t*)(ws + G_HOB); bf16_t* SG = (bf16_t*)(ws + G_SGH);
    const float* nw = p.hgrn_norm_w + (size_t)l * 128;
    float nwv[2][8];
#pragma unroll
    for (int i = 0; i < 2; ++i)
#pragma unroll
        for (int j = 0; j < 8; ++j) nwv[i][j] = nw[(((lane + 64 * i) * 8) & 127) + j];
    for (int m0 = gw; m0 < TG; m0 += 2 * NGW) {
        u32x4 av[2][2], bv[2][2], gv[2][2];
#pragma unroll
        for (int r = 0; r < 2; ++r) { const int m = m0 + r * NGW;
#pragma unroll
            for (int i = 0; i < 2; ++i) { const size_t o = (size_t)m * DM + (lane + 64 * i) * 8;
                if (m < TG) { av[r][i] = *(const u32x4*)(HOF + o); bv[r][i] = *(const u32x4*)(HOB + o); gv[r][i] = *(const u32x4*)(SG + o); } } }
#pragma unroll
        for (int r = 0; r < 2; ++r) { const int m = m0 + r * NGW;
            if (m < TG) {
#pragma unroll
                for (int i = 0; i < 2; ++i) { const size_t o = (size_t)m * DM + (lane + 64 * i) * 8;
                    const unsigned aw[4] = {av[r][i].x, av[r][i].y, av[r][i].z, av[r][i].w}, bw[4] = {bv[r][i].x, bv[r][i].y, bv[r][i].z, bv[r][i].w}, gw4[4] = {gv[r][i].x, gv[r][i].y, gv[r][i].z, gv[r][i].w};
                    float a[8]; float ss = 0.f;
#pragma unroll
                    for (int q = 0; q < 4; ++q) { a[2 * q] = bflo(aw[q]) + bflo(bw[q]); a[2 * q + 1] = bfhi(aw[q]) + bfhi(bw[q]); ss += a[2 * q] * a[2 * q] + a[2 * q + 1] * a[2 * q + 1]; }
                    ss += shx(ss, 1, lane); ss += shx(ss, 2, lane); ss += shx(ss, 4, lane); ss += shx(ss, 8, lane);
                    const float rr = rsqrtf(ss * (1.f / 128.f) + EPS); unsigned ow[4];
#pragma unroll
                    for (int q = 0; q < 4; ++q) ow[q] = pk2(a[2 * q] * rr * nwv[i][2 * q] * bflo(gw4[q]), a[2 * q + 1] * rr * nwv[i][2 * q + 1] * bfhi(gw4[q]));
                    *(u32x4*)(SG + o) = (u32x4){ow[0], ow[1], ow[2], ow[3]}; } } }
    }
}

#define XB_TMO      128
#define XB_XCNT(j)  (256  + 64 * (j))
#define XB_XSUB(j)  (1280 + 64 * (j))
#define XB_XGEN(j)  (2304 + 64 * (j))
#define XB_TOP      3328
#define XB_TOPGEN   3392
#define XCD_BAR_WORDS 3456
#define XB_SPIN_CAP (1u << 22)
__device__ __forceinline__ unsigned xb_ld(unsigned* p)              { return __hip_atomic_load(p, __ATOMIC_RELAXED, __HIP_MEMORY_SCOPE_AGENT); }
__device__ __forceinline__ unsigned xb_add(unsigned* p, unsigned v) { return __hip_atomic_fetch_add(p, v, __ATOMIC_RELAXED, __HIP_MEMORY_SCOPE_AGENT); }
__device__ __forceinline__ unsigned xb_xcc_id() { return (unsigned)__builtin_amdgcn_s_getreg((3 << 11) | 20) & 0xFu; }
#define XB_SPIN(cond, bar) do { unsigned _sp = 0; while (cond) { __builtin_amdgcn_s_sleep(1); \
    if ((++_sp & 255u) == 0u) { if (xb_ld(&(bar)[XB_TMO])) break; if (_sp > XB_SPIN_CAP) { atomicAdd(&(bar)[XB_TMO], 1u); break; } } } } while (0)
__device__ __forceinline__ void xcd_barrier_complete(unsigned* bar, unsigned x, unsigned G, unsigned& nloc, unsigned& nx) {
    unsigned sum, cnt, mine, sp = 0u;
    for (;;) {
        sum = 0u; cnt = 0u; mine = 0u;
#pragma unroll
        for (unsigned j = 0; j < 16; ++j) { const unsigned c = xb_ld(&bar[XB_XCNT(j)]); sum += c; cnt += (c > 0u) ? 1u : 0u; mine = (j == x) ? c : mine; }
        if (sum == G) break;
        __builtin_amdgcn_s_sleep(1);
        if ((++sp & 255u) == 0u) { if (xb_ld(&bar[XB_TMO])) break; if (sp > XB_SPIN_CAP) { atomicAdd(&bar[XB_TMO], 1u); break; } }
    }
    nloc = mine > 0u ? mine : 1u; nx = cnt > 0u ? cnt : 1u;
}
__device__ __forceinline__ void xcd_barrier(unsigned* bar, volatile LAS unsigned* st, unsigned nparts) {
    asm volatile("s_waitcnt vmcnt(0)" ::: "memory");
    __syncthreads();
    if (threadIdx.x == 0) {
        const unsigned x = xb_xcc_id();
        __builtin_amdgcn_s_waitcnt(0);
        unsigned nloc = st[0], nx = st[1];
        if (nloc == 0u) { xcd_barrier_complete(bar, x, nparts, nloc, nx); st[0] = nloc; st[1] = nx; }
        const unsigned old = xb_add(&bar[XB_XSUB(x)], 1u);
        const unsigned gen = old / nloc;
        if (old + 1u == (gen + 1u) * nloc) {
            __builtin_amdgcn_fence(__ATOMIC_RELEASE, "agent");
            asm volatile("s_waitcnt vmcnt(0)" ::: "memory");
            const unsigned og = xb_add(&bar[XB_TOP], 1u);
            const unsigned tg = og / nx;
            if (og + 1u == (tg + 1u) * nx) xb_add(&bar[XB_TOPGEN], 1u);
            else XB_SPIN(xb_ld(&bar[XB_TOPGEN]) == tg, bar);
            __builtin_amdgcn_fence(__ATOMIC_ACQUIRE, "agent");
            xb_add(&bar[XB_XGEN(x)], 1u);
            asm volatile("s_waitcnt vmcnt(0)" ::: "memory");
        } else {
            XB_SPIN(xb_ld(&bar[XB_XGEN(x)]) == gen, bar);
            __builtin_amdgcn_fence(__ATOMIC_ACQUIRE, "agent");
            asm volatile("s_waitcnt vmcnt(0)" ::: "memory");
        }
    }
    __syncthreads();
}

typedef const Params __attribute__((address_space(4)))* KParams;
__global__ void __launch_bounds__(NTHREADS, 2) fwd_kernel(Params pk) {
    extern __shared__ __attribute__((aligned(16))) unsigned char lds_raw[];
    LAS unsigned char* lds = (LAS unsigned char*)lds_raw;
    cg::grid_group grid = cg::this_grid();
    volatile LAS unsigned* bst = (volatile LAS unsigned*)(lds + LDS_BYTES - 16);
    unsigned* gbar = (unsigned*)(pk.ws + WS_BAR);
    volatile LAS unsigned* bst2 = (volatile LAS unsigned*)(lds + LDS_BYTES - 32);
    constexpr int NHG = NB * 8 * 2;
    const bool coop = (pk.ph_hi - pk.ph_lo > 1);
    if (coop) {
        if (threadIdx.x == 0) { bst[0] = 0u; bst[1] = 0u; bst2[0] = 0u; bst2[1] = 0u; (void)xb_add(&gbar[XB_XCNT(xb_xcc_id())], 1u);
            if ((int)blockIdx.x >= NHG) (void)xb_add(&gbar[4096 + XB_XCNT(xb_xcc_id())], 1u); }
        __syncthreads();
    }
    const int lo = pk.ph_lo, hi = pk.ph_hi;
    int ph = 0;
#define PH_BEGIN if (ph >= lo && ph < hi) { KParams kp = (KParams)__builtin_amdgcn_kernarg_segment_ptr(); asm volatile("" : "+s"(kp)); Params p; __builtin_memcpy(&p, (const void __attribute__((address_space(4)))*)kp, sizeof(Params)); \
        unsigned char* ws = p.ws; const int G = ogrid(), cb = obid(); const float* xsrc = (l == 0) ? p.x : p.out; const float* nw = p.norm_w + (size_t)l * 4 * DM;
#define PH_END   if (ph + 1 < hi) { if (lo < 0) grid.sync(); else xcd_barrier((unsigned*)(ws + WS_BAR), bst, gridDim.x); } } ++ph;

    for (int l = 0; l < DEPTH; ++l) {
        if (l == 0) {
        PH_BEGIN
            prep_tables(p); rms_rows(p.x, nw, (bf16_t*)(ws + WS_MIXIN), TA);
            prep_weights(p, 0, lds);
        PH_END
        }
        for (int g = 0; g < NGRP; ++g) {
            const int tok0 = g * TG;
            PH_BEGIN
                const bf16_t* XN = (const bf16_t*)(ws + WS_MIXIN) + (size_t)tok0 * DM;
                if (g > 0 && cb >= (G >> 1)) mix_combine((const bf16_t*)(ws + G_F1), (const bf16_t*)(ws + G_F2), (bf16_t*)(ws + WS_MIXIN) + (size_t)(tok0 - TG) * DM, cb - (G >> 1), G - (G >> 1));
                __syncthreads();
                { pg8::Gemm gm{XN, (const bf16_t*)(ws + WS_WIN), DM, DM, DM}; pg8::SchedInProj S; S.init(G, cb);
                  pg8::EpiInProj E{ws, (const float*)(ws + WS_ROPE), (const float*)(ws + WS_LB), tok0};
                  pg8::gemm_phase<pg8::EpiInProj, pg8::SchedInProj>(lds, gm, S, E); }
                __syncthreads();
                { pg8::Gemm gm{(const bf16_t*)(ws + WS_WIN) + (size_t)2048 * DM, XN, DM, DM, DM}; pg8::SchedPlain S; S.init(2048, TG, DM, DM, G, cb);
                  pg8::EpiBf16<TG> E{(bf16_t*)(ws + G_VT)};
                  pg8::gemm_phase<pg8::EpiBf16<TG>, pg8::SchedPlain>(lds, gm, S, E); }
            PH_END
            PH_BEGIN
                const bool split = coop && G > 2 * NHG;
                int chG = G, chC = cb, chBase = 0, chLim = 4 * 2 * (TG / 256); bool chDo = true;
                const bool xaware = split && G == 256 && NB == 4;
                if (split && cb < NHG) { hgrn_item(p, lds_raw, cb);
                    if (xaware) { chG = NHG; chC = cb; chBase = 0; chLim = 2 * NHG; }
                    else chDo = false; }
                else {
                    const int Gs = split ? G - NHG : G, cs = split ? cb - NHG : cb;
                    if (!split) for (int it = cb; it < NB * 8 * 2; it += G) hgrn_item(p, lds_raw, it);
                    for (int it = cs; it < NB * 4 * 6 * 4; it += Gs) ret_local(p, lds_raw, it);
                    if (split) xcd_barrier((unsigned*)(ws + WS_BAR) + 4096, bst2, (unsigned)Gs);
                    else if (coop) xcd_barrier((unsigned*)(ws + WS_BAR), bst, gridDim.x);
                    constexpr int NRI = NB * 4 * 32;
                    if (xaware) {
                        const int x = cb & 7, j = cs >> 3;
                        for (int idx = j; idx < 64; idx += 24) ret_item(p, lds_raw, (2 * x) * 32 + idx);
                        chDo = j >= 16; chG = 64; chC = (j - 16) * 8 + x; chBase = 2 * NHG; chLim = 4 * NHG;
                    } else {
                        for (int it = cs; it < NRI; it += Gs) ret_item(p, lds_raw, it);
                        const int nfull = split ? NRI % Gs : 0;
                        chDo = cs >= nfull; chG = Gs - nfull; chC = cs - nfull;
                    }
                }
                __syncthreads();
                if (chDo) { pg8::Gemm gm{(const bf16_t*)(ws + WS_CDFT), (const bf16_t*)(ws + G_FU), 256, DM, 256}; pg8::SchedChan S; S.init(chG, chC, chBase, chLim);
                  pg8::EpiChan E{(bf16_t*)(ws + G_PQT)};
                  pg8::gemm_phase<pg8::EpiChan, pg8::SchedChan>(lds, gm, S, E); }
            PH_END
            PH_BEGIN
                hgrn_combine(p, l);
                __syncthreads();
                const int half = G >> 1;
                if (cb < half) { pg8::Gemm gm{(const bf16_t*)(ws + WS_DSEQ), (const bf16_t*)(ws + G_PQT), 4096, 4096, 2048}; pg8::SchedSeqH S; S.init(half, cb);
                  pg8::EpiSeqH E{(bf16_t*)(ws + G_SQ)};
                  pg8::gemm_phase<pg8::EpiSeqH, pg8::SchedSeqH>(lds, gm, S, E); }
                else { pg8::Gemm gm{(const bf16_t*)(ws + G_SGR), (const bf16_t*)(ws + WS_WRET), 2048, 2048, 2048}; pg8::SchedPlain S; S.init(TG, DM, 2048, 2048, G - half, cb - half);
                  pg8::EpiMix<0> E{(bf16_t*)(ws + G_F1), (const bf16_t*)(ws + G_GATES)};
                  pg8::gemm_phase<pg8::EpiMix<0>, pg8::SchedPlain>(lds, gm, S, E); }
            PH_END
            PH_BEGIN
                seq_combine((const bf16_t*)(ws + G_SQ), (const bf16_t*)(ws + G_PQT), (bf16_t*)(ws + G_YF));
            PH_END
            PH_BEGIN
                __syncthreads();
                const int half = G >> 1;
                if (cb < half) { pg8::Gemm gm{(const bf16_t*)(ws + G_SGH), (const bf16_t*)(ws + WS_WHG), DM, DM, DM}; pg8::SchedPlain S; S.init(TG, DM, DM, DM, half, cb);
                  pg8::EpiMix<1> E{(bf16_t*)(ws + G_F1), (const bf16_t*)(ws + G_GATES) + 1024};
                  pg8::gemm_phase<pg8::EpiMix<1>, pg8::SchedPlain>(lds, gm, S, E); }
                else { pg8::Gemm gm{(const bf16_t*)(ws + G_YF), (const bf16_t*)(ws + WS_WFN), DM, DM, DM}; pg8::SchedPlain S; S.init(TG, DM, DM, DM, G - half, cb - half);
                  pg8::EpiMix<0> E{(bf16_t*)(ws + G_F2), (const bf16_t*)(ws + G_GATES) + 2048};
                  pg8::gemm_phase<pg8::EpiMix<0>, pg8::SchedPlain>(lds, gm, S, E); }
            PH_END
            if (g == NGRP - 1) {
            PH_BEGIN
                mix_combine((const bf16_t*)(ws + G_F1), (const bf16_t*)(ws + G_F2), (bf16_t*)(ws + WS_MIXIN) + (size_t)tok0 * DM, cb, G);
            PH_END
            }
        }
        PH_BEGIN
            __syncthreads();
            { pg8::Gemm gm{(const bf16_t*)(ws + WS_MIXIN), (const bf16_t*)(ws + WS_WOUT), DM, DM, DM}; pg8::SchedPlain S; S.init(TA, DM, DM, DM, G, cb);
              pg8::EpiBf16<DM> E{(bf16_t*)(ws + A_MIXO)};
              pg8::gemm_phase<pg8::EpiBf16<DM>, pg8::SchedPlain>(lds, gm, S, E); }
        PH_END
        PH_BEGIN
            resid_rows((const bf16_t*)(ws + A_MIXO), xsrc, p.out, nw + DM, nw + 2 * DM, (bf16_t*)(ws + A_HN));
        PH_END
        PH_BEGIN
            __syncthreads();
            { pg8::Gemm gm{(const bf16_t*)(ws + A_HN), (const bf16_t*)(ws + WS_WUP), DM, DM, DM}; pg8::SchedPlain S; S.init(TA, 2 * DFF, DM, DM, G, cb);
              pg8::EpiBf16<2 * DFF> E{(bf16_t*)(ws + A_H)};
              pg8::gemm_phase<pg8::EpiBf16<2 * DFF>, pg8::SchedPlain>(lds, gm, S, E); }
        PH_END
        PH_BEGIN
            conv_phase((const bf16_t*)(ws + A_H), p.conv_w + (size_t)l * 3 * 2 * DFF, p.conv_b + (size_t)l * 2 * DFF, (bf16_t*)(ws + A_ACT));
        PH_END
        PH_BEGIN
            __syncthreads();
            { pg8::Gemm gm{(const bf16_t*)(ws + A_ACT), (const bf16_t*)(ws + WS_WDN), DFF, DFF, DFF}; pg8::SchedPlain S; S.init(TA, DM, DFF, DFF, G, cb);
              pg8::EpiBf16<DM> E{(bf16_t*)(ws + A_FFO)};
              pg8::gemm_phase<pg8::EpiBf16<DM>, pg8::SchedPlain>(lds, gm, S, E); }
        PH_END
        PH_BEGIN
            if (l + 1 < DEPTH) { resid_rows((const bf16_t*)(ws + A_FFO), p.out, p.out, nw + 3 * DM, nw + 4 * DM, (bf16_t*)(ws + WS_MIXIN));
                                 prep_weights(p, l + 1, lds); }
            else resid_rows((const bf16_t*)(ws + A_FFO), p.out, p.out, nw + 3 * DM, nullptr, nullptr);
        PH_END
    }
#undef PH_BEGIN
#undef PH_END
}
constexpr int NPHASES = 1 + DEPTH * (NGRP * 5 + 1 + 6);

extern "C" void kernel_launch(void* const* d_in, const int* in_sizes, int n_in, void* d_out, int out_size, void* d_ws, size_t ws_size, hipStream_t stream) {
    static int grid = 0;
    if (grid == 0) {
        int dev = 0, cus = 0, per_cu = 0;
        hipGetDevice(&dev);
        hipDeviceGetAttribute(&cus, hipDeviceAttributeMultiprocessorCount, dev);
        if (hipFuncSetAttribute((const void*)fwd_kernel, hipFuncAttributeMaxDynamicSharedMemorySize, LDS_BYTES) != hipSuccess) fprintf(stderr, "hipFuncSetAttribute failed\n");
        if (hipOccupancyMaxActiveBlocksPerMultiprocessor(&per_cu, (const void*)fwd_kernel, NTHREADS, LDS_BYTES) != hipSuccess || per_cu < 1) { fprintf(stderr, "occupancy query: %d\n", per_cu); per_cu = 1; }
        (void)hipGetLastError();
        grid = cus * 1;
        if (ws_size < 480 * MiB) fprintf(stderr, "kernel_launch: workspace %zu too small\n", ws_size);
    }
    Params p{};
    p.x = (const float*)d_in[0]; p.pos = (const int*)d_in[1]; p.norm_w = (const float*)d_in[2]; p.w_in = (const float*)d_in[3]; p.lb_logits = (const float*)d_in[4];
    p.hgrn_norm_w = (const float*)d_in[5]; p.w_ret_o = (const float*)d_in[6]; p.w_hgrn_o = (const float*)d_in[7]; p.w_fnet = (const float*)d_in[8]; p.w_out = (const float*)d_in[9];
    p.w_up = (const float*)d_in[10]; p.conv_w = (const float*)d_in[11]; p.conv_b = (const float*)d_in[12]; p.w_down = (const float*)d_in[13];
    p.out = (float*)d_out; p.ws = (unsigned char*)d_ws;
    (void)hipMemsetAsync((unsigned char*)d_ws + WS_BAR, 0, 32768, stream);
#if MK_MULTI
    for (int ph = 0; ph < NPHASES; ++ph) { p.ph_lo = ph; p.ph_hi = ph + 1; hipLaunchKernelGGL(fwd_kernel, dim3(grid), dim3(NTHREADS), LDS_BYTES, stream, p); }
#else
    p.ph_lo = 0; p.ph_hi = NPHASES;
    void* args[] = {&p};
    hipError_t e = hipLaunchCooperativeKernel((const void*)fwd_kernel, dim3(grid), dim3(NTHREADS), args, LDS_BYTES, stream);
    if (e != hipSuccess) fprintf(stderr, "cooperative launch failed: %s (grid %d)\n", hipGetErrorString(e), grid);
#endif
}
```
